# Optimizing an MI355X kernel written in HIP

```python
import jax, jax.numpy as jnp
from jax import lax
import numpy as np

D_MODEL = 1024
BATCH = 2
SEQ = 8192
DEPTH = 4
DEC_BATCH = 1
DEC_SEQ = 16384
PAST_LEN = 128

N_MIXERS = 3
N_LAYERS_A = (DEPTH + 2) // 3
N_LAYERS_B = (DEPTH + 1) // 3
N_LAYERS_C = DEPTH // 3
CHUNK = 128
A_WIDTH = D_MODEL
A_GROUPS = 8
A_HEAD = A_WIDTH // A_GROUPS
B_HEADS = 16
B_KV_HEADS = 4
B_HEAD_DIM = 64
B_Q_PER_KV = B_HEADS // B_KV_HEADS
WINDOW = 128
BLOCK = 128
C_WIDTH = D_MODEL
C_GROUPS = 8
C_GROUP_DIM = C_WIDTH // C_GROUPS
FF_DIM = 2816
CONV_WIDTH = 3
EPS = 1e-6
NEG_INF = -1e30

kernel_name = "hybrid_bidir_gmlp_swa_fnet_encoder"


def rmsnorm(x, g):
    xf = x.astype(jnp.float32)
    y = xf * lax.rsqrt(jnp.mean(xf * xf, axis=-1, keepdims=True) + EPS)
    return y.astype(x.dtype) * g


def alibi_slopes():
    return jnp.exp2(-8.0 * jnp.arange(1, B_HEADS + 1, dtype=jnp.float32) / B_HEADS)


def gmlp_chunk_mixer(h, w_in, g_v, w_s, b_s, w_out):
    b, s, _ = h.shape
    uv = jax.nn.gelu(h @ w_in, approximate=False)
    u, v = jnp.split(uv, 2, axis=-1)
    v = rmsnorm(v, g_v).reshape(b, s // CHUNK, CHUNK, A_GROUPS, A_HEAD)
    sv = jnp.einsum("gts,bnsgd->bntgd", w_s, v) + b_s.T[None, None, :, :, None]
    return (u * sv.reshape(b, s, A_WIDTH)) @ w_out


def windowed_gqa_mixer(h, w_qkv, sinks, w_o):
    b, s, _ = h.shape
    nb = s // BLOCK
    qkv = h @ w_qkv
    q, k, v = jnp.split(qkv, [B_HEADS * B_HEAD_DIM, (B_HEADS + B_KV_HEADS) * B_HEAD_DIM], axis=-1)
    q = q.reshape(b, nb, BLOCK, B_KV_HEADS, B_Q_PER_KV, B_HEAD_DIM)

    def band(t):
        t = t.reshape(b, s, B_KV_HEADS, B_HEAD_DIM)
        tp = jnp.pad(t, ((0, 0), (BLOCK, BLOCK), (0, 0), (0, 0)))
        tp = tp.reshape(b, nb + 2, BLOCK, B_KV_HEADS, B_HEAD_DIM)
        return jnp.concatenate([tp[:, :-2], tp[:, 1:-1], tp[:, 2:]], axis=2)

    kb, vb = band(k), band(v)
    scores = jnp.einsum("bnqkgd,bnskd->bnkgqs", q, kb,
                        preferred_element_type=jnp.float32) * (B_HEAD_DIM ** -0.5)
    qpos = jnp.arange(nb)[:, None, None] * BLOCK + jnp.arange(BLOCK)[None, :, None]
    kpos = (jnp.arange(nb)[:, None, None] - 1) * BLOCK + jnp.arange(3 * BLOCK)[None, None, :]
    dist = jnp.abs(qpos - kpos)
    valid = (dist <= WINDOW) & (kpos >= 0) & (kpos < s)
    slopes = alibi_slopes().reshape(B_KV_HEADS, B_Q_PER_KV)
    alibi = -slopes[None, :, :, None, None] * dist.astype(jnp.float32)[:, None, None]
    scores = jnp.where(valid[None, :, None, None], scores + alibi[None], NEG_INF)
    sink = jnp.broadcast_to(
        sinks.astype(jnp.float32).reshape(B_KV_HEADS, B_Q_PER_KV)[None, None, :, :, None, None],
        scores.shape[:-1] + (1,))
    p = jax.nn.softmax(jnp.concatenate([scores, sink], axis=-1), axis=-1)[..., :-1]
    o = jnp.einsum("bnkgqs,bnskd->bnqkgd", p.astype(vb.dtype), vb)
    return o.reshape(b, s, B_HEADS * B_HEAD_DIM) @ w_o


def fourier_mixer(h, w_in, w_out):
    b, s, _ = h.shape
    z = (h @ w_in).reshape(b, s, C_GROUPS, C_GROUP_DIM).astype(jnp.float32)
    f = jnp.real(jnp.fft.fft2(z, axes=(1, 3), norm="ortho")).astype(h.dtype)
    return f.reshape(b, s, C_WIDTH) @ w_out


def conv_gated_ffn(h, w_up, w_conv, b_conv, w_down):
    s = h.shape[1]
    up = h @ w_up
    p = jnp.pad(up, ((0, 0), (1, 1), (0, 0)))
    up = p[:, :s] * w_conv[0] + p[:, 1:s + 1] * w_conv[1] + p[:, 2:] * w_conv[2] + b_conv
    a, g = jnp.split(up, 2, axis=-1)
    return (a * jax.nn.silu(g)) @ w_down


def trunk(x, c, w_ada, b_ada, norm_g, a_w_in, a_g_v, a_w_s, a_b_s, a_w_out,
          b_w_qkv, b_sinks, b_w_o, c_w_in, c_w_out,
          f_w_up, f_w_conv, f_b_conv, f_w_down, g_final):
    cs = jax.nn.silu(c)
    for i in range(DEPTH):
        mod = cs @ w_ada[i] + b_ada[i]
        sh1, sc1, gt1, sh2, sc2, gt2 = jnp.split(mod[:, None, :], 6, axis=-1)
        h = rmsnorm(x, norm_g[i, 0]) * (1 + sc1) + sh1
        kind, j = i % N_MIXERS, i // N_MIXERS
        if kind == 0:
            m = gmlp_chunk_mixer(h, a_w_in[j], a_g_v[j], a_w_s[j], a_b_s[j], a_w_out[j])
        elif kind == 1:
            m = windowed_gqa_mixer(h, b_w_qkv[j], b_sinks[j], b_w_o[j])
        else:
            m = fourier_mixer(h, c_w_in[j], c_w_out[j])
        x = x + gt1 * m
        h = rmsnorm(x, norm_g[i, 1]) * (1 + sc2) + sh2
        x = x + gt2 * conv_gated_ffn(h, f_w_up[i], f_w_conv[i], f_b_conv[i], f_w_down[i])
    return rmsnorm(x, g_final)


def setup_inputs(seed: int = 0) -> dict:
    key = jax.random.key(seed)
    ks = jax.random.split(key, 24)
    D = D_MODEL
    f32 = jnp.float32

    def nrm(k, shape, scale):
        return jax.random.normal(k, shape, f32) * scale

    qkv_w = (B_HEADS + 2 * B_KV_HEADS) * B_HEAD_DIM
    conv_center = jnp.zeros((CONV_WIDTH, 1), f32).at[1].set(1.0)
    return {
        "x_prompt": nrm(ks[0], (BATCH, SEQ, D), 1.0),
        "x_sample": nrm(ks[1], (DEC_BATCH, DEC_SEQ, D), 1.0),
        "c_prompt": nrm(ks[2], (BATCH, D), 1.0),
        "c_sample": nrm(ks[3], (DEC_BATCH, D), 1.0),
        "w_ada": nrm(ks[4], (DEPTH, D, 6 * D), 0.5 * D ** -0.5),
        "b_ada": nrm(ks[5], (DEPTH, 6 * D), 0.01),
        "norm_g": 1.0 + nrm(ks[6], (DEPTH, 2, D), 0.05),
        "a_w_in": nrm(ks[7], (N_LAYERS_A, D, 2 * A_WIDTH), D ** -0.5),
        "a_g_v": 1.0 + nrm(ks[8], (N_LAYERS_A, A_WIDTH), 0.05),
        "a_w_s": nrm(ks[9], (N_LAYERS_A, A_GROUPS, CHUNK, CHUNK), CHUNK ** -0.5),
        "a_b_s": 1.0 + nrm(ks[10], (N_LAYERS_A, A_GROUPS, CHUNK), 0.1),
        "a_w_out": nrm(ks[11], (N_LAYERS_A, A_WIDTH, D), A_WIDTH ** -0.5),
        "b_w_qkv": nrm(ks[12], (N_LAYERS_B, D, qkv_w), D ** -0.5),
        "b_sinks": nrm(ks[13], (N_LAYERS_B, B_HEADS), 0.5),
        "b_w_o": nrm(ks[14], (N_LAYERS_B, B_HEADS * B_HEAD_DIM, D), (B_HEADS * B_HEAD_DIM) ** -0.5),
        "c_w_in": nrm(ks[15], (N_LAYERS_C, D, C_WIDTH), D ** -0.5),
        "c_w_out": nrm(ks[16], (N_LAYERS_C, C_WIDTH, D), C_WIDTH ** -0.5),
        "f_w_up": nrm(ks[17], (DEPTH, D, 2 * FF_DIM), D ** -0.5),
        "f_w_conv": conv_center[None] + nrm(ks[18], (DEPTH, CONV_WIDTH, 2 * FF_DIM), 0.2),
        "f_b_conv": nrm(ks[19], (DEPTH, 2 * FF_DIM), 0.01),
        "f_w_down": nrm(ks[20], (DEPTH, FF_DIM, D), FF_DIM ** -0.5),
        "g_final": 1.0 + nrm(ks[21], (D,), 0.05),
    }


def reference(x_prompt, x_sample, c_prompt, c_sample, w_ada, b_ada, norm_g,
              a_w_in, a_g_v, a_w_s, a_b_s, a_w_out, b_w_qkv, b_sinks, b_w_o,
              c_w_in, c_w_out, f_w_up, f_w_conv, f_b_conv, f_w_down, g_final):
    y_prompt = trunk(x_prompt, c_prompt, w_ada, b_ada, norm_g, a_w_in, a_g_v, a_w_s, a_b_s,
                     a_w_out, b_w_qkv, b_sinks, b_w_o, c_w_in, c_w_out,
                     f_w_up, f_w_conv, f_b_conv, f_w_down, g_final)
    y_sample = trunk(x_sample, c_sample, w_ada, b_ada, norm_g, a_w_in, a_g_v, a_w_s, a_b_s,
                     a_w_out, b_w_qkv, b_sinks, b_w_o, c_w_in, c_w_out,
                     f_w_up, f_w_conv, f_b_conv, f_w_down, g_final)
    return (y_prompt, y_sample)
```

```cpp
#include <hip/hip_runtime.h>
#include <hip/hip_cooperative_groups.h>
#include <cstdio>
namespace cg = cooperative_groups;

#define LAS __attribute__((address_space(3)))
typedef unsigned short bf16_t;
typedef short bf16x8 __attribute__((ext_vector_type(8)));
typedef short bf16x4 __attribute__((ext_vector_type(4)));
typedef float f32x4 __attribute__((ext_vector_type(4)));
typedef unsigned u32x4 __attribute__((ext_vector_type(4)));
typedef unsigned u32x2 __attribute__((ext_vector_type(2)));

constexpr int DM = 1024, MTOK = 32768, FFD = 2816, NUP = 5632, MODW = 6144;
constexpr float EPSN = 1e-6f;
constexpr int NTHR = 512;
constexpr int LDS_BYTES = 147456;

constexpr size_t al256(size_t x) { return (x + 255) & ~(size_t)255; }
constexpr size_t WS_SS = 0;
constexpr size_t SS_BYTES = (size_t)11 * MTOK * 4;
constexpr size_t WS_MOD = al256(WS_SS + SS_BYTES);
constexpr size_t WS_GS = al256(WS_MOD + (size_t)4 * 3 * MODW * 4);
constexpr size_t WS_BG1 = al256(WS_GS + (size_t)9 * 3 * DM * 4);
constexpr size_t WS_BUP = al256(WS_BG1 + (size_t)4 * 3 * 2048 * 4);
constexpr size_t WS_CW = al256(WS_BUP + (size_t)2 * 3 * NUP * 4);
constexpr size_t WS_TAB = al256(WS_CW + (size_t)4 * 4 * NUP * 4);
constexpr size_t TAB_CT64 = 0, TAB_ST64 = 8192, TAB_CT128 = 16384, TAB_ST128 = 16384 + 32768;
constexpr size_t WS_WF32 = al256(WS_TAB + 81920);
constexpr size_t WS_WAIN = al256(WS_WF32 + (size_t)2048 * 1024 * 4);
constexpr size_t WS_WAOUT = al256(WS_WAIN + (size_t)2 * 2048 * 1024 * 2);
constexpr size_t WS_WQKV = al256(WS_WAOUT + (size_t)2 * 1024 * 1024 * 2);
constexpr size_t WS_WO = al256(WS_WQKV + (size_t)1536 * 1024 * 2);
constexpr size_t WS_WCIN = al256(WS_WO + (size_t)1024 * 1024 * 2);
constexpr size_t WS_WF = al256(WS_WCIN + (size_t)1024 * 1024 * 2);
constexpr size_t WS_WUP = al256(WS_WF + (size_t)1024 * 2048 * 2);
constexpr size_t WS_WDN = al256(WS_WUP + (size_t)2 * NUP * 1024 * 2);
constexpr size_t WS_XB = al256(WS_WDN + (size_t)2 * 1024 * FFD * 2);
constexpr size_t WS_BIG1 = al256(WS_XB + (size_t)MTOK * DM * 2);
constexpr size_t WS_BIG2 = al256(WS_BIG1 + (size_t)MTOK * 2048 * 2);
constexpr size_t WS_ACT = WS_BIG1;
constexpr size_t WS_EDGE = al256(WS_ACT + (size_t)MTOK * FFD * 2);
constexpr size_t WS_END = al256(WS_BIG2 + (size_t)MTOK * 2048 * 2);
static_assert(WS_EDGE + (size_t)512 * 4 * NUP * 4 <= WS_END, "edge buffer must fit");

struct Params {
    const float* xp; const float* xs; const float* cp; const float* csm; const float* w_ada; const float* b_ada; const float* norm_g;
    const float* a_w_in; const float* a_g_v; const float* a_w_s; const float* a_b_s; const float* a_w_out;
    const float* b_w_qkv; const float* b_sinks; const float* b_w_o; const float* c_w_in; const float* c_w_out;
    const float* f_w_up; const float* f_w_conv; const float* f_b_conv; const float* f_w_down; const float* g_final;
    float* out; unsigned char* ws;
};

__device__ __forceinline__ int otid(int wv) { int t; asm volatile("v_mbcnt_lo_u32_b32 %0, -1, 0\n\tv_mbcnt_hi_u32_b32 %0, -1, %0\n\tv_lshl_add_u32 %0, %1, 6, %0" : "=&v"(t) : "s"(wv)); return t; }
typedef __bf16 bf2_t __attribute__((ext_vector_type(2)));
typedef float f2_t __attribute__((ext_vector_type(2)));
__device__ __forceinline__ unsigned cvt_pk_bf16_asm(float lo, float hi) { unsigned r; asm volatile("v_cvt_pk_bf16_f32 %0, %1, %2" : "=v"(r) : "v"(lo), "v"(hi)); return r; }
__device__ __forceinline__ unsigned cvt_pk_bf16(float lo, float hi) { const f2_t v = {lo, hi}; const bf2_t b = __builtin_convertvector(v, bf2_t); return __builtin_bit_cast(unsigned, b); }
__device__ __forceinline__ bf16_t f2bf(float f) { return (bf16_t)(cvt_pk_bf16(f, 0.f) & 0xffffu); }
__device__ __forceinline__ int seq_of_row(int r) { return r < 8192 ? 0 : (r < 16384 ? 1 : 2); }
__device__ __forceinline__ int upcol(int n) { return (n >> 8) * 128 + (n & 127) + ((n & 128) ? FFD : 0); }

namespace pg8 {
constexpr int BM = 256, BK = 64, HALF = 128, HTB = HALF * BK * 2, STAGE_BYTES = 8 * HTB, NXCD = 8, WGM = 8;
__device__ __forceinline__ int lds_byte(int r, int c) { const int st = (r >> 4) * 2 + (c >> 5), rr = r & 15, cc = c & 31, ob = rr * 64 + cc * 2; return st * 1024 + (ob ^ (((ob >> 9) & 1) << 5)); }
__device__ __forceinline__ void stage_rc(int b, int& R, int& C) { const int st = b / 1024, sb = b % 1024, swz = sb ^ (((sb >> 9) & 1) << 5); R = (st >> 1) * 16 + swz / 64; C = (st & 1) * 32 + (swz % 64) / 2; }
__device__ __forceinline__ int perm32(int rho) { const int n = rho >> 4, i = rho & 15; return 8 * (i >> 2) + 4 * n + (i & 3); }
struct Unit { int pm, pn; };
struct Gemm { const bf16_t* A; const bf16_t* Bt; int M, N, K, lda; };
struct StaticOrder {
    int nM, nN, nwg, G, c;
    __device__ void init(int M, int N, int G_, int c_) { nM = M / BM; nN = N / BM; nwg = nM * nN; G = G_; c = c_; }
    __device__ bool next(int i, Unit& u) const {
        const long L = (long)i * G + c; if (L >= nwg) return false;
        int wgid = (int)L; { const int q = nwg / NXCD, r = nwg % NXCD, xcd = wgid % NXCD, off = wgid / NXCD; wgid = (xcd < r ? xcd * (q + 1) : r * (q + 1) + (xcd - r) * q) + off; }
        const int nig = WGM * nN, gid = wgid / nig, fm = gid * WGM, gsz = (nM - fm) < WGM ? (nM - fm) : WGM;
        u.pm = fm + ((wgid % nig) % gsz); u.pn = (wgid % nig) / gsz; return true;
    }
};

template <class Epi>
__device__ __forceinline__ void gemm_phase(int wv, LAS unsigned char* lds, const Gemm g, const StaticOrder& S, const Epi& E) {
    const int tid = otid(wv), wid = __builtin_amdgcn_readfirstlane(tid >> 6), lane = tid & 63, wr = wid >> 2, wc = wid & 3, fr = lane & 15, fq = lane >> 4;
    const int K = g.K, nt = K / BK, lda = g.lda;
    unsigned voffA[2], voffB[2];
#pragma unroll
    for (int i = 0; i < 2; ++i) { int R, C; stage_rc(tid * 16 + i * 8192, R, C); const int Rb = Epi::PERM ? ((R & ~31) + perm32(R & 31)) : R;
        voffA[i] = (unsigned)(R * lda + C) * 2u; voffB[i] = (unsigned)(Rb * K + C) * 2u; }
    const size_t kstep = (size_t)(BK * 2);
    const size_t hstepA = (size_t)HALF * lda * 2, hstepB = (size_t)HALF * K * 2;
    const size_t tstepA = 2 * hstepA, tstepB = 2 * hstepB;
    const unsigned ldsw = (unsigned)wid * 1024u;
    const int aoff = lds_byte(wr * 64 + fr, fq * 8), boff = lds_byte(wc * 32 + fr, fq * 8);
#define PG8_SA(b, h) (((b) * 2 + (h)) * HTB)
#define PG8_SB(b, h) ((4 + (b) * 2 + (h)) * HTB)
#define PG8_STAGE(bufoff, gbase, voff) do { _Pragma("unroll") for (int _i = 0; _i < 2; ++_i) \
        __builtin_amdgcn_global_load_lds((const unsigned*)((const char*)(gbase) + (voff)[_i]), (LAS unsigned*)(lds + (bufoff) + ldsw + _i * 8192), 16, 0, 0); } while (0)
#define PG8_LDA(dst, b, h) do { _Pragma("unroll") for (int m = 0; m < 4; ++m) _Pragma("unroll") for (int k = 0; k < 2; ++k) dst[m][k] = *(const LAS bf16x8*)(lds + PG8_SA(b, h) + aoff + m * 2048 + k * 1024); } while (0)
#define PG8_LDB(dst, b, h) do { _Pragma("unroll") for (int n = 0; n < 2; ++n) _Pragma("unroll") for (int k = 0; k < 2; ++k) dst[n][k] = *(const LAS bf16x8*)(lds + PG8_SB(b, h) + boff + n * 2048 + k * 1024); } while (0)
#define PG8_MMA(ai, bj, At, Bt) do { __builtin_amdgcn_s_setprio(1); _Pragma("unroll") for (int m = 0; m < 4; ++m) _Pragma("unroll") for (int n = 0; n < 2; ++n) _Pragma("unroll") for (int k = 0; k < 2; ++k) \
        acc[ai][bj][m][n] = __builtin_amdgcn_mfma_f32_16x16x32_bf16(Bt[n][k], At[m][k], acc[ai][bj][m][n], 0, 0, 0); __builtin_amdgcn_s_setprio(0); } while (0)
#define PG8_WAIT_V(n) asm volatile("s_waitcnt vmcnt(" #n ")" ::: "memory")
#define PG8_WAIT_L(n) asm volatile("s_waitcnt lgkmcnt(" #n ")" ::: "memory")
#define PG8_BAR __builtin_amdgcn_s_barrier()
#define PG8_SCHED __builtin_amdgcn_sched_barrier(0)
    Unit cur, nxt; int ui = 0;
    if (!S.next(0, cur)) return;
    f32x4 acc[2][2][4][2];
#pragma unroll
    for (int a = 0; a < 2; ++a)
#pragma unroll
        for (int b = 0; b < 2; ++b)
#pragma unroll
            for (int m = 0; m < 4; ++m)
#pragma unroll
                for (int n = 0; n < 2; ++n) acc[a][b][m][n] = (f32x4){0.f, 0.f, 0.f, 0.f};
    bf16x8 At[4][2], B0[2][2], B1[2][2];
    const char* cA = (const char*)g.A + (size_t)cur.pm * tstepA; const char* cB = (const char*)g.Bt + (size_t)cur.pn * tstepB;
    PG8_STAGE(PG8_SB(0, 0), cB, voffB); PG8_STAGE(PG8_SA(0, 0), cA, voffA); PG8_STAGE(PG8_SB(0, 1), cB + hstepB, voffB); PG8_STAGE(PG8_SA(0, 1), cA + hstepA, voffA);
    if (wr == 1) PG8_BAR;
    PG8_WAIT_V(4); PG8_BAR;
    PG8_STAGE(PG8_SB(1, 0), cB + kstep, voffB); PG8_STAGE(PG8_SA(1, 0), cA + kstep, voffA); PG8_STAGE(PG8_SB(1, 1), cB + hstepB + kstep, voffB);
    PG8_WAIT_V(6); PG8_BAR;
    for (;;) {
        const bool has_next = S.next(ui + 1, nxt);
        const char* nA = has_next ? (const char*)g.A + (size_t)nxt.pm * tstepA : cA; const char* nB = has_next ? (const char*)g.Bt + (size_t)nxt.pn * tstepB : cB;
        for (int t = 0; t < nt; t += 2) {
            const bool last = (t == nt - 2);
            const char* a1 = cA + (size_t)(t + 1) * kstep;
            const char* a2 = last ? nA : cA + (size_t)(t + 2) * kstep; const char* b2 = last ? nB : cB + (size_t)(t + 2) * kstep;
            const char* a3 = a2 + kstep; const char* b3 = b2 + kstep;
            PG8_LDB(B0, 0, 0); PG8_SCHED; PG8_LDA(At, 0, 0); PG8_STAGE(PG8_SA(1, 1), a1 + hstepA, voffA);
            PG8_WAIT_L(8); PG8_BAR; PG8_WAIT_L(0); PG8_MMA(0, 0, At, B0); PG8_BAR; PG8_SCHED;
            PG8_LDB(B1, 0, 1); PG8_STAGE(PG8_SB(0, 0), b2, voffB);
            PG8_BAR; PG8_WAIT_L(0); PG8_MMA(0, 1, At, B1); PG8_BAR;
            PG8_LDA(At, 0, 1); PG8_STAGE(PG8_SA(0, 0), a2, voffA);
            PG8_BAR; PG8_WAIT_L(0); PG8_MMA(1, 0, At, B0); PG8_BAR; PG8_SCHED;
            PG8_STAGE(PG8_SB(0, 1), b2 + hstepB, voffB);
            PG8_WAIT_V(6); PG8_BAR; PG8_MMA(1, 1, At, B1); PG8_BAR;
            PG8_LDB(B0, 1, 0); PG8_SCHED; PG8_LDA(At, 1, 0); PG8_STAGE(PG8_SA(0, 1), a2 + hstepA, voffA);
            PG8_WAIT_L(8); PG8_BAR; PG8_WAIT_L(0); PG8_MMA(0, 0, At, B0); PG8_BAR; PG8_SCHED;
            PG8_LDB(B1, 1, 1); PG8_STAGE(PG8_SB(1, 0), b3, voffB);
            PG8_BAR; PG8_WAIT_L(0); PG8_MMA(0, 1, At, B1); PG8_BAR;
            PG8_LDA(At, 1, 1); PG8_STAGE(PG8_SA(1, 0), a3, voffA);
            PG8_BAR; PG8_WAIT_L(0); PG8_MMA(1, 0, At, B0); PG8_BAR; PG8_SCHED;
            PG8_STAGE(PG8_SB(1, 1), b3 + hstepB, voffB);
            PG8_WAIT_V(6); PG8_BAR; PG8_MMA(1, 1, At, B1); PG8_BAR;
        }
        E(acc, cur, wr, wc, fr, fq);
        if (!has_next) break;
#pragma unroll
        for (int a = 0; a < 2; ++a)
#pragma unroll
            for (int b = 0; b < 2; ++b)
#pragma unroll
                for (int m = 0; m < 4; ++m)
#pragma unroll
                    for (int n = 0; n < 2; ++n) acc[a][b][m][n] = (f32x4){0.f, 0.f, 0.f, 0.f};
        cur = nxt; cA = nA; cB = nB; ++ui;
    }
    PG8_WAIT_V(0);
    if (wr == 0) PG8_BAR;
    PG8_BAR;
#undef PG8_SA
#undef PG8_SB
#undef PG8_STAGE
#undef PG8_LDA
#undef PG8_LDB
#undef PG8_MMA
#undef PG8_WAIT_V
#undef PG8_WAIT_L
#undef PG8_BAR
#undef PG8_SCHED
}

typedef float f32x2 __attribute__((ext_vector_type(2)));
__device__ __forceinline__ f32x2 gelu_pk(f32x2 v) {
    const f32x2 av = __builtin_elementwise_abs(v), d = av * 0.2316418882f + 1.0f;
    f32x2 t; t.x = __builtin_amdgcn_rcpf(d.x); t.y = __builtin_amdgcn_rcpf(d.y);
    f32x2 q = t * 0.5307027145f + (-0.7265760135f); q = q * t + 0.7107068705f; q = q * t + (-0.142248368f); q = q * t + 0.127414796f; q = q * t;
    const f32x2 s = (v * v) * (-0.72134752044f);
    f32x2 e; e.x = __builtin_amdgcn_exp2f(s.x); e.y = __builtin_amdgcn_exp2f(s.y);
    const f32x2 m = v * (q * e), r = v - m;
    f32x2 o; o.x = v.x < 0.f ? m.x : r.x; o.y = v.y < 0.f ? m.y : r.y; return o;
}
__device__ __forceinline__ f32x4 gelu4(f32x4 v) { f32x2 a = gelu_pk((f32x2){v[0], v[1]}), b = gelu_pk((f32x2){v[2], v[3]}); return (f32x4){a.x, a.y, b.x, b.y}; }

template <int ACT> struct EpiAct {
    static constexpr bool PERM = true;
    bf16_t* O; int ldc; const float* bias; int nb; const float* ssin; float* vss; int vcol0;
    __device__ __forceinline__ void operator()(const f32x4 (&acc)[2][2][4][2], const Unit& u, int wr, int wc, int fr, int fq) const {
        asm volatile("" : "+v"(fr), "+v"(fq));
        const int row0 = u.pm * BM + wr * 64 + fr, col0 = u.pn * BM + wc * 32 + 8 * fq;
        const int seq = seq_of_row(u.pm * BM);
        const float* bp = bias + (size_t)seq * nb + col0;
        const bool dov = (ACT == 1) && (u.pn * BM >= vcol0);
#pragma unroll
        for (int ai = 0; ai < 2; ++ai)
#pragma unroll
            for (int m = 0; m < 4; ++m) {
                const int r = row0 + ai * HALF + m * 16;
                const float rs = __builtin_amdgcn_rsqf(ssin[r] * (1.0f / DM) + EPSN);
                bf16_t* rowp = O + (size_t)r * ldc + col0; float s = 0.f;
#pragma unroll
                for (int bj = 0; bj < 2; ++bj) { f32x4 v0 = acc[ai][bj][m][0] * rs + *(const f32x4*)(bp + bj * HALF), v1 = acc[ai][bj][m][1] * rs + *(const f32x4*)(bp + bj * HALF + 4);
                    if (ACT == 1) { v0 = gelu4(v0); v1 = gelu4(v1); s += (v0[0] * v0[0] + v0[1] * v0[1]) + (v0[2] * v0[2] + v0[3] * v0[3]) + (v1[0] * v1[0] + v1[1] * v1[1]) + (v1[2] * v1[2] + v1[3] * v1[3]); }
                    u32x4 w; w.x = cvt_pk_bf16_asm(v0[0], v0[1]); w.y = cvt_pk_bf16_asm(v0[2], v0[3]); w.z = cvt_pk_bf16_asm(v1[0], v1[1]); w.w = cvt_pk_bf16_asm(v1[2], v1[3]);
                    *(u32x4*)(rowp + bj * HALF) = w; }
                if (ACT == 1) { s += __shfl_xor(s, 16); s += __shfl_xor(s, 32); if (dov && fq == 0) atomicAdd(vss + r, s); }
                asm volatile("" ::: "memory");
            }
    }
};

struct EpiRes {
    static constexpr bool PERM = false;
    const float* base0; const float* base1; float* xout; const float* gate; const float* gs; bf16_t* xb; float* ssn;
    __device__ __forceinline__ void operator()(const f32x4 (&acc)[2][2][4][2], const Unit& u, int wr, int wc, int fr, int fq) const {
        asm volatile("" : "+v"(fr), "+v"(fq));
        const int row0 = u.pm * BM + wr * 64 + fr, col0 = u.pn * BM + wc * 32 + 4 * fq;
        const int seq = seq_of_row(u.pm * BM);
        const float* gp = gate + (size_t)seq * MODW + col0; const float* gsp = gs + (size_t)seq * DM + col0;
#pragma unroll
        for (int ai = 0; ai < 2; ++ai)
#pragma unroll
            for (int m = 0; m < 4; ++m) {
                const int r = row0 + ai * HALF + m * 16;
                const float* bp = (r < 16384 ? base0 + (size_t)r * DM : base1 + (size_t)(r - 16384) * DM) + col0;
                float* op = xout + (size_t)r * DM + col0; float s = 0.f;
#pragma unroll
                for (int bj = 0; bj < 2; ++bj)
#pragma unroll
                    for (int n = 0; n < 2; ++n) { const f32x4 xo = *(const f32x4*)(bp + bj * HALF + n * 16); const f32x4 xn = xo + *(const f32x4*)(gp + bj * HALF + n * 16) * acc[ai][bj][m][n];
                        *(f32x4*)(op + bj * HALF + n * 16) = xn; s += (xn[0] * xn[0] + xn[1] * xn[1]) + (xn[2] * xn[2] + xn[3] * xn[3]);
                        if (xb) { const f32x4 g4 = *(const f32x4*)(gsp + bj * HALF + n * 16); const f32x4 h = xn * g4; u32x2 w; w.x = cvt_pk_bf16_asm(h[0], h[1]); w.y = cvt_pk_bf16_asm(h[2], h[3]);
                            *(u32x2*)(xb + (size_t)r * DM + col0 + bj * HALF + n * 16) = w; } }
                s += __shfl_xor(s, 16); s += __shfl_xor(s, 32); if (fq == 0) atomicAdd(ssn + r, s);
                asm volatile("" ::: "memory");
            }
    }
};

struct EpiUp {
    static constexpr bool PERM = true;
    bf16_t* act; const float* bias; const float* cw; const float* ssin; float* edge;
    __device__ __forceinline__ void operator()(const f32x4 (&acc)[2][2][4][2], const Unit& u, int wr, int wc, int fr, int fq) const {
        asm volatile("" : "+v"(fr), "+v"(fq));
        const int lane = fq * 16 + fr;
        const int row0 = u.pm * BM + wr * 64 + fr, colt = u.pn * BM + wc * 32 + 8 * fq;
        const int seq = seq_of_row(u.pm * BM);
        const int lprev = (lane & 48) | ((lane - 1) & 15), lnext = (lane & 48) | ((lane + 1) & 15);
        const float* biasp = bias + (size_t)seq * NUP + colt; const float* cwp = cw + colt;
#pragma unroll
        for (int ai = 0; ai < 2; ++ai) {
            float rs[4];
#pragma unroll
            for (int m = 0; m < 4; ++m) rs[m] = __builtin_amdgcn_rsqf(ssin[row0 + ai * HALF + m * 16] * (1.0f / DM) + EPSN);
            float* ep = edge + (size_t)(u.pm * 4 + ai * 2 + wr) * 4 * NUP + colt;
#pragma unroll
            for (int n = 0; n < 2; ++n) {
                f32x4 SG[4];
#pragma unroll
                for (int bjr = 0; bjr < 2; ++bjr) { const int bj = 1 - bjr; const int co = bj * HALF + 4 * n;
                    const f32x4 b4 = *(const f32x4*)(biasp + co); f32x4 U[4];
#pragma unroll
                    for (int m = 0; m < 4; ++m) U[m] = acc[ai][bj][m][n] * rs[m] + b4;
                    if (fr < 2) *(f32x4*)(ep + (size_t)fr * NUP + co) = U[0];
                    if (fr >= 14) *(f32x4*)(ep + (size_t)(fr - 12) * NUP + co) = U[3];
                    const f32x4 w0 = *(const f32x4*)(cwp + co), w1 = *(const f32x4*)(cwp + NUP + co), w2 = *(const f32x4*)(cwp + 2 * NUP + co), bc = *(const f32x4*)(cwp + 3 * NUP + co);
#pragma unroll
                    for (int m = 0; m < 4; ++m) { const f32x4 sp = (fr == 15 && m > 0) ? U[m > 0 ? m - 1 : 0] : U[m]; const f32x4 sn = (fr == 0 && m < 3) ? U[m < 3 ? m + 1 : 3] : U[m];
                        f32x4 pv, nv;
#pragma unroll
                        for (int j = 0; j < 4; ++j) { pv[j] = __shfl(sp[j], lprev); nv[j] = __shfl(sn[j], lnext); }
                        const f32x4 R = w0 * pv + w1 * U[m] + w2 * nv + bc;
                        if (bj == 1) {
#pragma unroll
                            for (int j = 0; j < 4; ++j) SG[m][j] = R[j] * __builtin_amdgcn_rcpf(1.0f + __expf(-R[j])); }
                        else { const int r = row0 + ai * HALF + m * 16; const bool skip = (m == 0 && fr == 0) || (m == 3 && fr == 15);
                            const f32x4 o = R * SG[m]; u32x2 w; w.x = cvt_pk_bf16_asm(o[0], o[1]); w.y = cvt_pk_bf16_asm(o[2], o[3]);
                            if (!skip) *(u32x2*)(act + (size_t)r * FFD + u.pn * 128 + wc * 32 + 8 * fq + 4 * n) = w; } }
                    asm volatile("" ::: "memory"); }
                asm volatile("" ::: "memory");
            } }
    }
};
}

__device__ __forceinline__ float silu_f(float x) { return x / (1.0f + __expf(-x)); }

__device__ void mod_task(int wv, const Params& p, int tk, float* ldsf) {
    const int tid = otid(wv), i = tk / 48, cgp = tk % 48;
    float* csL = ldsf; float* red = ldsf + 3072;
    for (int idx = tid; idx < 3072; idx += NTHR) { const int seq = idx >> 10, k = idx & 1023; const float c = seq < 2 ? p.cp[seq * DM + k] : p.csm[k]; csL[idx] = silu_f(c); }
    __syncthreads();
    const int quad = tid & 31, ksl = tid >> 5;
    const float* W = p.w_ada + (size_t)i * DM * MODW + (size_t)ksl * 64 * MODW + 128 * cgp + 4 * quad;
    f32x4 a0 = {0, 0, 0, 0}, a1 = {0, 0, 0, 0}, a2 = {0, 0, 0, 0};
#pragma unroll 8
    for (int kk = 0; kk < 64; ++kk) { const f32x4 w = *(const f32x4*)(W + (size_t)kk * MODW); const int k = ksl * 64 + kk;
        a0 += w * csL[k]; a1 += w * csL[1024 + k]; a2 += w * csL[2048 + k]; }
    float* rp = red + (ksl * 32 + quad) * 12;
    *(f32x4*)(rp) = a0; *(f32x4*)(rp + 4) = a1; *(f32x4*)(rp + 8) = a2;
    __syncthreads();
    if (tid < 384) { const int q = tid & 31, e = tid >> 5; float s = 0.f;
        for (int k = 0; k < 16; ++k) s += red[(k * 32 + q) * 12 + e];
        const int seq = e >> 2, col = 128 * cgp + 4 * q + (e & 3);
        float* mod = (float*)(p.ws + WS_MOD);
        mod[((size_t)i * 3 + seq) * MODW + col] = s + p.b_ada[i * MODW + col]; }
    __syncthreads();
}

__device__ void wf_task(int wv, const Params& p, int task, float* ldsf) {
    const int tid = otid(wv), g = task >> 4, n0 = (task & 15) * 64;
    float* tile = ldsf; float* ct = ldsf + 128 * 64;
    for (int idx = tid; idx < 128 * 16; idx += NTHR) { const int cp_ = idx >> 4, n4 = (idx & 15) * 4;
        *(f32x4*)(tile + cp_ * 64 + n4) = *(const f32x4*)(p.c_w_out + (size_t)(g * 128 + cp_) * DM + n0 + n4); }
    if (tid < 128) ct[tid] = cospif(2.0f * tid / 128.0f) * 0.08838834764831845f;
    __syncthreads();
    const int n = tid & 63, wvl = __builtin_amdgcn_readfirstlane(tid >> 6);
    float ac[16], as[16];
#pragma unroll
    for (int c = 0; c < 16; ++c) { ac[c] = 0.f; as[c] = 0.f; }
    for (int cq = 0; cq < 128; ++cq) { const float v = tile[cq * 64 + n];
#pragma unroll
        for (int cc = 0; cc < 16; ++cc) { const int idx = ((wvl * 16 + cc) * cq) & 127; ac[cc] += ct[idx] * v; as[cc] += ct[(idx + 96) & 127] * v; } }
    float* Wf = (float*)(p.ws + WS_WF32);
#pragma unroll
    for (int cc = 0; cc < 16; ++cc) { const int c = wvl * 16 + cc; Wf[(size_t)(g * 128 + c) * DM + n0 + n] = ac[cc]; Wf[(size_t)(1024 + g * 128 + c) * DM + n0 + n] = as[cc]; }
    __syncthreads();
}

__device__ void convert_matrix(int wv, const float* src, int K, int N, int ld, int perm, bf16_t* dst, float* tileL, int rot) {
    const int tid = otid(wv), G = gridDim.x, ntk = K >> 6, ntiles = ntk * (N >> 6);
    for (int t = (blockIdx.x + rot) % G; t < ntiles; t += G) {
        const int k0 = (t % ntk) * 64, n0 = (t / ntk) * 64, sc0 = perm ? upcol(n0) : n0;
#pragma unroll
        for (int ps = 0; ps < 2; ++ps) { const int idx = tid + ps * NTHR, kk = idx >> 4, n4 = (idx & 15) * 4;
            const f32x4 v = *(const f32x4*)(src + (size_t)(k0 + kk) * ld + sc0 + n4);
            float* tp = tileL + kk * 65 + n4; tp[0] = v[0]; tp[1] = v[1]; tp[2] = v[2]; tp[3] = v[3]; }
        __syncthreads();
        { const int n = tid >> 3, k8 = (tid & 7) * 8; float e[8];
#pragma unroll
            for (int j = 0; j < 8; ++j) e[j] = tileL[(k8 + j) * 65 + n];
            u32x4 w; w.x = cvt_pk_bf16(e[0], e[1]); w.y = cvt_pk_bf16(e[2], e[3]); w.z = cvt_pk_bf16(e[4], e[5]); w.w = cvt_pk_bf16(e[6], e[7]);
            *(u32x4*)(dst + (size_t)(n0 + n) * K + k0 + k8) = w; }
        __syncthreads();
    }
}

__device__ void bias_task(int wv, const float* W, int ld, int perm, const float* sh, float* bias, int nb, int grp, float* red) {
    const int tid = otid(wv), quad = tid & 63, ksl = __builtin_amdgcn_readfirstlane(tid >> 6);
    const int nn = 256 * grp + 4 * quad, sc = perm ? upcol(nn) : nn;
    f32x4 a0 = {0, 0, 0, 0}, a1 = {0, 0, 0, 0}, a2 = {0, 0, 0, 0};
    const float* wp = W + (size_t)ksl * 128 * ld + sc; const float* s0 = sh + ksl * 128;
#pragma unroll 8
    for (int kk = 0; kk < 128; ++kk) { const f32x4 w = *(const f32x4*)(wp + (size_t)kk * ld); a0 += w * s0[kk]; a1 += w * s0[MODW + kk]; a2 += w * s0[2 * MODW + kk]; }
    float* rp = red + (ksl * 64 + quad) * 12;
    *(f32x4*)(rp) = a0; *(f32x4*)(rp + 4) = a1; *(f32x4*)(rp + 8) = a2;
    __syncthreads();
    for (int idx = tid; idx < 768; idx += NTHR) { const int q = idx & 63, e = idx >> 6; float s = 0.f;
        for (int k = 0; k < 8; ++k) s += red[(k * 64 + q) * 12 + e];
        bias[(size_t)(e >> 2) * nb + 256 * grp + 4 * q + (e & 3)] = s; }
    __syncthreads();
}

__device__ __forceinline__ f32x4 mfma16(bf16x8 a, bf16x8 b, f32x4 c) { return __builtin_amdgcn_mfma_f32_16x16x32_bf16(a, b, c, 0, 0, 0); }

__device__ void sg_phase(int wv, const Params& p, int jl, unsigned char* lds) {
    const int tid = otid(wv), lane = tid & 63, w = __builtin_amdgcn_readfirstlane(tid >> 6), lr = lane & 15, lq = lane >> 4;
    bf16_t* uv = (bf16_t*)(p.ws + WS_BIG1);
    const float* vss = (const float*)(p.ws + WS_SS) + (size_t)(9 + jl) * MTOK;
    constexpr int PW = 136;
    bf16_t* WsL = (bf16_t*)lds; bf16_t* VTL = WsL + 128 * PW; float* rsL = (float*)(VTL + 128 * PW);
    for (int unit = blockIdx.x; unit < 2048; unit += gridDim.x) {
        const int ch = unit >> 3, g = unit & 7, t0 = ch * 128;
        if (tid < 128) rsL[tid] = 1.0f / sqrtf(vss[t0 + tid] * (1.0f / DM) + EPSN);
        __syncthreads();
        const float* ws = p.a_w_s + ((size_t)jl * 8 + g) * 128 * 128;
#pragma unroll
        for (int ps = 0; ps < 8; ++ps) { const int idx = tid + ps * NTHR, t = idx >> 5, s4 = (idx & 31) * 4;
            const f32x4 wv = *(const f32x4*)(ws + t * 128 + s4); const f32x4 r4 = *(const f32x4*)(rsL + s4); const f32x4 x = wv * r4;
            u32x2 pk; pk.x = cvt_pk_bf16(x[0], x[1]); pk.y = cvt_pk_bf16(x[2], x[3]); *(u32x2*)(WsL + t * PW + s4) = pk; }
#pragma unroll
        for (int ps = 0; ps < 4; ++ps) { const int idx = tid + ps * NTHR, s = idx >> 4, d8 = (idx & 15) * 8;
            const bf16x8 v = *(const bf16x8*)(uv + (size_t)(t0 + s) * 2048 + 1024 + g * 128 + d8);
#pragma unroll
            for (int e = 0; e < 8; ++e) VTL[(d8 + e) * PW + s] = (bf16_t)v[e]; }
        __syncthreads();
        bf16x8 af[4];
#pragma unroll
        for (int kk = 0; kk < 4; ++kk) af[kk] = *(const bf16x8*)(WsL + (16 * w + lr) * PW + 32 * kk + 8 * lq);
        const int tok = t0 + 16 * w + lr; const float bs = p.a_b_s[((size_t)jl * 8 + g) * 128 + 16 * w + lr];
#pragma unroll
        for (int db = 0; db < 8; ++db) { f32x4 acc = {0, 0, 0, 0};
#pragma unroll
            for (int kk = 0; kk < 4; ++kk) { const bf16x8 bf = *(const bf16x8*)(VTL + (16 * db + lr) * PW + 32 * kk + 8 * lq); acc = mfma16(bf, af[kk], acc); }
            const int col = g * 128 + 16 * db + 4 * lq; const f32x4 gv = *(const f32x4*)(p.a_g_v + jl * DM + col);
            bf16_t* up = uv + (size_t)tok * 2048 + col; const u32x2 uu = *(const u32x2*)up;
            const float u0 = __uint_as_float(uu.x << 16), u1 = __uint_as_float(uu.x & 0xffff0000u), u2 = __uint_as_float(uu.y << 16), u3 = __uint_as_float(uu.y & 0xffff0000u);
            const f32x4 sv = acc * gv + bs; u32x2 o; o.x = cvt_pk_bf16(u0 * sv[0], u1 * sv[1]); o.y = cvt_pk_bf16(u2 * sv[2], u3 * sv[3]);
            *(u32x2*)up = o; }
        __syncthreads();
    }
}

__device__ void att_phase(int wv, const Params& p, unsigned char* lds) {
    const int tid = otid(wv), lane = tid & 63, w = __builtin_amdgcn_readfirstlane(tid >> 6), lr = lane & 15, lq = lane >> 4;
    bf16_t* qkv = (bf16_t*)(p.ws + WS_BIG1);
    constexpr int KP = 72, VP = 392;
    bf16_t* KL = (bf16_t*)lds; bf16_t* VTL = KL + 384 * KP;
    for (int unit = blockIdx.x; unit < 1024; unit += gridDim.x) {
        const int B = unit >> 2, kh = unit & 3;
        const int sb = B < 64 ? 0 : (B < 128 ? 64 : 128), se = B < 64 ? 64 : (B < 128 ? 128 : 256);
#pragma unroll
        for (int ps = 0; ps < 6; ++ps) { const int idx = tid + ps * NTHR, s = idx >> 3, c8 = (idx & 7) * 8; const int kb = B - 1 + (s >> 7);
            bf16x8 kv = {0, 0, 0, 0, 0, 0, 0, 0}, vv = {0, 0, 0, 0, 0, 0, 0, 0};
            if (kb >= sb && kb < se) { const bf16_t* rp = qkv + (size_t)(kb * 128 + (s & 127)) * 1536 + 64 * kh + c8; kv = *(const bf16x8*)(rp + 1024); vv = *(const bf16x8*)(rp + 1280); }
            *(bf16x8*)(KL + s * KP + c8) = kv;
#pragma unroll
            for (int e = 0; e < 8; ++e) VTL[(c8 + e) * VP + s] = (bf16_t)vv[e]; }
        __syncthreads();
        const int gq = w >> 1, h = 4 * kh + gq;
        const float slope = exp2f(-0.5f * (float)(h + 1)), sink = p.b_sinks[h];
        for (int rb = 0; rb < 4; ++rb) {
            const int qrow = 64 * (w & 1) + 16 * rb + lr;
            const size_t tokq = (size_t)B * 128 + qrow;
            bf16x8 qf[2];
#pragma unroll
            for (int kk = 0; kk < 2; ++kk) qf[kk] = *(const bf16x8*)(qkv + tokq * 1536 + 64 * h + 32 * kk + 8 * lq);
            f32x4 sc[24];
#pragma unroll
            for (int cb = 0; cb < 24; ++cb) { f32x4 a = {0, 0, 0, 0};
#pragma unroll
                for (int kk = 0; kk < 2; ++kk) { const bf16x8 kf = *(const bf16x8*)(KL + (16 * cb + lr) * KP + 32 * kk + 8 * lq); a = mfma16(kf, qf[kk], a); }
                sc[cb] = a; }
            float mx = sink;
#pragma unroll
            for (int cb = 0; cb < 24; ++cb) { const int kb = B - 1 + (cb >> 3); const bool bval = (kb >= sb && kb < se);
#pragma unroll
                for (int j = 0; j < 4; ++j) { const int krel = 16 * cb + 4 * lq + j - 128;
                    int dist = qrow - krel; dist = dist < 0 ? -dist : dist;
                    const float v = (bval && dist <= 128) ? sc[cb][j] * 0.125f - slope * (float)dist : -1e30f;
                    sc[cb][j] = v; mx = fmaxf(mx, v); } }
            mx = fmaxf(mx, __shfl_xor(mx, 16)); mx = fmaxf(mx, __shfl_xor(mx, 32));
            float sum = 0.f;
#pragma unroll
            for (int cb = 0; cb < 24; ++cb)
#pragma unroll
                for (int j = 0; j < 4; ++j) { const float e = __expf(sc[cb][j] - mx); sc[cb][j] = e; sum += e; }
            sum += __shfl_xor(sum, 16); sum += __shfl_xor(sum, 32);
            sum += __expf(sink - mx);
            const float inv = 1.0f / sum;
            f32x4 oa[4];
#pragma unroll
            for (int db = 0; db < 4; ++db) oa[db] = (f32x4){0, 0, 0, 0};
#pragma unroll
            for (int ks = 0; ks < 12; ++ks) {
                union { bf16x8 v; unsigned u[4]; } pf;
                pf.u[0] = cvt_pk_bf16_asm(sc[2 * ks][0], sc[2 * ks][1]); pf.u[1] = cvt_pk_bf16_asm(sc[2 * ks][2], sc[2 * ks][3]);
                pf.u[2] = cvt_pk_bf16_asm(sc[2 * ks + 1][0], sc[2 * ks + 1][1]); pf.u[3] = cvt_pk_bf16_asm(sc[2 * ks + 1][2], sc[2 * ks + 1][3]);
#pragma unroll
                for (int db = 0; db < 4; ++db) {
                    union { bf16x8 v; u32x2 h2[2]; } vf;
                    const bf16_t* vp = VTL + (16 * db + lr) * VP + 32 * ks + 4 * lq;
                    vf.h2[0] = *(const u32x2*)vp; vf.h2[1] = *(const u32x2*)(vp + 16);
                    oa[db] = mfma16(vf.v, pf.v, oa[db]); } }
#pragma unroll
            for (int db = 0; db < 4; ++db) { const f32x4 o = oa[db] * inv; u32x2 wv; wv.x = cvt_pk_bf16_asm(o[0], o[1]); wv.y = cvt_pk_bf16_asm(o[2], o[3]);
                *(u32x2*)(qkv + tokq * 1536 + 64 * h + 16 * db + 4 * lq) = wv; }
        }
        __syncthreads();
    }
}

template <int N1> __device__ void fft1_units(int wv, const Params& p, unsigned char* lds, int seq_lo, int nseq, int part, int nparts) {
    const int tid = otid(wv), lane = tid & 63, w = __builtin_amdgcn_readfirstlane(tid >> 6), lr = lane & 15, lq = lane >> 4;
    constexpr int PW = N1 + 8, NB = N1 / 16, NK = N1 / 32; constexpr int S = N1 * 128;
    const bf16_t* z = (const bf16_t*)(p.ws + WS_BIG1); bf16_t* A1 = (bf16_t*)(p.ws + WS_BIG2);
    const bf16_t* ctg = (const bf16_t*)(p.ws + WS_TAB + (N1 == 64 ? TAB_CT64 : TAB_CT128)); const bf16_t* stg = (const bf16_t*)(p.ws + WS_TAB + (N1 == 64 ? TAB_ST64 : TAB_ST128));
    bf16_t* CT = (bf16_t*)lds; bf16_t* ST = CT + N1 * PW; bf16_t* XT = ST + N1 * PW;
    for (int idx = tid; idx < N1 * N1 / 8; idx += NTHR) { const int r = idx / (N1 / 8), c8 = (idx % (N1 / 8)) * 8;
        *(bf16x8*)(CT + r * PW + c8) = *(const bf16x8*)(ctg + r * N1 + c8); *(bf16x8*)(ST + r * PW + c8) = *(const bf16x8*)(stg + r * N1 + c8); }
    __syncthreads();
    const int nunits = nseq * 128 * 8;
    for (int unit = part; unit < nunits; unit += nparts) {
        const int sq = unit / 1024, b = (unit >> 3) & 127, cb = unit & 7;
        const int seq = seq_lo + sq; const size_t sbase = (size_t)seq * 8192;
        for (int idx = tid; idx < N1 * 16; idx += NTHR) { const int a = idx >> 4, c8 = (idx & 15) * 8;
            const bf16x8 v = *(const bf16x8*)(z + (sbase + 128 * a + b) * DM + cb * 128 + c8);
#pragma unroll
            for (int e = 0; e < 8; ++e) XT[(c8 + e) * PW + a] = (bf16_t)v[e]; }
        __syncthreads();
        bf16x8 xf[NK];
#pragma unroll
        for (int kk = 0; kk < NK; ++kk) xf[kk] = *(const bf16x8*)(XT + (16 * w + lr) * PW + 32 * kk + 8 * lq);
#pragma unroll
        for (int i = 0; i < NB; ++i) { f32x4 ar = {0, 0, 0, 0}, as = {0, 0, 0, 0};
#pragma unroll
            for (int kk = 0; kk < NK; ++kk) { const bf16x8 cf = *(const bf16x8*)(CT + (16 * i + lr) * PW + 32 * kk + 8 * lq), sf = *(const bf16x8*)(ST + (16 * i + lr) * PW + 32 * kk + 8 * lq);
                ar = mfma16(xf[kk], cf, ar); as = mfma16(xf[kk], sf, as); }
            const int ka = 16 * i + lr; float tc, ts; sincospif(2.0f * (float)(b * ka) / (float)S, &ts, &tc);
            const f32x4 re = ar * tc - as * ts, im = -(as * tc) - ar * ts;
            bf16_t* op = A1 + (sbase + (size_t)ka * 128 + b) * 2048 + cb * 128 + 16 * w + 4 * lq;
            u32x2 o; o.x = cvt_pk_bf16(re[0], re[1]); o.y = cvt_pk_bf16(re[2], re[3]); *(u32x2*)op = o;
            o.x = cvt_pk_bf16(im[0], im[1]); o.y = cvt_pk_bf16(im[2], im[3]); *(u32x2*)(op + 1024) = o; }
        __syncthreads();
    }
}
__device__ void fft2_phase(int wv, const Params& p, unsigned char* lds) {
    const int tid = otid(wv), lane = tid & 63, w = __builtin_amdgcn_readfirstlane(tid >> 6), lr = lane & 15, lq = lane >> 4;
    constexpr int PW = 136;
    const bf16_t* A1 = (const bf16_t*)(p.ws + WS_BIG2); bf16_t* Y = (bf16_t*)(p.ws + WS_BIG1);
    const bf16_t* ctg = (const bf16_t*)(p.ws + WS_TAB + TAB_CT128); const bf16_t* stg = (const bf16_t*)(p.ws + WS_TAB + TAB_ST128);
    bf16_t* CT = (bf16_t*)lds; bf16_t* ST = CT + 128 * PW; bf16_t* XR = ST + 128 * PW; bf16_t* XI = XR + 128 * PW;
    for (int idx = tid; idx < 128 * 16; idx += NTHR) { const int r = idx >> 4, c8 = (idx & 15) * 8;
        *(bf16x8*)(CT + r * PW + c8) = *(const bf16x8*)(ctg + r * 128 + c8); *(bf16x8*)(ST + r * PW + c8) = *(const bf16x8*)(stg + r * 128 + c8); }
    __syncthreads();
    for (int unit = blockIdx.x; unit < 2048; unit += gridDim.x) {
        const int gi = unit >> 3, cb = unit & 7;
        const int seq = gi < 64 ? 0 : (gi < 128 ? 1 : 2); const int ka = gi - (seq == 0 ? 0 : (seq == 1 ? 64 : 128)); const int N1 = seq == 2 ? 128 : 64;
        const size_t sbase = (size_t)seq * 8192;
#pragma unroll
        for (int ps = 0; ps < 4; ++ps) { const int idx = tid + ps * NTHR, b = idx >> 4, c8 = (idx & 15) * 8;
            const bf16_t* rp = A1 + ((size_t)gi * 128 + b) * 2048 + cb * 128 + c8; const bf16x8 vr = *(const bf16x8*)rp, vi = *(const bf16x8*)(rp + 1024);
#pragma unroll
            for (int e = 0; e < 8; ++e) { XR[(c8 + e) * PW + b] = (bf16_t)vr[e]; XI[(c8 + e) * PW + b] = (bf16_t)vi[e]; } }
        __syncthreads();
        bf16x8 xr[4], xi[4], nxr[4];
#pragma unroll
        for (int kk = 0; kk < 4; ++kk) { xr[kk] = *(const bf16x8*)(XR + (16 * w + lr) * PW + 32 * kk + 8 * lq); xi[kk] = *(const bf16x8*)(XI + (16 * w + lr) * PW + 32 * kk + 8 * lq);
            union { bf16x8 v; unsigned u[4]; } t; t.v = xr[kk]; t.u[0] ^= 0x80008000u; t.u[1] ^= 0x80008000u; t.u[2] ^= 0x80008000u; t.u[3] ^= 0x80008000u; nxr[kk] = t.v; }
#pragma unroll
        for (int i = 0; i < 8; ++i) { f32x4 re = {0, 0, 0, 0}, im = {0, 0, 0, 0};
#pragma unroll
            for (int kk = 0; kk < 4; ++kk) { const bf16x8 cf = *(const bf16x8*)(CT + (16 * i + lr) * PW + 32 * kk + 8 * lq), sf = *(const bf16x8*)(ST + (16 * i + lr) * PW + 32 * kk + 8 * lq);
                re = mfma16(xr[kk], cf, re); re = mfma16(xi[kk], sf, re); im = mfma16(xi[kk], cf, im); im = mfma16(nxr[kk], sf, im); }
            const int kb = 16 * i + lr;
            bf16_t* op = Y + (sbase + (size_t)N1 * kb + ka) * 2048 + cb * 128 + 16 * w + 4 * lq;
            u32x2 o; o.x = cvt_pk_bf16(re[0], re[1]); o.y = cvt_pk_bf16(re[2], re[3]); *(u32x2*)op = o;
            o.x = cvt_pk_bf16(im[0], im[1]); o.y = cvt_pk_bf16(im[2], im[3]); *(u32x2*)(op + 1024) = o; }
        __syncthreads();
    }
}

__device__ void fix_phase(int wv, const Params& p, int li) {
    const float* edge = (const float*)(p.ws + WS_EDGE); const float* cw = (const float*)(p.ws + WS_CW) + (size_t)li * 4 * NUP; bf16_t* act = (bf16_t*)(p.ws + WS_ACT);
    const int total = 1024 * (FFD / 4);
    const int tid = otid(wv);
    for (int idx = blockIdx.x * NTHR + tid; idx < total; idx += gridDim.x * NTHR) {
        const int e = idx / (FFD / 4), c = (idx % (FFD / 4)) * 4; const int band = e >> 1, hi = e & 1; const int R = band * 64 + (hi ? 63 : 0);
        const int ca = (c >> 7) * 256 + (c & 127), cg_ = ca + 128;
        const bool seqstart = (R == 0 || R == 8192 || R == 16384), seqend = (R == 8191 || R == 16383 || R == 32767);
        const float* ep = edge + (size_t)band * 4 * NUP;
        f32x4 pa, pg, ua, ug, na, ng; const f32x4 zero = {0, 0, 0, 0};
        if (!hi) { pa = seqstart ? zero : *(const f32x4*)(ep - NUP + ca); pg = seqstart ? zero : *(const f32x4*)(ep - NUP + cg_);
            ua = *(const f32x4*)(ep + ca); ug = *(const f32x4*)(ep + cg_); na = *(const f32x4*)(ep + NUP + ca); ng = *(const f32x4*)(ep + NUP + cg_); }
        else { pa = *(const f32x4*)(ep + 2 * NUP + ca); pg = *(const f32x4*)(ep + 2 * NUP + cg_); ua = *(const f32x4*)(ep + 3 * NUP + ca); ug = *(const f32x4*)(ep + 3 * NUP + cg_);
            na = seqend ? zero : *(const f32x4*)(ep + 4 * NUP + ca); ng = seqend ? zero : *(const f32x4*)(ep + 4 * NUP + cg_); }
        const f32x4 a = *(const f32x4*)(cw + ca) * pa + *(const f32x4*)(cw + NUP + ca) * ua + *(const f32x4*)(cw + 2 * NUP + ca) * na + *(const f32x4*)(cw + 3 * NUP + ca);
        const f32x4 g = *(const f32x4*)(cw + cg_) * pg + *(const f32x4*)(cw + NUP + cg_) * ug + *(const f32x4*)(cw + 2 * NUP + cg_) * ng + *(const f32x4*)(cw + 3 * NUP + cg_);
        float o[4];
#pragma unroll
        for (int j = 0; j < 4; ++j) o[j] = a[j] * g[j] / (1.0f + __expf(-g[j]));
        u32x2 wv; wv.x = cvt_pk_bf16(o[0], o[1]); wv.y = cvt_pk_bf16(o[2], o[3]);
        *(u32x2*)(act + (size_t)R * FFD + c) = wv;
    }
}

__global__ void __launch_bounds__(NTHR, 2) mega(Params p) {
    extern __shared__ __attribute__((aligned(16))) unsigned char lds[];
    cg::grid_group grid = cg::this_grid();
    const int G = gridDim.x, bid = blockIdx.x;
    const int wv = __builtin_amdgcn_readfirstlane(threadIdx.x >> 6);
    float* ldsf = (float*)lds;
#define WSPTRS \
    unsigned char* ws = p.ws; asm volatile("" : "+s"(ws)); \
    float* ssb = (float*)(ws + WS_SS); float* mod = (float*)(ws + WS_MOD); float* gsT = (float*)(ws + WS_GS); \
    float* biasG1 = (float*)(ws + WS_BG1); float* biasUP = (float*)(ws + WS_BUP); float* cwT = (float*)(ws + WS_CW); \
    bf16_t* xb = (bf16_t*)(ws + WS_XB); bf16_t* big1 = (bf16_t*)(ws + WS_BIG1); \
    bf16_t* wain = (bf16_t*)(ws + WS_WAIN); bf16_t* waout = (bf16_t*)(ws + WS_WAOUT); bf16_t* wqkv = (bf16_t*)(ws + WS_WQKV); bf16_t* wo = (bf16_t*)(ws + WS_WO); \
    bf16_t* wcin = (bf16_t*)(ws + WS_WCIN); bf16_t* wf = (bf16_t*)(ws + WS_WF); bf16_t* wup = (bf16_t*)(ws + WS_WUP); bf16_t* wdn = (bf16_t*)(ws + WS_WDN); \
    (void)ssb; (void)mod; (void)gsT; (void)biasG1; (void)biasUP; (void)cwT; (void)xb; (void)big1; (void)wain; (void)waout; (void)wqkv; (void)wo; (void)wcin; (void)wf; (void)wup; (void)wdn;
    {
    WSPTRS
    const int tid = otid(wv);
    for (int idx = bid * NTHR + tid; idx < 10 * MTOK / 4; idx += G * NTHR) *(f32x4*)(ssb + MTOK + 4 * (size_t)idx) = (f32x4){0.f, 0.f, 0.f, 0.f};
    if (bid < 192) mod_task(wv, p, bid, ldsf);
    { bf16_t* tab = (bf16_t*)(ws + WS_TAB);
        for (int idx = bid * NTHR + tid; idx < 4096 + 16384; idx += G * NTHR) {
            if (idx < 4096) { const int ka = idx >> 6, a = idx & 63; const float x = 2.0f * (float)((ka * a) & 63) / 64.0f; tab[TAB_CT64 / 2 + idx] = f2bf(cospif(x) * 0.125f); tab[TAB_ST64 / 2 + idx] = f2bf(sinpif(x) * 0.125f); }
            else { const int i2 = idx - 4096, ka = i2 >> 7, a = i2 & 127; const float x = 2.0f * (float)((ka * a) & 127) / 128.0f; tab[TAB_CT128 / 2 + i2] = f2bf(cospif(x) * 0.08838834764831845f); tab[TAB_ST128 / 2 + i2] = f2bf(sinpif(x) * 0.08838834764831845f); } } }
    if (bid >= G - 128) wf_task(wv, p, bid - (G - 128), ldsf);
    convert_matrix(wv, p.a_w_in, 1024, 2048, 2048, 0, wain, ldsf, 0);
    convert_matrix(wv, p.a_w_in + (size_t)1024 * 2048, 1024, 2048, 2048, 0, wain + (size_t)2048 * 1024, ldsf, 64);
    convert_matrix(wv, p.a_w_out, 1024, 1024, 1024, 0, waout, ldsf, 128);
    convert_matrix(wv, p.a_w_out + (size_t)1024 * 1024, 1024, 1024, 1024, 0, waout + (size_t)1024 * 1024, ldsf, 192);
    convert_matrix(wv, p.b_w_qkv, 1024, 1536, 1536, 0, wqkv, ldsf, 32);
    convert_matrix(wv, p.b_w_o, 1024, 1024, 1024, 0, wo, ldsf, 96);
    convert_matrix(wv, p.c_w_in, 1024, 1024, 1024, 0, wcin, ldsf, 160);
    convert_matrix(wv, p.f_w_up, 1024, NUP, NUP, 1, wup, ldsf, 224);
    convert_matrix(wv, p.f_w_down, FFD, 1024, 1024, 0, wdn, ldsf, 16);
    grid.sync();

    }
    {
    WSPTRS
    const int tid = otid(wv);
    if (bid < 48) {
        if (bid < 8) bias_task(wv, p.a_w_in, 2048, 0, mod, biasG1, 2048, bid, ldsf);
        else if (bid < 14) bias_task(wv, p.b_w_qkv, 1536, 0, mod + 3 * MODW, biasG1 + 3 * 2048, 1536, bid - 8, ldsf);
        else if (bid < 18) bias_task(wv, p.c_w_in, 1024, 0, mod + 6 * MODW, biasG1 + 6 * 2048, 1024, bid - 14, ldsf);
        else if (bid < 26) bias_task(wv, p.a_w_in + (size_t)1024 * 2048, 2048, 0, mod + 9 * MODW, biasG1 + 9 * 2048, 2048, bid - 18, ldsf);
        else bias_task(wv, p.f_w_up, NUP, 1, mod + 3 * DM, biasUP, NUP, bid - 26, ldsf);
    }
    for (int idx = bid * NTHR + tid; idx < 9 * 3 * DM; idx += G * NTHR) { const int ni = idx / (3 * DM), seq = (idx / DM) % 3, c = idx % DM;
        float v; if (ni == 8) v = p.g_final[c]; else { const int i = ni >> 1, t = ni & 1; v = p.norm_g[(i * 2 + t) * DM + c] * (1.0f + mod[((size_t)i * 3 + seq) * MODW + (t ? 4 : 1) * DM + c]); }
        gsT[idx] = v; }
    for (int idx = bid * NTHR + tid; idx < 4 * 4 * NUP; idx += G * NTHR) { const int i = idx / (4 * NUP), q = (idx / NUP) & 3, n = idx % NUP; const int oc = upcol(n);
        cwT[idx] = q < 3 ? p.f_w_conv[((size_t)i * 3 + q) * NUP + oc] : p.f_b_conv[(size_t)i * NUP + oc]; }
    convert_matrix(wv, (const float*)(ws + WS_WF32), 2048, 1024, 1024, 0, wf, ldsf, 48);
    { const int wid = tid >> 6, lane = tid & 63;
        for (int r = bid * 8 + wid; r < MTOK; r += G * 8) { const int seq = seq_of_row(r);
            const float* xr = r < 16384 ? p.xp + (size_t)r * DM : p.xs + (size_t)(r - 16384) * DM; float s = 0.f; f32x4 v[4];
#pragma unroll
            for (int jj = 0; jj < 4; ++jj) { v[jj] = *(const f32x4*)(xr + jj * 256 + 4 * lane); s += (v[jj][0] * v[jj][0] + v[jj][1] * v[jj][1]) + (v[jj][2] * v[jj][2] + v[jj][3] * v[jj][3]); }
#pragma unroll
            for (int o = 32; o >= 1; o >>= 1) s += __shfl_xor(s, o);
            if (lane == 0) ssb[r] = s;
#pragma unroll
            for (int jj = 0; jj < 4; ++jj) { const int c = jj * 256 + 4 * lane; u32x2 wv; float h[4];
#pragma unroll
                for (int j = 0; j < 4; ++j) h[j] = v[jj][j] * (p.norm_g[c + j] * (1.0f + mod[(size_t)seq * MODW + DM + c + j]));
                wv.x = cvt_pk_bf16(h[0], h[1]); wv.y = cvt_pk_bf16(h[2], h[3]); *(u32x2*)(xb + (size_t)r * DM + c) = wv; } } }
    grid.sync();
    }

    LAS unsigned char* ldsl = (LAS unsigned char*)lds;
    for (int i = 0; i < 4; ++i) {
        WSPTRS
        const int kind = i % 3, jl = i / 3;
        {   pg8::StaticOrder S; const float* ssin = ssb + (size_t)(2 * i) * MTOK;
            if (kind == 0) { pg8::Gemm g{xb, wain + (size_t)jl * 2048 * 1024, MTOK, 2048, 1024, 1024}; S.init(MTOK, 2048, G, bid);
                pg8::EpiAct<1> E{big1, 2048, biasG1 + (size_t)i * 3 * 2048, 2048, ssin, ssb + (size_t)(9 + jl) * MTOK, 1024};
#ifndef NO_G1A
                pg8::gemm_phase<pg8::EpiAct<1>>(wv, ldsl, g, S, E);
#endif
 }
            else { const int N = kind == 1 ? 1536 : 1024; pg8::Gemm g{xb, kind == 1 ? wqkv : wcin, MTOK, N, 1024, 1024}; S.init(MTOK, N, G, bid);
                pg8::EpiAct<0> E{big1, N, biasG1 + (size_t)i * 3 * 2048, N, ssin, nullptr, 0};
#ifndef NO_G1B
                pg8::gemm_phase<pg8::EpiAct<0>>(wv, ldsl, g, S, E);
#endif
 }
        }
        grid.sync();
#ifndef NO_SG
        if (kind == 0) sg_phase(wv, p, jl, lds);
#endif
#ifndef NO_ATT
        if (kind == 1) att_phase(wv, p, lds);
#endif
#ifndef NO_FFT
        if (kind == 2) {
#ifndef NO_FFT1
            if (bid < G / 2) fft1_units<64>(wv, p, lds, 0, 2, bid, G / 2); else fft1_units<128>(wv, p, lds, 2, 1, bid - G / 2, G - G / 2);
#endif
            grid.sync();
#ifndef NO_FFT2
            fft2_phase(wv, p, lds);
#endif
        }
#endif
        grid.sync();
        for (int half = 0; half < 2; ++half) {
            if (half == 1) {
                {   pg8::Gemm g{xb, wup + (size_t)(i & 1) * NUP * 1024, MTOK, NUP, 1024, 1024}; pg8::StaticOrder S; S.init(MTOK, NUP, G, bid);
                    pg8::EpiUp E{(bf16_t*)(ws + WS_ACT), biasUP + (size_t)(i & 1) * 3 * NUP, cwT + (size_t)i * 4 * NUP, ssb + (size_t)(2 * i + 1) * MTOK, (float*)(ws + WS_EDGE)};
#ifndef NO_UP
                    pg8::gemm_phase<pg8::EpiUp>(wv, ldsl, g, S, E);
#endif
 }
                grid.sync();
                fix_phase(wv, p, i);
                if (i < 3) {
                    convert_matrix(wv, p.f_w_up + (size_t)(i + 1) * 1024 * NUP, 1024, NUP, NUP, 1, wup + (size_t)((i + 1) & 1) * NUP * 1024, ldsf, 0);
                    convert_matrix(wv, p.f_w_down + (size_t)(i + 1) * FFD * 1024, FFD, 1024, 1024, 0, wdn + (size_t)((i + 1) & 1) * 1024 * FFD, ldsf, 128);
                    if (bid >= G - 22) bias_task(wv, p.f_w_up + (size_t)(i + 1) * 1024 * NUP, NUP, 1, mod + (size_t)(i + 1) * 3 * MODW + 3 * DM, biasUP + (size_t)((i + 1) & 1) * 3 * NUP, NUP, bid - (G - 22), ldsf);
                }
                grid.sync();
            }
            pg8::Gemm g; const float* gate; const float* gsn; bf16_t* xbo = xb; float* ssn; const float* b0 = p.out; const float* b1 = p.out + (size_t)16384 * DM;
            if (half == 0) {
                if (kind == 0) g = pg8::Gemm{big1, waout + (size_t)jl * 1024 * 1024, MTOK, 1024, 1024, 2048};
                else if (kind == 1) g = pg8::Gemm{big1, wo, MTOK, 1024, 1024, 1536};
                else g = pg8::Gemm{big1, wf, MTOK, 1024, 2048, 2048};
                gate = mod + (size_t)i * 3 * MODW + 2 * DM; gsn = gsT + (size_t)(2 * i + 1) * 3 * DM; ssn = ssb + (size_t)(2 * i + 1) * MTOK;
                if (i == 0) { b0 = p.xp; b1 = p.xs; }
            } else {
                g = pg8::Gemm{(const bf16_t*)(ws + WS_ACT), wdn + (size_t)(i & 1) * 1024 * FFD, MTOK, 1024, FFD, FFD};
                gate = mod + (size_t)i * 3 * MODW + 5 * DM; gsn = gsT + (size_t)(2 * i + 2) * 3 * DM; ssn = ssb + (size_t)(2 * i + 2) * MTOK;
                if (i == 3) xbo = nullptr;
            }
            pg8::StaticOrder S; S.init(MTOK, 1024, G, bid);
            pg8::EpiRes E{b0, b1, p.out, gate, gsn, xbo, ssn};
#ifndef NO_RES
            pg8::gemm_phase<pg8::EpiRes>(wv, ldsl, g, S, E);
#endif
            grid.sync();
        }
    }
    { const float* ssF = (const float*)(p.ws + WS_SS) + (size_t)8 * MTOK; const int tid = otid(wv);
        for (size_t idx = (size_t)bid * NTHR + tid; idx < (size_t)MTOK * DM / 4; idx += (size_t)G * NTHR) { const int r = (int)(idx >> 8), c = (int)(idx & 255) * 4;
            const float rs = 1.0f / sqrtf(ssF[r] * (1.0f / DM) + EPSN); f32x4 v = *(const f32x4*)(p.out + (size_t)r * DM + c); const f32x4 gf = *(const f32x4*)(p.g_final + c);
            v = v * rs * gf; *(f32x4*)(p.out + (size_t)r * DM + c) = v; } }
}

extern "C" void kernel_launch(void* const* d_in, const int* in_sizes, int n_in, void* d_out, int out_size, void* d_ws, size_t ws_size, hipStream_t stream) {
    static int grid_blocks = 0;
    if (!grid_blocks) {
        if (ws_size < WS_END) { fprintf(stderr, "kernel_launch: workspace too small: %zu < %zu\n", ws_size, (size_t)WS_END); grid_blocks = -1; return; }
        int dev = 0, cus = 0, per_cu = 0;
        hipGetDevice(&dev);
        hipDeviceGetAttribute(&cus, hipDeviceAttributeMultiprocessorCount, dev);
        hipFuncSetAttribute((const void*)mega, hipFuncAttributeMaxDynamicSharedMemorySize, LDS_BYTES);
        hipOccupancyMaxActiveBlocksPerMultiprocessor(&per_cu, (const void*)mega, NTHR, LDS_BYTES);
        if (per_cu < 1) { fprintf(stderr, "kernel_launch: occupancy query says %d blocks per CU\n", per_cu); per_cu = 1; }
        grid_blocks = cus;
        (void)hipGetLastError();
    }
    if (grid_blocks < 0) return;
    Params p{};
    p.xp = (const float*)d_in[0]; p.xs = (const float*)d_in[1]; p.cp = (const float*)d_in[2]; p.csm = (const float*)d_in[3]; p.w_ada = (const float*)d_in[4]; p.b_ada = (const float*)d_in[5];
    p.norm_g = (const float*)d_in[6]; p.a_w_in = (const float*)d_in[7]; p.a_g_v = (const float*)d_in[8]; p.a_w_s = (const float*)d_in[9]; p.a_b_s = (const float*)d_in[10]; p.a_w_out = (const float*)d_in[11];
    p.b_w_qkv = (const float*)d_in[12]; p.b_sinks = (const float*)d_in[13]; p.b_w_o = (const float*)d_in[14]; p.c_w_in = (const float*)d_in[15]; p.c_w_out = (const float*)d_in[16];
    p.f_w_up = (const float*)d_in[17]; p.f_w_conv = (const float*)d_in[18]; p.f_b_conv = (const float*)d_in[19]; p.f_w_down = (const float*)d_in[20]; p.g_final = (const float*)d_in[21];
    p.out = (float*)d_out; p.ws = (unsigned char*)d_ws;
    void* args[] = {&p};
    hipError_t e = hipLaunchCooperativeKernel((const void*)mega, dim3(grid_blocks), dim3(NTHR), args, LDS_BYTES, stream);
    if (e != hipSuccess) fprintf(stderr, "cooperative launch failed: %s (grid %d)\n", hipGetErrorString(e), grid_blocks);
}
```

```cpp
#include <hip/hip_runtime.h>
#include <hip/hip_cooperative_groups.h>
#include <cstdio>
namespace cg = cooperative_groups;

#define LAS __attribute__((address_space(3)))
typedef unsigned short bf16_t;
typedef short bf16x8 __attribute__((ext_vector_type(8)));
typedef short bf16x4 __attribute__((ext_vector_type(4)));
typedef float f32x4 __attribute__((ext_vector_type(4)));
typedef unsigned u32x4 __attribute__((ext_vector_type(4)));
typedef unsigned u32x2 __attribute__((ext_vector_type(2)));

constexpr int DM = 1024, MTOK = 32768, FFD = 2816, NUP = 5632, MODW = 6144;
constexpr float EPSN = 1e-6f;
constexpr int NTHR = 512;
constexpr int LDS_BYTES = 147456;

constexpr size_t al256(size_t x) { return (x + 255) & ~(size_t)255; }
constexpr size_t WS_SS = 0;
constexpr size_t SS_BYTES = (size_t)11 * MTOK * 4;
constexpr size_t WS_MOD = al256(WS_SS + SS_BYTES);
constexpr size_t WS_GS = al256(WS_MOD + (size_t)4 * 3 * MODW * 4);
constexpr size_t WS_BG1 = al256(WS_GS + (size_t)9 * 3 * DM * 4);
constexpr size_t WS_BUP = al256(WS_BG1 + (size_t)4 * 3 * 2048 * 4);
constexpr size_t WS_CW = al256(WS_BUP + (size_t)2 * 3 * NUP * 4);
constexpr size_t WS_TAB = al256(WS_CW + (size_t)4 * 4 * NUP * 4);
constexpr size_t TAB_CT64 = 0, TAB_ST64 = 8192, TAB_CT128 = 16384, TAB_ST128 = 16384 + 32768;
constexpr size_t WS_BAR = al256(WS_TAB + 81920);
constexpr size_t BAR_BYTES = 3456 * 4;
constexpr size_t WS_WF32 = al256(WS_BAR + BAR_BYTES);
constexpr size_t WS_WAIN = al256(WS_WF32 + (size_t)2048 * 1024 * 4);
constexpr size_t WS_WAOUT = al256(WS_WAIN + (size_t)2 * 2048 * 1024 * 2);
constexpr size_t WS_WQKV = al256(WS_WAOUT + (size_t)2 * 1024 * 1024 * 2);
constexpr size_t WS_WO = al256(WS_WQKV + (size_t)1536 * 1024 * 2);
constexpr size_t WS_WCIN = al256(WS_WO + (size_t)1024 * 1024 * 2);
constexpr size_t WS_WF = al256(WS_WCIN + (size_t)1024 * 1024 * 2);
constexpr size_t WS_WUP = al256(WS_WF + (size_t)1024 * 2048 * 2);
constexpr size_t WS_WDN = al256(WS_WUP + (size_t)2 * NUP * 1024 * 2);
constexpr size_t WS_XB = al256(WS_WDN + (size_t)2 * 1024 * FFD * 2);
constexpr size_t WS_BIG1 = al256(WS_XB + (size_t)MTOK * DM * 2);
constexpr size_t WS_BIG2 = al256(WS_BIG1 + (size_t)MTOK * 2048 * 2);
constexpr size_t WS_ACT = WS_BIG1;
constexpr size_t WS_EDGE = al256(WS_ACT + (size_t)MTOK * FFD * 2);
constexpr size_t WS_END = al256(WS_BIG2 + (size_t)MTOK * 2048 * 2);
static_assert(WS_EDGE + (size_t)512 * 4 * NUP * 4 <= WS_END, "edge buffer must fit");

struct Params {
    const float* xp; const float* xs; const float* cp; const float* csm; const float* w_ada; const float* b_ada; const float* norm_g;
    const float* a_w_in; const float* a_g_v; const float* a_w_s; const float* a_b_s; const float* a_w_out;
    const float* b_w_qkv; const float* b_sinks; const float* b_w_o; const float* c_w_in; const float* c_w_out;
    const float* f_w_up; const float* f_w_conv; const float* f_b_conv; const float* f_w_down; const float* g_final;
    float* out; unsigned char* ws;
};

__device__ __forceinline__ int otid(int wv) { int t; asm volatile("v_mbcnt_lo_u32_b32 %0, -1, 0\n\tv_mbcnt_hi_u32_b32 %0, -1, %0\n\tv_lshl_add_u32 %0, %1, 6, %0" : "=&v"(t) : "s"(wv)); return t; }
typedef __bf16 bf2_t __attribute__((ext_vector_type(2)));
typedef float f2_t __attribute__((ext_vector_type(2)));
__device__ __forceinline__ unsigned cvt_pk_bf16_asm(float lo, float hi) { unsigned r; asm volatile("v_cvt_pk_bf16_f32 %0, %1, %2" : "=v"(r) : "v"(lo), "v"(hi)); return r; }
__device__ __forceinline__ unsigned cvt_pk_bf16(float lo, float hi) { const f2_t v = {lo, hi}; const bf2_t b = __builtin_convertvector(v, bf2_t); return __builtin_bit_cast(unsigned, b); }
__device__ __forceinline__ bf16_t f2bf(float f) { return (bf16_t)(cvt_pk_bf16(f, 0.f) & 0xffffu); }
__device__ __forceinline__ int seq_of_row(int r) { return r < 8192 ? 0 : (r < 16384 ? 1 : 2); }
__device__ __forceinline__ int upcol(int n) { return (n >> 8) * 128 + (n & 127) + ((n & 128) ? FFD : 0); }

namespace pg8 {
constexpr int BM = 256, BK = 64, HALF = 128, HTB = HALF * BK * 2, STAGE_BYTES = 8 * HTB, NXCD = 8, WGM = 8;
__device__ __forceinline__ int lds_byte(int r, int c) { const int st = (r >> 4) * 2 + (c >> 5), rr = r & 15, cc = c & 31, ob = rr * 64 + cc * 2; return st * 1024 + (ob ^ (((ob >> 9) & 1) << 5)); }
__device__ __forceinline__ void stage_rc(int b, int& R, int& C) { const int st = b / 1024, sb = b % 1024, swz = sb ^ (((sb >> 9) & 1) << 5); R = (st >> 1) * 16 + swz / 64; C = (st & 1) * 32 + (swz % 64) / 2; }
__device__ __forceinline__ int perm32(int rho) { const int n = rho >> 4, i = rho & 15; return 8 * (i >> 2) + 4 * n + (i & 3); }
struct Unit { int pm, pn; };
struct Gemm { const bf16_t* A; const bf16_t* Bt; int M, N, K, lda; };
struct StaticOrder {
    int nM, nN, nwg, G, c;
    __device__ void init(int M, int N, int G_, int c_) { nM = M / BM; nN = N / BM; nwg = nM * nN; G = G_; c = c_; }
    __device__ bool next(int i, Unit& u) const {
        const long L = (long)i * G + c; if (L >= nwg) return false;
        int wgid = (int)L; { const int q = nwg / NXCD, r = nwg % NXCD, xcd = wgid % NXCD, off = wgid / NXCD; wgid = (xcd < r ? xcd * (q + 1) : r * (q + 1) + (xcd - r) * q) + off; }
        const int nig = WGM * nN, gid = wgid / nig, fm = gid * WGM, gsz = (nM - fm) < WGM ? (nM - fm) : WGM;
        u.pm = fm + ((wgid % nig) % gsz); u.pn = (wgid % nig) / gsz; return true;
    }
};

template <class Epi>
__device__ __forceinline__ void gemm_phase(int wv, LAS unsigned char* lds, const Gemm g, const StaticOrder& S, const Epi& E) {
    const int tid = otid(wv), wid = __builtin_amdgcn_readfirstlane(tid >> 6), lane = tid & 63, wr = wid >> 2, wc = wid & 3, fr = lane & 15, fq = lane >> 4;
    const int K = g.K, nt = K / BK, lda = g.lda;
    unsigned voffA[2], voffB[2];
#pragma unroll
    for (int i = 0; i < 2; ++i) { int R, C; stage_rc(tid * 16 + i * 8192, R, C); const int Rb = Epi::PERM ? ((R & ~31) + perm32(R & 31)) : R;
        voffA[i] = (unsigned)(R * lda + C) * 2u; voffB[i] = (unsigned)(Rb * K + C) * 2u; }
    const size_t kstep = (size_t)(BK * 2);
    const size_t hstepA = (size_t)HALF * lda * 2, hstepB = (size_t)HALF * K * 2;
    const size_t tstepA = 2 * hstepA, tstepB = 2 * hstepB;
    const unsigned ldsw = (unsigned)wid * 1024u;
    const int aoff = lds_byte(wr * 64 + fr, fq * 8), boff = lds_byte(wc * 32 + fr, fq * 8);
#define PG8_SA(b, h) (((b) * 2 + (h)) * HTB)
#define PG8_SB(b, h) ((4 + (b) * 2 + (h)) * HTB)
#define PG8_STAGE(bufoff, gbase, voff) do { _Pragma("unroll") for (int _i = 0; _i < 2; ++_i) \
        __builtin_amdgcn_global_load_lds((const unsigned*)((const char*)(gbase) + (voff)[_i]), (LAS unsigned*)(lds + (bufoff) + ldsw + _i * 8192), 16, 0, 0); } while (0)
#define PG8_LDA(dst, b, h) do { _Pragma("unroll") for (int m = 0; m < 4; ++m) _Pragma("unroll") for (int k = 0; k < 2; ++k) dst[m][k] = *(const LAS bf16x8*)(lds + PG8_SA(b, h) + aoff + m * 2048 + k * 1024); } while (0)
#define PG8_LDB(dst, b, h) do { _Pragma("unroll") for (int n = 0; n < 2; ++n) _Pragma("unroll") for (int k = 0; k < 2; ++k) dst[n][k] = *(const LAS bf16x8*)(lds + PG8_SB(b, h) + boff + n * 2048 + k * 1024); } while (0)
#define PG8_MMA(ai, bj, At, Bt) do { __builtin_amdgcn_s_setprio(1); _Pragma("unroll") for (int m = 0; m < 4; ++m) _Pragma("unroll") for (int n = 0; n < 2; ++n) _Pragma("unroll") for (int k = 0; k < 2; ++k) \
        acc[ai][bj][m][n] = __builtin_amdgcn_mfma_f32_16x16x32_bf16(Bt[n][k], At[m][k], acc[ai][bj][m][n], 0, 0, 0); __builtin_amdgcn_s_setprio(0); } while (0)
#define PG8_WAIT_V(n) asm volatile("s_waitcnt vmcnt(" #n ")" ::: "memory")
#define PG8_WAIT_L(n) asm volatile("s_waitcnt lgkmcnt(" #n ")" ::: "memory")
#define PG8_BAR __builtin_amdgcn_s_barrier()
#define PG8_SCHED __builtin_amdgcn_sched_barrier(0)
    Unit cur, nxt; int ui = 0;
    if (!S.next(0, cur)) return;
    f32x4 acc[2][2][4][2];
#pragma unroll
    for (int a = 0; a < 2; ++a)
#pragma unroll
        for (int b = 0; b < 2; ++b)
#pragma unroll
            for (int m = 0; m < 4; ++m)
#pragma unroll
                for (int n = 0; n < 2; ++n) acc[a][b][m][n] = (f32x4){0.f, 0.f, 0.f, 0.f};
    bf16x8 At[4][2], B0[2][2], B1[2][2];
    const char* cA = (const char*)g.A + (size_t)cur.pm * tstepA; const char* cB = (const char*)g.Bt + (size_t)cur.pn * tstepB;
    PG8_STAGE(PG8_SB(0, 0), cB, voffB); PG8_STAGE(PG8_SA(0, 0), cA, voffA); PG8_STAGE(PG8_SB(0, 1), cB + hstepB, voffB); PG8_STAGE(PG8_SA(0, 1), cA + hstepA, voffA);
    if (wr == 1) PG8_BAR;
    PG8_WAIT_V(4); PG8_BAR;
    PG8_STAGE(PG8_SB(1, 0), cB + kstep, voffB); PG8_STAGE(PG8_SA(1, 0), cA + kstep, voffA); PG8_STAGE(PG8_SB(1, 1), cB + hstepB + kstep, voffB);
    PG8_WAIT_V(6); PG8_BAR;
    for (;;) {
        const bool has_next = S.next(ui + 1, nxt);
        const char* nA = has_next ? (const char*)g.A + (size_t)nxt.pm * tstepA : cA; const char* nB = has_next ? (const char*)g.Bt + (size_t)nxt.pn * tstepB : cB;
        for (int t = 0; t < nt; t += 2) {
            const bool last = (t == nt - 2);
            const char* a1 = cA + (size_t)(t + 1) * kstep;
            const char* a2 = last ? nA : cA + (size_t)(t + 2) * kstep; const char* b2 = last ? nB : cB + (size_t)(t + 2) * kstep;
            const char* a3 = a2 + kstep; const char* b3 = b2 + kstep;
            PG8_LDB(B0, 0, 0); PG8_SCHED; PG8_LDA(At, 0, 0); PG8_STAGE(PG8_SA(1, 1), a1 + hstepA, voffA);
            PG8_WAIT_L(8); PG8_BAR; PG8_WAIT_L(0); PG8_MMA(0, 0, At, B0); PG8_BAR; PG8_SCHED;
            PG8_LDB(B1, 0, 1); PG8_STAGE(PG8_SB(0, 0), b2, voffB);
            PG8_BAR; PG8_WAIT_L(0); PG8_MMA(0, 1, At, B1); PG8_BAR;
            PG8_LDA(At, 0, 1); PG8_STAGE(PG8_SA(0, 0), a2, voffA);
            PG8_BAR; PG8_WAIT_L(0); PG8_MMA(1, 0, At, B0); PG8_BAR; PG8_SCHED;
            PG8_STAGE(PG8_SB(0, 1), b2 + hstepB, voffB);
            PG8_WAIT_V(6); PG8_BAR; PG8_MMA(1, 1, At, B1); PG8_BAR;
            PG8_LDB(B0, 1, 0); PG8_SCHED; PG8_LDA(At, 1, 0); PG8_STAGE(PG8_SA(0, 1), a2 + hstepA, voffA);
            PG8_WAIT_L(8); PG8_BAR; PG8_WAIT_L(0); PG8_MMA(0, 0, At, B0); PG8_BAR; PG8_SCHED;
            PG8_LDB(B1, 1, 1); PG8_STAGE(PG8_SB(1, 0), b3, voffB);
            PG8_BAR; PG8_WAIT_L(0); PG8_MMA(0, 1, At, B1); PG8_BAR;
            PG8_LDA(At, 1, 1); PG8_STAGE(PG8_SA(1, 0), a3, voffA);
            PG8_BAR; PG8_WAIT_L(0); PG8_MMA(1, 0, At, B0); PG8_BAR; PG8_SCHED;
            PG8_STAGE(PG8_SB(1, 1), b3 + hstepB, voffB);
            PG8_WAIT_V(6); PG8_BAR; PG8_MMA(1, 1, At, B1); PG8_BAR;
        }
        E(acc, cur, wr, wc, fr, fq);
        if (!has_next) break;
#pragma unroll
        for (int a = 0; a < 2; ++a)
#pragma unroll
            for (int b = 0; b < 2; ++b)
#pragma unroll
                for (int m = 0; m < 4; ++m)
#pragma unroll
                    for (int n = 0; n < 2; ++n) acc[a][b][m][n] = (f32x4){0.f, 0.f, 0.f, 0.f};
        cur = nxt; cA = nA; cB = nB; ++ui;
    }
    PG8_WAIT_V(0);
    if (wr == 0) PG8_BAR;
    PG8_BAR;
#undef PG8_SA
#undef PG8_SB
#undef PG8_STAGE
#undef PG8_LDA
#undef PG8_LDB
#undef PG8_MMA
#undef PG8_WAIT_V
#undef PG8_WAIT_L
#undef PG8_BAR
#undef PG8_SCHED
}

typedef float f32x2 __attribute__((ext_vector_type(2)));
__device__ __forceinline__ f32x2 gelu_pk(f32x2 v) {
    const f32x2 av = __builtin_elementwise_abs(v), d = av * 0.2316418882f + 1.0f;
    f32x2 t; t.x = __builtin_amdgcn_rcpf(d.x); t.y = __builtin_amdgcn_rcpf(d.y);
    f32x2 q = t * 0.5307027145f + (-0.7265760135f); q = q * t + 0.7107068705f; q = q * t + (-0.142248368f); q = q * t + 0.127414796f; q = q * t;
    const f32x2 s = (v * v) * (-0.72134752044f);
    f32x2 e; e.x = __builtin_amdgcn_exp2f(s.x); e.y = __builtin_amdgcn_exp2f(s.y);
    const f32x2 m = v * (q * e), r = v - m;
    f32x2 o; o.x = v.x < 0.f ? m.x : r.x; o.y = v.y < 0.f ? m.y : r.y; return o;
}
__device__ __forceinline__ f32x4 gelu4(f32x4 v) { f32x2 a = gelu_pk((f32x2){v[0], v[1]}), b = gelu_pk((f32x2){v[2], v[3]}); return (f32x4){a.x, a.y, b.x, b.y}; }

template <int ACT> struct EpiAct {
    static constexpr bool PERM = true;
    bf16_t* O; int ldc; const float* bias; int nb; const float* ssin; float* vss; int vcol0;
    __device__ __forceinline__ void operator()(const f32x4 (&acc)[2][2][4][2], const Unit& u, int wr, int wc, int fr, int fq) const {
        asm volatile("" : "+v"(fr), "+v"(fq));
        const int row0 = u.pm * BM + wr * 64 + fr, col0 = u.pn * BM + wc * 32 + 8 * fq;
        const int seq = seq_of_row(u.pm * BM);
        const float* bp = bias + (size_t)seq * nb + col0;
        f32x4 bv[2][2]; float rsv[2][4];
#pragma unroll
        for (int bj = 0; bj < 2; ++bj)
#pragma unroll
            for (int n = 0; n < 2; ++n) bv[bj][n] = *(const f32x4*)(bp + bj * HALF + 4 * n);
#pragma unroll
        for (int ai = 0; ai < 2; ++ai)
#pragma unroll
            for (int m = 0; m < 4; ++m) rsv[ai][m] = ssin[row0 + ai * HALF + m * 16];
#pragma unroll
        for (int ai = 0; ai < 2; ++ai)
#pragma unroll
            for (int m = 0; m < 4; ++m) rsv[ai][m] = __builtin_amdgcn_rsqf(rsv[ai][m] * (1.0f / DM) + EPSN);
        const bool dov = (ACT == 1) && (u.pn * BM >= vcol0);
#pragma unroll
        for (int ai = 0; ai < 2; ++ai)
#pragma unroll
            for (int m = 0; m < 4; ++m) {
                const int r = row0 + ai * HALF + m * 16;
                const float rs = rsv[ai][m];
                bf16_t* rowp = O + (size_t)r * ldc + col0; float s = 0.f;
#pragma unroll
                for (int bj = 0; bj < 2; ++bj) { f32x4 v0 = acc[ai][bj][m][0] * rs + bv[bj][0], v1 = acc[ai][bj][m][1] * rs + bv[bj][1];
                    if (ACT == 1) { v0 = gelu4(v0); v1 = gelu4(v1); s += (v0[0] * v0[0] + v0[1] * v0[1]) + (v0[2] * v0[2] + v0[3] * v0[3]) + (v1[0] * v1[0] + v1[1] * v1[1]) + (v1[2] * v1[2] + v1[3] * v1[3]); }
                    u32x4 w; w.x = cvt_pk_bf16_asm(v0[0], v0[1]); w.y = cvt_pk_bf16_asm(v0[2], v0[3]); w.z = cvt_pk_bf16_asm(v1[0], v1[1]); w.w = cvt_pk_bf16_asm(v1[2], v1[3]);
                    *(u32x4*)(rowp + bj * HALF) = w; }
                if (ACT == 1) { s += __shfl_xor(s, 16); s += __shfl_xor(s, 32); if (dov && fq == 0) unsafeAtomicAdd(vss + r, s); }
            }
    }
};

struct EpiRes {
    static constexpr bool PERM = false;
    const float* base0; const float* base1; float* xout; const float* gate; const float* gs; bf16_t* xb; float* ssn;
    __device__ __forceinline__ void operator()(const f32x4 (&acc)[2][2][4][2], const Unit& u, int wr, int wc, int fr, int fq) const {
        asm volatile("" : "+v"(fr), "+v"(fq));
        const int row0 = u.pm * BM + wr * 64 + fr, col0 = u.pn * BM + wc * 32 + 4 * fq;
        const int seq = seq_of_row(u.pm * BM);
        const float* gp = gate + (size_t)seq * MODW + col0; const float* gsp = gs + (size_t)seq * DM + col0;
        f32x4 gv[2][2], gsv[2][2];
#pragma unroll
        for (int bj = 0; bj < 2; ++bj)
#pragma unroll
            for (int n = 0; n < 2; ++n) { gv[bj][n] = *(const f32x4*)(gp + bj * HALF + n * 16); gsv[bj][n] = *(const f32x4*)(gsp + bj * HALF + n * 16); }
        const float* bbase = (u.pm * BM < 16384 ? base0 + (size_t)row0 * DM : base1 + (size_t)(row0 - 16384) * DM) + col0;
        f32x4 xc[2][2], xn2[2][2];
#pragma unroll
        for (int bj = 0; bj < 2; ++bj)
#pragma unroll
            for (int n = 0; n < 2; ++n) xc[bj][n] = *(const f32x4*)(bbase + bj * HALF + n * 16);
#pragma unroll
        for (int g8 = 0; g8 < 8; ++g8) { const int ai = g8 >> 2, m = g8 & 3;
            if (g8 < 7) { const int an = (g8 + 1) >> 2, mn = (g8 + 1) & 3; const float* bp = bbase + (size_t)(an * HALF + mn * 16) * DM;
#pragma unroll
                for (int bj = 0; bj < 2; ++bj)
#pragma unroll
                    for (int n = 0; n < 2; ++n) xn2[bj][n] = *(const f32x4*)(bp + bj * HALF + n * 16); }
            const int r = row0 + ai * HALF + m * 16;
            float* op = xout + (size_t)r * DM + col0; float s = 0.f;
#pragma unroll
            for (int bj = 0; bj < 2; ++bj)
#pragma unroll
                for (int n = 0; n < 2; ++n) { const f32x4 xn = xc[bj][n] + gv[bj][n] * acc[ai][bj][m][n];
                    *(f32x4*)(op + bj * HALF + n * 16) = xn; s += (xn[0] * xn[0] + xn[1] * xn[1]) + (xn[2] * xn[2] + xn[3] * xn[3]);
                    if (xb) { const f32x4 h = xn * gsv[bj][n]; u32x2 w; w.x = cvt_pk_bf16_asm(h[0], h[1]); w.y = cvt_pk_bf16_asm(h[2], h[3]);
                        *(u32x2*)(xb + (size_t)r * DM + col0 + bj * HALF + n * 16) = w; } }
            s += __shfl_xor(s, 16); s += __shfl_xor(s, 32); if (fq == 0) unsafeAtomicAdd(ssn + r, s);
#pragma unroll
            for (int bj = 0; bj < 2; ++bj)
#pragma unroll
                for (int n = 0; n < 2; ++n) xc[bj][n] = xn2[bj][n];
        }
    }
};

struct EpiUp {
    static constexpr bool PERM = true;
    bf16_t* act; const float* bias; const float* cw; const float* ssin; float* edge;
    __device__ __forceinline__ void operator()(const f32x4 (&acc)[2][2][4][2], const Unit& u, int wr, int wc, int fr, int fq) const {
        asm volatile("" : "+v"(fr), "+v"(fq));
        const int row0 = u.pm * BM + wr * 64 + fr, colt = u.pn * BM + wc * 32 + 8 * fq;
        const int seq = seq_of_row(u.pm * BM);
        const float* biasp = bias + (size_t)seq * NUP + colt; const float* cwp = cw + colt;
        float rs[2][4];
#pragma unroll
        for (int ai = 0; ai < 2; ++ai)
#pragma unroll
            for (int m = 0; m < 4; ++m) rs[ai][m] = ssin[row0 + ai * HALF + m * 16];
#pragma unroll
        for (int ai = 0; ai < 2; ++ai)
#pragma unroll
            for (int m = 0; m < 4; ++m) rs[ai][m] = __builtin_amdgcn_rsqf(rs[ai][m] * (1.0f / DM) + EPSN);
#pragma unroll
        for (int n = 0; n < 2; ++n) {
            f32x4 prm[2][5];
#pragma unroll
            for (int bj = 0; bj < 2; ++bj) { const int co = bj * HALF + 4 * n;
                prm[bj][0] = *(const f32x4*)(biasp + co); prm[bj][1] = *(const f32x4*)(cwp + co); prm[bj][2] = *(const f32x4*)(cwp + NUP + co); prm[bj][3] = *(const f32x4*)(cwp + 2 * NUP + co); prm[bj][4] = *(const f32x4*)(cwp + 3 * NUP + co); }
#pragma unroll
            for (int ai = 0; ai < 2; ++ai) {
                float* ep = edge + (size_t)(u.pm * 4 + ai * 2 + wr) * 4 * NUP + colt;
                f32x4 SG[4];
#pragma unroll
                for (int bjr = 0; bjr < 2; ++bjr) { const int bj = 1 - bjr; const int co = bj * HALF + 4 * n;
                    f32x4 U[4];
#pragma unroll
                    for (int m = 0; m < 4; ++m) U[m] = acc[ai][bj][m][n] * rs[ai][m] + prm[bj][0];
                    if (fr < 2) *(f32x4*)(ep + (size_t)fr * NUP + co) = U[0];
                    if (fr >= 14) *(f32x4*)(ep + (size_t)(fr - 12) * NUP + co) = U[3];
#pragma unroll
                    for (int m = 0; m < 4; ++m) { const f32x4 sp = (fr == 15 && m > 0) ? U[m > 0 ? m - 1 : 0] : U[m]; const f32x4 sn = (fr == 0 && m < 3) ? U[m < 3 ? m + 1 : 3] : U[m];
                        f32x4 pv, nv;
#pragma unroll
                        for (int j = 0; j < 4; ++j) { pv[j] = __int_as_float(__builtin_amdgcn_update_dpp(0, __float_as_int(sp[j]), 0x121, 0xf, 0xf, false)); nv[j] = __int_as_float(__builtin_amdgcn_update_dpp(0, __float_as_int(sn[j]), 0x12F, 0xf, 0xf, false)); }
                        const f32x4 R = prm[bj][1] * pv + prm[bj][2] * U[m] + prm[bj][3] * nv + prm[bj][4];
                        if (bj == 1) {
#pragma unroll
                            for (int j = 0; j < 4; ++j) SG[m][j] = R[j] * __builtin_amdgcn_rcpf(1.0f + __expf(-R[j])); }
                        else { const int r = row0 + ai * HALF + m * 16; const bool skip = (m == 0 && fr == 0) || (m == 3 && fr == 15);
                            const f32x4 o = R * SG[m]; u32x2 w; w.x = cvt_pk_bf16_asm(o[0], o[1]); w.y = cvt_pk_bf16_asm(o[2], o[3]);
                            if (!skip) *(u32x2*)(act + (size_t)r * FFD + u.pn * 128 + wc * 32 + 8 * fq + 4 * n) = w; } } } }
        }
    }
};
}

__device__ __forceinline__ float silu_f(float x) { return x / (1.0f + __expf(-x)); }

__device__ void mod_task(int wv, const Params& p, int tk, float* ldsf) {
    const int tid = otid(wv), i = tk / 48, cgp = tk % 48;
    float* csL = ldsf; float* red = ldsf + 3072;
    for (int idx = tid; idx < 3072; idx += NTHR) { const int seq = idx >> 10, k = idx & 1023; const float c = seq < 2 ? p.cp[seq * DM + k] : p.csm[k]; csL[idx] = silu_f(c); }
    __syncthreads();
    const int quad = tid & 31, ksl = tid >> 5;
    const float* W = p.w_ada + (size_t)i * DM * MODW + (size_t)ksl * 64 * MODW + 128 * cgp + 4 * quad;
    f32x4 a0 = {0, 0, 0, 0}, a1 = {0, 0, 0, 0}, a2 = {0, 0, 0, 0};
#pragma unroll 8
    for (int kk = 0; kk < 64; ++kk) { const f32x4 w = *(const f32x4*)(W + (size_t)kk * MODW); const int k = ksl * 64 + kk;
        a0 += w * csL[k]; a1 += w * csL[1024 + k]; a2 += w * csL[2048 + k]; }
    float* rp = red + (ksl * 32 + quad) * 12;
    *(f32x4*)(rp) = a0; *(f32x4*)(rp + 4) = a1; *(f32x4*)(rp + 8) = a2;
    __syncthreads();
    if (tid < 384) { const int q = tid & 31, e = tid >> 5; float s = 0.f;
        for (int k = 0; k < 16; ++k) s += red[(k * 32 + q) * 12 + e];
        const int seq = e >> 2, col = 128 * cgp + 4 * q + (e & 3);
        float* mod = (float*)(p.ws + WS_MOD);
        mod[((size_t)i * 3 + seq) * MODW + col] = s + p.b_ada[i * MODW + col]; }
    __syncthreads();
}

__device__ void wf_task(int wv, const Params& p, int task, float* ldsf) {
    const int tid = otid(wv), g = task >> 4, n0 = (task & 15) * 64;
    float* tile = ldsf; float* ct = ldsf + 128 * 64;
    for (int idx = tid; idx < 128 * 16; idx += NTHR) { const int cp_ = idx >> 4, n4 = (idx & 15) * 4;
        *(f32x4*)(tile + cp_ * 64 + n4) = *(const f32x4*)(p.c_w_out + (size_t)(g * 128 + cp_) * DM + n0 + n4); }
    if (tid < 128) ct[tid] = cospif(2.0f * tid / 128.0f) * 0.08838834764831845f;
    __syncthreads();
    const int n = tid & 63, wvl = __builtin_amdgcn_readfirstlane(tid >> 6);
    float ac[16], as[16];
#pragma unroll
    for (int c = 0; c < 16; ++c) { ac[c] = 0.f; as[c] = 0.f; }
    for (int cq = 0; cq < 128; ++cq) { const float v = tile[cq * 64 + n];
#pragma unroll
        for (int cc = 0; cc < 16; ++cc) { const int idx = ((wvl * 16 + cc) * cq) & 127; ac[cc] += ct[idx] * v; as[cc] += ct[(idx + 96) & 127] * v; } }
    float* Wf = (float*)(p.ws + WS_WF32);
#pragma unroll
    for (int cc = 0; cc < 16; ++cc) { const int c = wvl * 16 + cc; Wf[(size_t)(g * 128 + c) * DM + n0 + n] = ac[cc]; Wf[(size_t)(1024 + g * 128 + c) * DM + n0 + n] = as[cc]; }
    __syncthreads();
}

__device__ void convert_matrix(int wv, const float* src, int K, int N, int ld, int perm, bf16_t* dst, float* tileL, int rot) {
    const int tid = otid(wv), G = gridDim.x, ntk = K >> 6, ntiles = ntk * (N >> 6);
    for (int t = (blockIdx.x + rot) % G; t < ntiles; t += G) {
        const int k0 = (t % ntk) * 64, n0 = (t / ntk) * 64, sc0 = perm ? upcol(n0) : n0;
#pragma unroll
        for (int ps = 0; ps < 2; ++ps) { const int idx = tid + ps * NTHR, kk = idx >> 4, n4 = (idx & 15) * 4;
            const f32x4 v = *(const f32x4*)(src + (size_t)(k0 + kk) * ld + sc0 + n4);
            float* tp = tileL + kk * 65 + n4; tp[0] = v[0]; tp[1] = v[1]; tp[2] = v[2]; tp[3] = v[3]; }
        __syncthreads();
        { const int n = tid >> 3, k8 = (tid & 7) * 8; float e[8];
#pragma unroll
            for (int j = 0; j < 8; ++j) e[j] = tileL[(k8 + j) * 65 + n];
            u32x4 w; w.x = cvt_pk_bf16(e[0], e[1]); w.y = cvt_pk_bf16(e[2], e[3]); w.z = cvt_pk_bf16(e[4], e[5]); w.w = cvt_pk_bf16(e[6], e[7]);
            *(u32x4*)(dst + (size_t)(n0 + n) * K + k0 + k8) = w; }
        __syncthreads();
    }
}

__device__ void bias_task(int wv, const float* W, int ld, int perm, const float* sh, float* bias, int nb, int grp, float* red) {
    const int tid = otid(wv), quad = tid & 63, ksl = __builtin_amdgcn_readfirstlane(tid >> 6);
    const int nn = 256 * grp + 4 * quad, sc = perm ? upcol(nn) : nn;
    f32x4 a0 = {0, 0, 0, 0}, a1 = {0, 0, 0, 0}, a2 = {0, 0, 0, 0};
    const float* wp = W + (size_t)ksl * 128 * ld + sc; const float* s0 = sh + ksl * 128;
#pragma unroll 8
    for (int kk = 0; kk < 128; ++kk) { const f32x4 w = *(const f32x4*)(wp + (size_t)kk * ld); a0 += w * s0[kk]; a1 += w * s0[MODW + kk]; a2 += w * s0[2 * MODW + kk]; }
    float* rp = red + (ksl * 64 + quad) * 12;
    *(f32x4*)(rp) = a0; *(f32x4*)(rp + 4) = a1; *(f32x4*)(rp + 8) = a2;
    __syncthreads();
    for (int idx = tid; idx < 768; idx += NTHR) { const int q = idx & 63, e = idx >> 6; float s = 0.f;
        for (int k = 0; k < 8; ++k) s += red[(k * 64 + q) * 12 + e];
        bias[(size_t)(e >> 2) * nb + 256 * grp + 4 * q + (e & 3)] = s; }
    __syncthreads();
}

__device__ __forceinline__ f32x4 mfma16(bf16x8 a, bf16x8 b, f32x4 c) { return __builtin_amdgcn_mfma_f32_16x16x32_bf16(a, b, c, 0, 0, 0); }

__device__ void sg_phase(int wv, const Params& p, int jl, unsigned char* lds) {
    const int tid = otid(wv), lane = tid & 63, w = __builtin_amdgcn_readfirstlane(tid >> 6), lr = lane & 15, lq = lane >> 4;
    bf16_t* uv = (bf16_t*)(p.ws + WS_BIG1);
    const float* vss = (const float*)(p.ws + WS_SS) + (size_t)(9 + jl) * MTOK;
    constexpr int PW = 136;
    bf16_t* WsL = (bf16_t*)lds; bf16_t* VTL = WsL + 128 * PW; float* rsL = (float*)(VTL + 128 * PW);
    for (int unit = blockIdx.x; unit < 2048; unit += gridDim.x) {
        const int ch = unit >> 3, g = unit & 7, t0 = ch * 128;
        if (tid < 128) rsL[tid] = 1.0f / sqrtf(vss[t0 + tid] * (1.0f / DM) + EPSN);
        __syncthreads();
        const float* ws = p.a_w_s + ((size_t)jl * 8 + g) * 128 * 128;
#pragma unroll
        for (int ps = 0; ps < 8; ++ps) { const int idx = tid + ps * NTHR, t = idx >> 5, s4 = (idx & 31) * 4;
            const f32x4 wv = *(const f32x4*)(ws + t * 128 + s4); const f32x4 r4 = *(const f32x4*)(rsL + s4); const f32x4 x = wv * r4;
            u32x2 pk; pk.x = cvt_pk_bf16(x[0], x[1]); pk.y = cvt_pk_bf16(x[2], x[3]); *(u32x2*)(WsL + t * PW + s4) = pk; }
#pragma unroll
        for (int ps = 0; ps < 4; ++ps) { const int idx = tid + ps * NTHR, s = idx >> 4, d8 = (idx & 15) * 8;
            const bf16x8 v = *(const bf16x8*)(uv + (size_t)(t0 + s) * 2048 + 1024 + g * 128 + d8);
#pragma unroll
            for (int e = 0; e < 8; ++e) VTL[(d8 + e) * PW + s] = (bf16_t)v[e]; }
        __syncthreads();
        bf16x8 af[4];
#pragma unroll
        for (int kk = 0; kk < 4; ++kk) af[kk] = *(const bf16x8*)(WsL + (16 * w + lr) * PW + 32 * kk + 8 * lq);
        const int tok = t0 + 16 * w + lr; const float bs = p.a_b_s[((size_t)jl * 8 + g) * 128 + 16 * w + lr];
#pragma unroll
        for (int db = 0; db < 8; ++db) { f32x4 acc = {0, 0, 0, 0};
#pragma unroll
            for (int kk = 0; kk < 4; ++kk) { const bf16x8 bf = *(const bf16x8*)(VTL + (16 * db + lr) * PW + 32 * kk + 8 * lq); acc = mfma16(bf, af[kk], acc); }
            const int col = g * 128 + 16 * db + 4 * lq; const f32x4 gv = *(const f32x4*)(p.a_g_v + jl * DM + col);
            bf16_t* up = uv + (size_t)tok * 2048 + col; const u32x2 uu = *(const u32x2*)up;
            const float u0 = __uint_as_float(uu.x << 16), u1 = __uint_as_float(uu.x & 0xffff0000u), u2 = __uint_as_float(uu.y << 16), u3 = __uint_as_float(uu.y & 0xffff0000u);
            const f32x4 sv = acc * gv + bs; u32x2 o; o.x = cvt_pk_bf16(u0 * sv[0], u1 * sv[1]); o.y = cvt_pk_bf16(u2 * sv[2], u3 * sv[3]);
            *(u32x2*)up = o; }
        __syncthreads();
    }
}

__device__ void att_phase(int wv, const Params& p, unsigned char* lds) {
    const int tid = otid(wv), lane = tid & 63, w = __builtin_amdgcn_readfirstlane(tid >> 6), lr = lane & 15, lq = lane >> 4;
    bf16_t* qkv = (bf16_t*)(p.ws + WS_BIG1);
    constexpr int KP = 72, VP = 392;
    bf16_t* KL = (bf16_t*)lds; bf16_t* VTL = KL + 384 * KP;
    for (int unit = blockIdx.x; unit < 1024; unit += gridDim.x) {
        const int B = unit >> 2, kh = unit & 3;
        const int sb = B < 64 ? 0 : (B < 128 ? 64 : 128), se = B < 64 ? 64 : (B < 128 ? 128 : 256);
#pragma unroll
        for (int ps = 0; ps < 6; ++ps) { const int idx = tid + ps * NTHR, s = idx >> 3, c8 = (idx & 7) * 8; const int kb = B - 1 + (s >> 7);
            bf16x8 kv = {0, 0, 0, 0, 0, 0, 0, 0}, vv = {0, 0, 0, 0, 0, 0, 0, 0};
            if (kb >= sb && kb < se) { const bf16_t* rp = qkv + (size_t)(kb * 128 + (s & 127)) * 1536 + 64 * kh + c8; kv = *(const bf16x8*)(rp + 1024); vv = *(const bf16x8*)(rp + 1280); }
            *(bf16x8*)(KL + s * KP + c8) = kv;
#pragma unroll
            for (int e = 0; e < 8; ++e) VTL[(c8 + e) * VP + s] = (bf16_t)vv[e]; }
        __syncthreads();
        const int gq = w >> 1, h = 4 * kh + gq;
        const float slope = exp2f(-0.5f * (float)(h + 1)), sink = p.b_sinks[h];
        for (int rb = 0; rb < 4; ++rb) {
            const int qrow = 64 * (w & 1) + 16 * rb + lr;
            const size_t tokq = (size_t)B * 128 + qrow;
            bf16x8 qf[2];
#pragma unroll
            for (int kk = 0; kk < 2; ++kk) qf[kk] = *(const bf16x8*)(qkv + tokq * 1536 + 64 * h + 32 * kk + 8 * lq);
            f32x4 sc[24];
#pragma unroll
            for (int cb = 0; cb < 24; ++cb) { f32x4 a = {0, 0, 0, 0};
#pragma unroll
                for (int kk = 0; kk < 2; ++kk) { const bf16x8 kf = *(const bf16x8*)(KL + (16 * cb + lr) * KP + 32 * kk + 8 * lq); a = mfma16(kf, qf[kk], a); }
                sc[cb] = a; }
            float mx = sink;
#pragma unroll
            for (int cb = 0; cb < 24; ++cb) { const int kb = B - 1 + (cb >> 3); const bool bval = (kb >= sb && kb < se);
#pragma unroll
                for (int j = 0; j < 4; ++j) { const int krel = 16 * cb + 4 * lq + j - 128;
                    int dist = qrow - krel; dist = dist < 0 ? -dist : dist;
                    const float v = (bval && dist <= 128) ? sc[cb][j] * 0.125f - slope * (float)dist : -1e30f;
                    sc[cb][j] = v; mx = fmaxf(mx, v); } }
            mx = fmaxf(mx, __shfl_xor(mx, 16)); mx = fmaxf(mx, __shfl_xor(mx, 32));
            float sum = 0.f;
#pragma unroll
            for (int cb = 0; cb < 24; ++cb)
#pragma unroll
                for (int j = 0; j < 4; ++j) { const float e = __expf(sc[cb][j] - mx); sc[cb][j] = e; sum += e; }
            sum += __shfl_xor(sum, 16); sum += __shfl_xor(sum, 32);
            sum += __expf(sink - mx);
            const float inv = 1.0f / sum;
            f32x4 oa[4];
#pragma unroll
            for (int db = 0; db < 4; ++db) oa[db] = (f32x4){0, 0, 0, 0};
#pragma unroll
            for (int ks = 0; ks < 12; ++ks) {
                union { bf16x8 v; unsigned u[4]; } pf;
                pf.u[0] = cvt_pk_bf16_asm(sc[2 * ks][0], sc[2 * ks][1]); pf.u[1] = cvt_pk_bf16_asm(sc[2 * ks][2], sc[2 * ks][3]);
                pf.u[2] = cvt_pk_bf16_asm(sc[2 * ks + 1][0], sc[2 * ks + 1][1]); pf.u[3] = cvt_pk_bf16_asm(sc[2 * ks + 1][2], sc[2 * ks + 1][3]);
#pragma unroll
                for (int db = 0; db < 4; ++db) {
                    union { bf16x8 v; u32x2 h2[2]; } vf;
                    const bf16_t* vp = VTL + (16 * db + lr) * VP + 32 * ks + 4 * lq;
                    vf.h2[0] = *(const u32x2*)vp; vf.h2[1] = *(const u32x2*)(vp + 16);
                    oa[db] = mfma16(vf.v, pf.v, oa[db]); } }
#pragma unroll
            for (int db = 0; db < 4; ++db) { const f32x4 o = oa[db] * inv; u32x2 wv; wv.x = cvt_pk_bf16_asm(o[0], o[1]); wv.y = cvt_pk_bf16_asm(o[2], o[3]);
                *(u32x2*)(qkv + tokq * 1536 + 64 * h + 16 * db + 4 * lq) = wv; }
        }
        __syncthreads();
    }
}

template <int N1> __device__ void fft1_units(int wv, const Params& p, unsigned char* lds, int seq_lo, int nseq, int part, int nparts) {
    const int tid = otid(wv), lane = tid & 63, w = __builtin_amdgcn_readfirstlane(tid >> 6), lr = lane & 15, lq = lane >> 4;
    constexpr int PW = N1 + 8, NB = N1 / 16, NK = N1 / 32; constexpr int S = N1 * 128;
    const bf16_t* z = (const bf16_t*)(p.ws + WS_BIG1); bf16_t* A1 = (bf16_t*)(p.ws + WS_BIG2);
    const bf16_t* ctg = (const bf16_t*)(p.ws + WS_TAB + (N1 == 64 ? TAB_CT64 : TAB_CT128)); const bf16_t* stg = (const bf16_t*)(p.ws + WS_TAB + (N1 == 64 ? TAB_ST64 : TAB_ST128));
    bf16_t* CT = (bf16_t*)lds; bf16_t* ST = CT + N1 * PW; bf16_t* XT = ST + N1 * PW;
    for (int idx = tid; idx < N1 * N1 / 8; idx += NTHR) { const int r = idx / (N1 / 8), c8 = (idx % (N1 / 8)) * 8;
        *(bf16x8*)(CT + r * PW + c8) = *(const bf16x8*)(ctg + r * N1 + c8); *(bf16x8*)(ST + r * PW + c8) = *(const bf16x8*)(stg + r * N1 + c8); }
    __syncthreads();
    const int nunits = nseq * 128 * 8;
    for (int unit = part; unit < nunits; unit += nparts) {
        const int sq = unit / 1024, b = (unit >> 3) & 127, cb = unit & 7;
        const int seq = seq_lo + sq; const size_t sbase = (size_t)seq * 8192;
        for (int idx = tid; idx < N1 * 16; idx += NTHR) { const int a = idx >> 4, c8 = (idx & 15) * 8;
            const bf16x8 v = *(const bf16x8*)(z + (sbase + 128 * a + b) * DM + cb * 128 + c8);
#pragma unroll
            for (int e = 0; e < 8; ++e) XT[(c8 + e) * PW + a] = (bf16_t)v[e]; }
        __syncthreads();
        bf16x8 xf[NK];
#pragma unroll
        for (int kk = 0; kk < NK; ++kk) xf[kk] = *(const bf16x8*)(XT + (16 * w + lr) * PW + 32 * kk + 8 * lq);
#pragma unroll
        for (int i = 0; i < NB; ++i) { f32x4 ar = {0, 0, 0, 0}, as = {0, 0, 0, 0};
#pragma unroll
            for (int kk = 0; kk < NK; ++kk) { const bf16x8 cf = *(const bf16x8*)(CT + (16 * i + lr) * PW + 32 * kk + 8 * lq), sf = *(const bf16x8*)(ST + (16 * i + lr) * PW + 32 * kk + 8 * lq);
                ar = mfma16(xf[kk], cf, ar); as = mfma16(xf[kk], sf, as); }
            const int ka = 16 * i + lr; float tc, ts; sincospif(2.0f * (float)(b * ka) / (float)S, &ts, &tc);
            const f32x4 re = ar * tc - as * ts, im = -(as * tc) - ar * ts;
            bf16_t* op = A1 + (sbase + (size_t)ka * 128 + b) * 2048 + cb * 128 + 16 * w + 4 * lq;
            u32x2 o; o.x = cvt_pk_bf16(re[0], re[1]); o.y = cvt_pk_bf16(re[2], re[3]); *(u32x2*)op = o;
            o.x = cvt_pk_bf16(im[0], im[1]); o.y = cvt_pk_bf16(im[2], im[3]); *(u32x2*)(op + 1024) = o; }
        __syncthreads();
    }
}
__device__ void fft2_phase(int wv, const Params& p, unsigned char* lds) {
    const int tid = otid(wv), lane = tid & 63, w = __builtin_amdgcn_readfirstlane(tid >> 6), lr = lane & 15, lq = lane >> 4;
    constexpr int PW = 136;
    const bf16_t* A1 = (const bf16_t*)(p.ws + WS_BIG2); bf16_t* Y = (bf16_t*)(p.ws + WS_BIG1);
    const bf16_t* ctg = (const bf16_t*)(p.ws + WS_TAB + TAB_CT128); const bf16_t* stg = (const bf16_t*)(p.ws + WS_TAB + TAB_ST128);
    bf16_t* CT = (bf16_t*)lds; bf16_t* ST = CT + 128 * PW; bf16_t* XR = ST + 128 * PW; bf16_t* XI = XR + 128 * PW;
    for (int idx = tid; idx < 128 * 16; idx += NTHR) { const int r = idx >> 4, c8 = (idx & 15) * 8;
        *(bf16x8*)(CT + r * PW + c8) = *(const bf16x8*)(ctg + r * 128 + c8); *(bf16x8*)(ST + r * PW + c8) = *(const bf16x8*)(stg + r * 128 + c8); }
    __syncthreads();
    for (int unit = blockIdx.x; unit < 2048; unit += gridDim.x) {
        const int gi = unit >> 3, cb = unit & 7;
        const int seq = gi < 64 ? 0 : (gi < 128 ? 1 : 2); const int ka = gi - (seq == 0 ? 0 : (seq == 1 ? 64 : 128)); const int N1 = seq == 2 ? 128 : 64;
        const size_t sbase = (size_t)seq * 8192;
#pragma unroll
        for (int ps = 0; ps < 4; ++ps) { const int idx = tid + ps * NTHR, b = idx >> 4, c8 = (idx & 15) * 8;
            const bf16_t* rp = A1 + ((size_t)gi * 128 + b) * 2048 + cb * 128 + c8; const bf16x8 vr = *(const bf16x8*)rp, vi = *(const bf16x8*)(rp + 1024);
#pragma unroll
            for (int e = 0; e < 8; ++e) { XR[(c8 + e) * PW + b] = (bf16_t)vr[e]; XI[(c8 + e) * PW + b] = (bf16_t)vi[e]; } }
        __syncthreads();
        bf16x8 xr[4], xi[4], nxr[4];
#pragma unroll
        for (int kk = 0; kk < 4; ++kk) { xr[kk] = *(const bf16x8*)(XR + (16 * w + lr) * PW + 32 * kk + 8 * lq); xi[kk] = *(const bf16x8*)(XI + (16 * w + lr) * PW + 32 * kk + 8 * lq);
            union { bf16x8 v; unsigned u[4]; } t; t.v = xr[kk]; t.u[0] ^= 0x80008000u; t.u[1] ^= 0x80008000u; t.u[2] ^= 0x80008000u; t.u[3] ^= 0x80008000u; nxr[kk] = t.v; }
#pragma unroll
        for (int i = 0; i < 8; ++i) { f32x4 re = {0, 0, 0, 0}, im = {0, 0, 0, 0};
#pragma unroll
            for (int kk = 0; kk < 4; ++kk) { const bf16x8 cf = *(const bf16x8*)(CT + (16 * i + lr) * PW + 32 * kk + 8 * lq), sf = *(const bf16x8*)(ST + (16 * i + lr) * PW + 32 * kk + 8 * lq);
                re = mfma16(xr[kk], cf, re); re = mfma16(xi[kk], sf, re); im = mfma16(xi[kk], cf, im); im = mfma16(nxr[kk], sf, im); }
            const int kb = 16 * i + lr;
            bf16_t* op = Y + (sbase + (size_t)N1 * kb + ka) * 2048 + cb * 128 + 16 * w + 4 * lq;
            u32x2 o; o.x = cvt_pk_bf16(re[0], re[1]); o.y = cvt_pk_bf16(re[2], re[3]); *(u32x2*)op = o;
            o.x = cvt_pk_bf16(im[0], im[1]); o.y = cvt_pk_bf16(im[2], im[3]); *(u32x2*)(op + 1024) = o; }
        __syncthreads();
    }
}

__device__ void fix_phase(int wv, const Params& p, int li) {
    const float* edge = (const float*)(p.ws + WS_EDGE); const float* cw = (const float*)(p.ws + WS_CW) + (size_t)li * 4 * NUP; bf16_t* act = (bf16_t*)(p.ws + WS_ACT);
    const int total = 1024 * (FFD / 4);
    const int tid = otid(wv);
    for (int idx = blockIdx.x * NTHR + tid; idx < total; idx += gridDim.x * NTHR) {
        const int e = idx / (FFD / 4), c = (idx % (FFD / 4)) * 4; const int band = e >> 1, hi = e & 1; const int R = band * 64 + (hi ? 63 : 0);
        const int ca = (c >> 7) * 256 + (c & 127), cg_ = ca + 128;
        const bool seqstart = (R == 0 || R == 8192 || R == 16384), seqend = (R == 8191 || R == 16383 || R == 32767);
        const float* ep = edge + (size_t)band * 4 * NUP;
        f32x4 pa, pg, ua, ug, na, ng; const f32x4 zero = {0, 0, 0, 0};
        if (!hi) { pa = seqstart ? zero : *(const f32x4*)(ep - NUP + ca); pg = seqstart ? zero : *(const f32x4*)(ep - NUP + cg_);
            ua = *(const f32x4*)(ep + ca); ug = *(const f32x4*)(ep + cg_); na = *(const f32x4*)(ep + NUP + ca); ng = *(const f32x4*)(ep + NUP + cg_); }
        else { pa = *(const f32x4*)(ep + 2 * NUP + ca); pg = *(const f32x4*)(ep + 2 * NUP + cg_); ua = *(const f32x4*)(ep + 3 * NUP + ca); ug = *(const f32x4*)(ep + 3 * NUP + cg_);
            na = seqend ? zero : *(const f32x4*)(ep + 4 * NUP + ca); ng = seqend ? zero : *(const f32x4*)(ep + 4 * NUP + cg_); }
        const f32x4 a = *(const f32x4*)(cw + ca) * pa + *(const f32x4*)(cw + NUP + ca) * ua + *(const f32x4*)(cw + 2 * NUP + ca) * na + *(const f32x4*)(cw + 3 * NUP + ca);
        const f32x4 g = *(const f32x4*)(cw + cg_) * pg + *(const f32x4*)(cw + NUP + cg_) * ug + *(const f32x4*)(cw + 2 * NUP + cg_) * ng + *(const f32x4*)(cw + 3 * NUP + cg_);
        float o[4];
#pragma unroll
        for (int j = 0; j < 4; ++j) o[j] = a[j] * g[j] / (1.0f + __expf(-g[j]));
        u32x2 wv; wv.x = cvt_pk_bf16(o[0], o[1]); wv.y = cvt_pk_bf16(o[2], o[3]);
        *(u32x2*)(act + (size_t)R * FFD + c) = wv;
    }
}

#define XB_TMO      128
#define XB_XCNT(j)  (256  + 64 * (j))
#define XB_XSUB(j)  (1280 + 64 * (j))
#define XB_XGEN(j)  (2304 + 64 * (j))
#define XB_TOP      3328
#define XB_TOPGEN   3392
#define XCD_BAR_WORDS 3456
#define XB_SPIN_CAP (1u << 18)
__device__ __forceinline__ unsigned xb_ld(unsigned* p)              { return __hip_atomic_load(p, __ATOMIC_RELAXED, __HIP_MEMORY_SCOPE_AGENT); }
__device__ __forceinline__ unsigned xb_add(unsigned* p, unsigned v) { return __hip_atomic_fetch_add(p, v, __ATOMIC_RELAXED, __HIP_MEMORY_SCOPE_AGENT); }
__device__ __forceinline__ unsigned xb_xcc_id() { return (unsigned)__builtin_amdgcn_s_getreg((3 << 11) | 20) & 0xFu; }
#define XB_SPIN(cond, bar) do { unsigned _sp = 0; while (cond) { __builtin_amdgcn_s_sleep(1); \
    if ((++_sp & 255u) == 0u) { if (xb_ld(&(bar)[XB_TMO])) break; if (_sp > XB_SPIN_CAP) { atomicAdd(&(bar)[XB_TMO], 1u); break; } } } } while (0)
struct XcdBarrier { unsigned* bar; unsigned x; volatile LAS unsigned* st; };
__device__ __forceinline__ XcdBarrier xcd_barrier_post(unsigned* bar, volatile LAS unsigned* st) {
    XcdBarrier b; b.bar = bar; b.x = xb_xcc_id(); b.st = st;
    if (threadIdx.x == 0) (void)xb_add(&bar[XB_XCNT(b.x)], 1u);
    return b;
}
__device__ __forceinline__ void xcd_barrier_complete(unsigned* bar, unsigned x, unsigned& nloc, unsigned& nx) {
    const unsigned G = gridDim.x * gridDim.y * gridDim.z;
    unsigned sum, cnt, mine, sp = 0u;
    for (;;) {
        sum = 0u; cnt = 0u; mine = 0u;
#pragma unroll
        for (unsigned j = 0; j < 16; ++j) { const unsigned c = xb_ld(&bar[XB_XCNT(j)]); sum += c; cnt += (c > 0u) ? 1u : 0u; mine = (j == x) ? c : mine; }
        if (sum == G) break;
        __builtin_amdgcn_s_sleep(1);
        if ((++sp & 255u) == 0u) { if (xb_ld(&bar[XB_TMO])) break; if (sp > XB_SPIN_CAP) { atomicAdd(&bar[XB_TMO], 1u); break; } }
    }
    nloc = mine > 0u ? mine : 1u; nx = cnt > 0u ? cnt : 1u;
}
__device__ __forceinline__ void xcd_barrier(const XcdBarrier& b, int wv) {
    asm volatile("s_waitcnt vmcnt(0)" ::: "memory");
    __syncthreads();
    if (otid(wv) == 0) {
        unsigned* bar = b.bar;
        unsigned bx = (unsigned)__builtin_amdgcn_readfirstlane((int)xb_xcc_id()); asm volatile("" : "+s"(bx));
        __builtin_amdgcn_s_waitcnt(0);
        unsigned nloc = b.st[0], nx = b.st[1];
        if (nloc == 0u) { xcd_barrier_complete(bar, bx, nloc, nx); b.st[0] = nloc; b.st[1] = nx; }
        const unsigned old = xb_add(&bar[XB_XSUB(bx)], 1u);
        const unsigned gen = old / nloc;
        if (old + 1u == (gen + 1u) * nloc) {
            __builtin_amdgcn_fence(__ATOMIC_RELEASE, "agent");
            asm volatile("s_waitcnt vmcnt(0)" ::: "memory");
            const unsigned og = xb_add(&bar[XB_TOP], 1u);
            const unsigned tg = og / nx;
            if (og + 1u == (tg + 1u) * nx) xb_add(&bar[XB_TOPGEN], 1u);
            else XB_SPIN(xb_ld(&bar[XB_TOPGEN]) == tg, bar);
            __builtin_amdgcn_fence(__ATOMIC_ACQUIRE, "agent");
            xb_add(&bar[XB_XGEN(bx)], 1u);
            asm volatile("s_waitcnt vmcnt(0)" ::: "memory");
        } else {
            XB_SPIN(xb_ld(&bar[XB_XGEN(bx)]) == gen, bar);
            __builtin_amdgcn_fence(__ATOMIC_ACQUIRE, "agent");
            asm volatile("s_waitcnt vmcnt(0)" ::: "memory");
        }
    }
    __syncthreads();
}

__global__ void __launch_bounds__(NTHR, 2) mega(Params p) {
    extern __shared__ __attribute__((aligned(16))) unsigned char lds[];
    cg::grid_group grid = cg::this_grid();
    const int G = gridDim.x, bid = blockIdx.x;
    const int wv = __builtin_amdgcn_readfirstlane(threadIdx.x >> 6);
    volatile LAS unsigned* xst = (volatile LAS unsigned*)((LAS unsigned char*)lds + (LDS_BYTES - 16));
    if (threadIdx.x == 0) { xst[0] = 0u; xst[1] = 0u; }
    __syncthreads();
    const XcdBarrier xbar = xcd_barrier_post((unsigned*)(p.ws + WS_BAR), xst);
    float* ldsf = (float*)lds;
#define WSPTRS \
    size_t wsoff_ = 0; asm volatile("" : "+s"(wsoff_)); unsigned char* ws = p.ws + wsoff_; \
    float* ssb = (float*)(ws + WS_SS); float* mod = (float*)(ws + WS_MOD); float* gsT = (float*)(ws + WS_GS); \
    float* biasG1 = (float*)(ws + WS_BG1); float* biasUP = (float*)(ws + WS_BUP); float* cwT = (float*)(ws + WS_CW); \
    bf16_t* xb = (bf16_t*)(ws + WS_XB); bf16_t* big1 = (bf16_t*)(ws + WS_BIG1); \
    bf16_t* wain = (bf16_t*)(ws + WS_WAIN); bf16_t* waout = (bf16_t*)(ws + WS_WAOUT); bf16_t* wqkv = (bf16_t*)(ws + WS_WQKV); bf16_t* wo = (bf16_t*)(ws + WS_WO); \
    bf16_t* wcin = (bf16_t*)(ws + WS_WCIN); bf16_t* wf = (bf16_t*)(ws + WS_WF); bf16_t* wup = (bf16_t*)(ws + WS_WUP); bf16_t* wdn = (bf16_t*)(ws + WS_WDN); \
    (void)ssb; (void)mod; (void)gsT; (void)biasG1; (void)biasUP; (void)cwT; (void)xb; (void)big1; (void)wain; (void)waout; (void)wqkv; (void)wo; (void)wcin; (void)wf; (void)wup; (void)wdn;
    {
    WSPTRS
    const int tid = otid(wv);
    for (int idx = bid * NTHR + tid; idx < 10 * MTOK / 4; idx += G * NTHR) *(f32x4*)(ssb + MTOK + 4 * (size_t)idx) = (f32x4){0.f, 0.f, 0.f, 0.f};
    if (bid < 192) mod_task(wv, p, bid, ldsf);
    { bf16_t* tab = (bf16_t*)(ws + WS_TAB);
        for (int idx = bid * NTHR + tid; idx < 4096 + 16384; idx += G * NTHR) {
            if (idx < 4096) { const int ka = idx >> 6, a = idx & 63; const float x = 2.0f * (float)((ka * a) & 63) / 64.0f; tab[TAB_CT64 / 2 + idx] = f2bf(cospif(x) * 0.125f); tab[TAB_ST64 / 2 + idx] = f2bf(sinpif(x) * 0.125f); }
            else { const int i2 = idx - 4096, ka = i2 >> 7, a = i2 & 127; const float x = 2.0f * (float)((ka * a) & 127) / 128.0f; tab[TAB_CT128 / 2 + i2] = f2bf(cospif(x) * 0.08838834764831845f); tab[TAB_ST128 / 2 + i2] = f2bf(sinpif(x) * 0.08838834764831845f); } } }
    if (bid >= G - 128) wf_task(wv, p, bid - (G - 128), ldsf);
    convert_matrix(wv, p.a_w_in, 1024, 2048, 2048, 0, wain, ldsf, 0);
    convert_matrix(wv, p.a_w_in + (size_t)1024 * 2048, 1024, 2048, 2048, 0, wain + (size_t)2048 * 1024, ldsf, 64);
    convert_matrix(wv, p.a_w_out, 1024, 1024, 1024, 0, waout, ldsf, 128);
    convert_matrix(wv, p.a_w_out + (size_t)1024 * 1024, 1024, 1024, 1024, 0, waout + (size_t)1024 * 1024, ldsf, 192);
    convert_matrix(wv, p.b_w_qkv, 1024, 1536, 1536, 0, wqkv, ldsf, 32);
    convert_matrix(wv, p.b_w_o, 1024, 1024, 1024, 0, wo, ldsf, 96);
    convert_matrix(wv, p.c_w_in, 1024, 1024, 1024, 0, wcin, ldsf, 160);
    convert_matrix(wv, p.f_w_up, 1024, NUP, NUP, 1, wup, ldsf, 224);
    convert_matrix(wv, p.f_w_down, FFD, 1024, 1024, 0, wdn, ldsf, 16);
    grid.sync();

    }
    {
    WSPTRS
    const int tid = otid(wv);
    if (bid < 48) {
        if (bid < 8) bias_task(wv, p.a_w_in, 2048, 0, mod, biasG1, 2048, bid, ldsf);
        else if (bid < 14) bias_task(wv, p.b_w_qkv, 1536, 0, mod + 3 * MODW, biasG1 + 3 * 2048, 1536, bid - 8, ldsf);
        else if (bid < 18) bias_task(wv, p.c_w_in, 1024, 0, mod + 6 * MODW, biasG1 + 6 * 2048, 1024, bid - 14, ldsf);
        else if (bid < 26) bias_task(wv, p.a_w_in + (size_t)1024 * 2048, 2048, 0, mod + 9 * MODW, biasG1 + 9 * 2048, 2048, bid - 18, ldsf);
        else bias_task(wv, p.f_w_up, NUP, 1, mod + 3 * DM, biasUP, NUP, bid - 26, ldsf);
    }
    for (int idx = bid * NTHR + tid; idx < 9 * 3 * DM; idx += G * NTHR) { const int ni = idx / (3 * DM), seq = (idx / DM) % 3, c = idx % DM;
        float v; if (ni == 8) v = p.g_final[c]; else { const int i = ni >> 1, t = ni & 1; v = p.norm_g[(i * 2 + t) * DM + c] * (1.0f + mod[((size_t)i * 3 + seq) * MODW + (t ? 4 : 1) * DM + c]); }
        gsT[idx] = v; }
    for (int idx = bid * NTHR + tid; idx < 4 * 4 * NUP; idx += G * NTHR) { const int i = idx / (4 * NUP), q = (idx / NUP) & 3, n = idx % NUP; const int oc = upcol(n);
        cwT[idx] = q < 3 ? p.f_w_conv[((size_t)i * 3 + q) * NUP + oc] : p.f_b_conv[(size_t)i * NUP + oc]; }
    convert_matrix(wv, (const float*)(ws + WS_WF32), 2048, 1024, 1024, 0, wf, ldsf, 48);
    { const int wid = tid >> 6, lane = tid & 63;
        for (int r = bid * 8 + wid; r < MTOK; r += G * 8) { const int seq = seq_of_row(r);
            const float* xr = r < 16384 ? p.xp + (size_t)r * DM : p.xs + (size_t)(r - 16384) * DM; float s = 0.f; f32x4 v[4];
#pragma unroll
            for (int jj = 0; jj < 4; ++jj) { v[jj] = *(const f32x4*)(xr + jj * 256 + 4 * lane); s += (v[jj][0] * v[jj][0] + v[jj][1] * v[jj][1]) + (v[jj][2] * v[jj][2] + v[jj][3] * v[jj][3]); }
#pragma unroll
            for (int o = 32; o >= 1; o >>= 1) s += __shfl_xor(s, o);
            if (lane == 0) ssb[r] = s;
#pragma unroll
            for (int jj = 0; jj < 4; ++jj) { const int c = jj * 256 + 4 * lane; u32x2 wv; float h[4];
#pragma unroll
                for (int j = 0; j < 4; ++j) h[j] = v[jj][j] * (p.norm_g[c + j] * (1.0f + mod[(size_t)seq * MODW + DM + c + j]));
                wv.x = cvt_pk_bf16(h[0], h[1]); wv.y = cvt_pk_bf16(h[2], h[3]); *(u32x2*)(xb + (size_t)r * DM + c) = wv; } } }
    xcd_barrier(xbar, wv);
    }

    LAS unsigned char* ldsl = (LAS unsigned char*)lds;
    for (int i = 0; i < 4; ++i) {
        WSPTRS
        const int kind = i % 3, jl = i / 3;
        {   pg8::StaticOrder S; const float* ssin = ssb + (size_t)(2 * i) * MTOK;
            if (kind == 0) { pg8::Gemm g{xb, wain + (size_t)jl * 2048 * 1024, MTOK, 2048, 1024, 1024}; S.init(MTOK, 2048, G, bid);
                pg8::EpiAct<1> E{big1, 2048, biasG1 + (size_t)i * 3 * 2048, 2048, ssin, ssb + (size_t)(9 + jl) * MTOK, 1024};
#ifndef NO_G1A
                pg8::gemm_phase<pg8::EpiAct<1>>(wv, ldsl, g, S, E);
#endif
 }
            else { const int N = kind == 1 ? 1536 : 1024; pg8::Gemm g{xb, kind == 1 ? wqkv : wcin, MTOK, N, 1024, 1024}; S.init(MTOK, N, G, bid);
                pg8::EpiAct<0> E{big1, N, biasG1 + (size_t)i * 3 * 2048, N, ssin, nullptr, 0};
#ifndef NO_G1B
                pg8::gemm_phase<pg8::EpiAct<0>>(wv, ldsl, g, S, E);
#endif
 }
        }
        xcd_barrier(xbar, wv);
#ifndef NO_SG
        if (kind == 0) sg_phase(wv, p, jl, lds);
#endif
#ifndef NO_ATT
        if (kind == 1) att_phase(wv, p, lds);
#endif
#ifndef NO_FFT
        if (kind == 2) {
#ifndef NO_FFT1
            if (bid < G / 2) fft1_units<64>(wv, p, lds, 0, 2, bid, G / 2); else fft1_units<128>(wv, p, lds, 2, 1, bid - G / 2, G - G / 2);
#endif
            xcd_barrier(xbar, wv);
#ifndef NO_FFT2
            fft2_phase(wv, p, lds);
#endif
        }
#endif
        xcd_barrier(xbar, wv);
        for (int half = 0; half < 2; ++half) {
            if (half == 1) {
                {   pg8::Gemm g{xb, wup + (size_t)(i & 1) * NUP * 1024, MTOK, NUP, 1024, 1024}; pg8::StaticOrder S; S.init(MTOK, NUP, G, bid);
                    pg8::EpiUp E{(bf16_t*)(ws + WS_ACT), biasUP + (size_t)(i & 1) * 3 * NUP, cwT + (size_t)i * 4 * NUP, ssb + (size_t)(2 * i + 1) * MTOK, (float*)(ws + WS_EDGE)};
#ifndef NO_UP
                    pg8::gemm_phase<pg8::EpiUp>(wv, ldsl, g, S, E);
#endif
 }
                xcd_barrier(xbar, wv);
                fix_phase(wv, p, i);
                if (i < 3) {
                    convert_matrix(wv, p.f_w_up + (size_t)(i + 1) * 1024 * NUP, 1024, NUP, NUP, 1, wup + (size_t)((i + 1) & 1) * NUP * 1024, ldsf, 0);
                    convert_matrix(wv, p.f_w_down + (size_t)(i + 1) * FFD * 1024, FFD, 1024, 1024, 0, wdn + (size_t)((i + 1) & 1) * 1024 * FFD, ldsf, 128);
                    if (bid >= G - 22) bias_task(wv, p.f_w_up + (size_t)(i + 1) * 1024 * NUP, NUP, 1, mod + (size_t)(i + 1) * 3 * MODW + 3 * DM, biasUP + (size_t)((i + 1) & 1) * 3 * NUP, NUP, bid - (G - 22), ldsf);
                }
                xcd_barrier(xbar, wv);
            }
            pg8::Gemm g; const float* gate; const float* gsn; bf16_t* xbo = xb; float* ssn; const float* b0 = p.out; const float* b1 = p.out + (size_t)16384 * DM;
            if (half == 0) {
                if (kind == 0) g = pg8::Gemm{big1, waout + (size_t)jl * 1024 * 1024, MTOK, 1024, 1024, 2048};
                else if (kind == 1) g = pg8::Gemm{big1, wo, MTOK, 1024, 1024, 1536};
                else g = pg8::Gemm{big1, wf, MTOK, 1024, 2048, 2048};
                gate = mod + (size_t)i * 3 * MODW + 2 * DM; gsn = gsT + (size_t)(2 * i + 1) * 3 * DM; ssn = ssb + (size_t)(2 * i + 1) * MTOK;
                if (i == 0) { b0 = p.xp; b1 = p.xs; }
            } else {
                g = pg8::Gemm{(const bf16_t*)(ws + WS_ACT), wdn + (size_t)(i & 1) * 1024 * FFD, MTOK, 1024, FFD, FFD};
                gate = mod + (size_t)i * 3 * MODW + 5 * DM; gsn = gsT + (size_t)(2 * i + 2) * 3 * DM; ssn = ssb + (size_t)(2 * i + 2) * MTOK;
                if (i == 3) xbo = nullptr;
            }
            pg8::StaticOrder S; S.init(MTOK, 1024, G, bid);
            pg8::EpiRes E{b0, b1, p.out, gate, gsn, xbo, ssn};
#ifndef NO_RES
            pg8::gemm_phase<pg8::EpiRes>(wv, ldsl, g, S, E);
#endif
            xcd_barrier(xbar, wv);
        }
    }
    { const float* ssF = (const float*)(p.ws + WS_SS) + (size_t)8 * MTOK; const int tid = otid(wv);
        for (size_t idx = (size_t)bid * NTHR + tid; idx < (size_t)MTOK * DM / 4; idx += (size_t)G * NTHR) { const int r = (int)(idx >> 8), c = (int)(idx & 255) * 4;
            const float rs = 1.0f / sqrtf(ssF[r] * (1.0f / DM) + EPSN); f32x4 v = *(const f32x4*)(p.out + (size_t)r * DM + c); const f32x4 gf = *(const f32x4*)(p.g_final + c);
            v = v * rs * gf; *(f32x4*)(p.out + (size_t)r * DM + c) = v; } }
}

extern "C" void kernel_launch(void* const* d_in, const int* in_sizes, int n_in, void* d_out, int out_size, void* d_ws, size_t ws_size, hipStream_t stream) {
    static int grid_blocks = 0;
    if (!grid_blocks) {
        if (ws_size < WS_END) { fprintf(stderr, "kernel_launch: workspace too small: %zu < %zu\n", ws_size, (size_t)WS_END); grid_blocks = -1; return; }
        int dev = 0, cus = 0, per_cu = 0;
        hipGetDevice(&dev);
        hipDeviceGetAttribute(&cus, hipDeviceAttributeMultiprocessorCount, dev);
        hipFuncSetAttribute((const void*)mega, hipFuncAttributeMaxDynamicSharedMemorySize, LDS_BYTES);
        hipOccupancyMaxActiveBlocksPerMultiprocessor(&per_cu, (const void*)mega, NTHR, LDS_BYTES);
        if (per_cu < 1) { fprintf(stderr, "kernel_launch: occupancy query says %d blocks per CU\n", per_cu); per_cu = 1; }
        grid_blocks = cus;
        (void)hipGetLastError();
    }
    if (grid_blocks < 0) return;
    if (hipMemsetAsync((char*)d_ws + WS_BAR, 0, BAR_BYTES, stream) != hipSuccess) { fprintf(stderr, "kernel_launch: memset of the barrier words failed\n"); return; }
    Params p{};
    p.xp = (const float*)d_in[0]; p.xs = (const float*)d_in[1]; p.cp = (const float*)d_in[2]; p.csm = (const float*)d_in[3]; p.w_ada = (const float*)d_in[4]; p.b_ada = (const float*)d_in[5];
    p.norm_g = (const float*)d_in[6]; p.a_w_in = (const float*)d_in[7]; p.a_g_v = (const float*)d_in[8]; p.a_w_s = (const float*)d_in[9]; p.a_b_s = (const float*)d_in[10]; p.a_w_out = (const float*)d_in[11];
    p.b_w_qkv = (const float*)d_in[12]; p.b_sinks = (const float*)d_in[13]; p.b_w_o = (const float*)d_in[14]; p.c_w_in = (const float*)d_in[15]; p.c_w_out = (const float*)d_in[16];
    p.f_w_up = (const float*)d_in[17]; p.f_w_conv = (const float*)d_in[18]; p.f_b_conv = (const float*)d_in[19]; p.f_w_down = (const float*)d_in[20]; p.g_final = (const float*)d_in[21];
    p.out = (float*)d_out; p.ws = (unsigned char*)d_ws;
    void* args[] = {&p};
    hipError_t e = hipLaunchCooperativeKernel((const void*)mega, dim3(grid_blocks), dim3(NTHR), args, LDS_BYTES, stream);
    if (e != hipSuccess) fprintf(stderr, "cooperative launch failed: %s (grid %d)\n", hipGetErrorString(e), grid_blocks);
}
```

```cpp
#include <hip/hip_runtime.h>
#include <hip/hip_cooperative_groups.h>
#include <cstdio>
namespace cg = cooperative_groups;

#define LAS __attribute__((address_space(3)))
typedef unsigned short bf16_t;
typedef short bf16x8 __attribute__((ext_vector_type(8)));
typedef short bf16x4 __attribute__((ext_vector_type(4)));
typedef float f32x4 __attribute__((ext_vector_type(4)));
typedef unsigned u32x4 __attribute__((ext_vector_type(4)));
typedef unsigned u32x2 __attribute__((ext_vector_type(2)));

constexpr int DM = 1024, MTOK = 32768, FFD = 2816, NUP = 5632, MODW = 6144;
constexpr float EPSN = 1e-6f;
constexpr int NTHR = 512;
constexpr int LDS_BYTES = 147456;

constexpr size_t al256(size_t x) { return (x + 255) & ~(size_t)255; }
constexpr size_t WS_SS = 0;
constexpr size_t SS_BYTES = (size_t)11 * MTOK * 4;
constexpr size_t WS_MOD = al256(WS_SS + SS_BYTES);
constexpr size_t WS_GS = al256(WS_MOD + (size_t)4 * 3 * MODW * 4);
constexpr size_t WS_BG1 = al256(WS_GS + (size_t)9 * 3 * DM * 4);
constexpr size_t WS_BUP = al256(WS_BG1 + (size_t)4 * 3 * 2048 * 4);
constexpr size_t WS_CW = al256(WS_BUP + (size_t)2 * 3 * NUP * 4);
constexpr size_t WS_TAB = al256(WS_CW + (size_t)4 * 4 * NUP * 4);
constexpr size_t TAB_CT64 = 0, TAB_ST64 = 8192, TAB_CT128 = 16384, TAB_ST128 = 16384 + 32768;
constexpr size_t WS_BAR = al256(WS_TAB + 81920);
constexpr size_t BAR_BYTES = 3456 * 4;
constexpr size_t WS_WF32 = al256(WS_BAR + BAR_BYTES);
constexpr size_t WS_WAIN = al256(WS_WF32 + (size_t)2048 * 1024 * 4);
constexpr size_t WS_WAOUT = al256(WS_WAIN + (size_t)2 * 2048 * 1024 * 2);
constexpr size_t WS_WQKV = al256(WS_WAOUT + (size_t)2 * 1024 * 1024 * 2);
constexpr size_t WS_WO = al256(WS_WQKV + (size_t)1536 * 1024 * 2);
constexpr size_t WS_WCIN = al256(WS_WO + (size_t)1024 * 1024 * 2);
constexpr size_t WS_WF = al256(WS_WCIN + (size_t)1024 * 1024 * 2);
constexpr size_t WS_WUP = al256(WS_WF + (size_t)1024 * 2048 * 2);
constexpr size_t WS_WDN = al256(WS_WUP + (size_t)2 * NUP * 1024 * 2);
constexpr size_t WS_XB = al256(WS_WDN + (size_t)2 * 1024 * FFD * 2);
constexpr size_t WS_BIG1 = al256(WS_XB + (size_t)MTOK * DM * 2);
constexpr size_t WS_BIG2 = al256(WS_BIG1 + (size_t)MTOK * 2048 * 2);
constexpr size_t WS_ACT = WS_BIG1;
constexpr size_t WS_EDGE = al256(WS_ACT + (size_t)MTOK * FFD * 2);
constexpr size_t WS_END = al256(WS_BIG2 + (size_t)MTOK * 2048 * 2);
static_assert(WS_EDGE + (size_t)512 * 4 * NUP * 4 <= WS_END, "edge buffer must fit");

struct Params {
    const float* xp; const float* xs; const float* cp; const float* csm; const float* w_ada; const float* b_ada; const float* norm_g;
    const float* a_w_in; const float* a_g_v; const float* a_w_s; const float* a_b_s; const float* a_w_out;
    const float* b_w_qkv; const float* b_sinks; const float* b_w_o; const float* c_w_in; const float* c_w_out;
    const float* f_w_up; const float* f_w_conv; const float* f_b_conv; const float* f_w_down; const float* g_final;
    float* out; unsigned char* ws;
};

__device__ __forceinline__ int otid(int wv) { int t; asm volatile("v_mbcnt_lo_u32_b32 %0, -1, 0\n\tv_mbcnt_hi_u32_b32 %0, -1, %0\n\tv_lshl_add_u32 %0, %1, 6, %0" : "=&v"(t) : "s"(wv)); return t; }
typedef __bf16 bf2_t __attribute__((ext_vector_type(2)));
typedef float f2_t __attribute__((ext_vector_type(2)));
__device__ __forceinline__ unsigned cvt_pk_bf16_asm(float lo, float hi) { unsigned r; asm volatile("v_cvt_pk_bf16_f32 %0, %1, %2" : "=v"(r) : "v"(lo), "v"(hi)); return r; }
__device__ __forceinline__ unsigned cvt_pk_bf16(float lo, float hi) { const f2_t v = {lo, hi}; const bf2_t b = __builtin_convertvector(v, bf2_t); return __builtin_bit_cast(unsigned, b); }
__device__ __forceinline__ bf16_t f2bf(float f) { return (bf16_t)(cvt_pk_bf16(f, 0.f) & 0xffffu); }
__device__ __forceinline__ int seq_of_row(int r) { return r < 8192 ? 0 : (r < 16384 ? 1 : 2); }
__device__ __forceinline__ int upcol(int n) { return (n >> 8) * 128 + (n & 127) + ((n & 128) ? FFD : 0); }

namespace pg8 {
constexpr int BM = 256, BK = 64, HALF = 128, HTB = HALF * BK * 2, STAGE_BYTES = 8 * HTB, NXCD = 8, WGM = 8;
__device__ __forceinline__ int lds_byte(int r, int c) { const int st = (r >> 4) * 2 + (c >> 5), rr = r & 15, cc = c & 31, ob = rr * 64 + cc * 2; return st * 1024 + (ob ^ (((ob >> 9) & 1) << 5)); }
__device__ __forceinline__ void stage_rc(int b, int& R, int& C) { const int st = b / 1024, sb = b % 1024, swz = sb ^ (((sb >> 9) & 1) << 5); R = (st >> 1) * 16 + swz / 64; C = (st & 1) * 32 + (swz % 64) / 2; }
__device__ __forceinline__ int perm32(int rho) { const int n = rho >> 4, i = rho & 15; return 8 * (i >> 2) + 4 * n + (i & 3); }
struct Unit { int pm, pn; };
struct Gemm { const bf16_t* A; const bf16_t* Bt; int M, N, K, lda; };
struct StaticOrder {
    int nM, nN, nwg, G, c;
    __device__ void init(int M, int N, int G_, int c_) { nM = M / BM; nN = N / BM; nwg = nM * nN; G = G_; c = c_; }
    __device__ bool next(int i, Unit& u) const {
        const long L = (long)i * G + c; if (L >= nwg) return false;
        int wgid = (int)L; { const int q = nwg / NXCD, r = nwg % NXCD, xcd = wgid % NXCD, off = wgid / NXCD; wgid = (xcd < r ? xcd * (q + 1) : r * (q + 1) + (xcd - r) * q) + off; }
        const int nig = WGM * nN, gid = wgid / nig, fm = gid * WGM, gsz = (nM - fm) < WGM ? (nM - fm) : WGM;
        u.pm = fm + ((wgid % nig) % gsz); u.pn = (wgid % nig) / gsz; return true;
    }
};

template <class Epi>
__device__ __forceinline__ void gemm_phase(int wv, LAS unsigned char* lds, const Gemm g, const StaticOrder& S, const Epi& E) {
    const int tid = otid(wv), wid = __builtin_amdgcn_readfirstlane(tid >> 6), lane = tid & 63, wr = wid >> 2, wc = wid & 3, fr = lane & 15, fq = lane >> 4;
    const int K = g.K, nt = K / BK, lda = g.lda;
    unsigned voffA[2], voffB[2];
#pragma unroll
    for (int i = 0; i < 2; ++i) { int R, C; stage_rc(tid * 16 + i * 8192, R, C); const int Rb = Epi::PERM ? ((R & ~31) + perm32(R & 31)) : R;
        voffA[i] = (unsigned)(R * lda + C) * 2u; voffB[i] = (unsigned)(Rb * K + C) * 2u; }
    const size_t kstep = (size_t)(BK * 2);
    const size_t hstepA = (size_t)HALF * lda * 2, hstepB = (size_t)HALF * K * 2;
    const size_t tstepA = 2 * hstepA, tstepB = 2 * hstepB;
    const unsigned ldsw = (unsigned)wid * 1024u;
    const int aoff = lds_byte(wr * 64 + fr, fq * 8), boff = lds_byte(wc * 32 + fr, fq * 8);
#define PG8_SA(b, h) (((b) * 2 + (h)) * HTB)
#define PG8_SB(b, h) ((4 + (b) * 2 + (h)) * HTB)
#define PG8_STAGE(bufoff, gbase, voff) do { _Pragma("unroll") for (int _i = 0; _i < 2; ++_i) \
        __builtin_amdgcn_global_load_lds((const unsigned*)((const char*)(gbase) + (voff)[_i]), (LAS unsigned*)(lds + (bufoff) + ldsw + _i * 8192), 16, 0, 0); } while (0)
#define PG8_LDA(dst, b, h) do { _Pragma("unroll") for (int m = 0; m < 4; ++m) _Pragma("unroll") for (int k = 0; k < 2; ++k) dst[m][k] = *(const LAS bf16x8*)(lds + PG8_SA(b, h) + aoff + m * 2048 + k * 1024); } while (0)
#define PG8_LDB(dst, b, h) do { _Pragma("unroll") for (int n = 0; n < 2; ++n) _Pragma("unroll") for (int k = 0; k < 2; ++k) dst[n][k] = *(const LAS bf16x8*)(lds + PG8_SB(b, h) + boff + n * 2048 + k * 1024); } while (0)
#define PG8_MMA(ai, bj, At, Bt) do { __builtin_amdgcn_s_setprio(1); _Pragma("unroll") for (int m = 0; m < 4; ++m) _Pragma("unroll") for (int n = 0; n < 2; ++n) _Pragma("unroll") for (int k = 0; k < 2; ++k) \
        acc[ai][bj][m][n] = __builtin_amdgcn_mfma_f32_16x16x32_bf16(Bt[n][k], At[m][k], acc[ai][bj][m][n], 0, 0, 0); __builtin_amdgcn_s_setprio(0); } while (0)
#define PG8_WAIT_V(n) asm volatile("s_waitcnt vmcnt(" #n ")" ::: "memory")
#define PG8_WAIT_L(n) asm volatile("s_waitcnt lgkmcnt(" #n ")" ::: "memory")
#define PG8_BAR __builtin_amdgcn_s_barrier()
#define PG8_SCHED __builtin_amdgcn_sched_barrier(0)
    Unit cur, nxt; int ui = 0;
    if (!S.next(0, cur)) return;
    f32x4 acc[2][2][4][2];
#pragma unroll
    for (int a = 0; a < 2; ++a)
#pragma unroll
        for (int b = 0; b < 2; ++b)
#pragma unroll
            for (int m = 0; m < 4; ++m)
#pragma unroll
                for (int n = 0; n < 2; ++n) acc[a][b][m][n] = (f32x4){0.f, 0.f, 0.f, 0.f};
    bf16x8 At[4][2], B0[2][2], B1[2][2];
    const char* cA = (const char*)g.A + (size_t)cur.pm * tstepA; const char* cB = (const char*)g.Bt + (size_t)cur.pn * tstepB;
    PG8_STAGE(PG8_SB(0, 0), cB, voffB); PG8_STAGE(PG8_SA(0, 0), cA, voffA); PG8_STAGE(PG8_SB(0, 1), cB + hstepB, voffB); PG8_STAGE(PG8_SA(0, 1), cA + hstepA, voffA);
    if (wr == 1) PG8_BAR;
    PG8_WAIT_V(4); PG8_BAR;
    PG8_STAGE(PG8_SB(1, 0), cB + kstep, voffB); PG8_STAGE(PG8_SA(1, 0), cA + kstep, voffA); PG8_STAGE(PG8_SB(1, 1), cB + hstepB + kstep, voffB);
    PG8_WAIT_V(6); PG8_BAR;
    for (;;) {
        const bool has_next = S.next(ui + 1, nxt);
        const char* nA = has_next ? (const char*)g.A + (size_t)nxt.pm * tstepA : cA; const char* nB = has_next ? (const char*)g.Bt + (size_t)nxt.pn * tstepB : cB;
        for (int t = 0; t < nt; t += 2) {
            const bool last = (t == nt - 2);
            const char* a1 = cA + (size_t)(t + 1) * kstep;
            const char* a2 = last ? nA : cA + (size_t)(t + 2) * kstep; const char* b2 = last ? nB : cB + (size_t)(t + 2) * kstep;
            const char* a3 = a2 + kstep; const char* b3 = b2 + kstep;
            PG8_LDB(B0, 0, 0); PG8_SCHED; PG8_LDA(At, 0, 0); PG8_STAGE(PG8_SA(1, 1), a1 + hstepA, voffA);
            PG8_WAIT_L(8); PG8_BAR; PG8_WAIT_L(0); PG8_MMA(0, 0, At, B0); PG8_BAR; PG8_SCHED;
            PG8_LDB(B1, 0, 1); PG8_STAGE(PG8_SB(0, 0), b2, voffB);
            PG8_BAR; PG8_WAIT_L(0); PG8_MMA(0, 1, At, B1); PG8_BAR;
            PG8_LDA(At, 0, 1); PG8_STAGE(PG8_SA(0, 0), a2, voffA);
            PG8_BAR; PG8_WAIT_L(0); PG8_MMA(1, 0, At, B0); PG8_BAR; PG8_SCHED;
            PG8_STAGE(PG8_SB(0, 1), b2 + hstepB, voffB);
            PG8_WAIT_V(6); PG8_BAR; PG8_MMA(1, 1, At, B1); PG8_BAR;
            PG8_LDB(B0, 1, 0); PG8_SCHED; PG8_LDA(At, 1, 0); PG8_STAGE(PG8_SA(0, 1), a2 + hstepA, voffA);
            PG8_WAIT_L(8); PG8_BAR; PG8_WAIT_L(0); PG8_MMA(0, 0, At, B0); PG8_BAR; PG8_SCHED;
            PG8_LDB(B1, 1, 1); PG8_STAGE(PG8_SB(1, 0), b3, voffB);
            PG8_BAR; PG8_WAIT_L(0); PG8_MMA(0, 1, At, B1); PG8_BAR;
            PG8_LDA(At, 1, 1); PG8_STAGE(PG8_SA(1, 0), a3, voffA);
            PG8_BAR; PG8_WAIT_L(0); PG8_MMA(1, 0, At, B0); PG8_BAR; PG8_SCHED;
            PG8_STAGE(PG8_SB(1, 1), b3 + hstepB, voffB);
            PG8_WAIT_V(6); PG8_BAR; PG8_MMA(1, 1, At, B1); PG8_BAR;
        }
        E(acc, cur, wr, wc, fr, fq);
        if (!has_next) break;
#pragma unroll
        for (int a = 0; a < 2; ++a)
#pragma unroll
            for (int b = 0; b < 2; ++b)
#pragma unroll
                for (int m = 0; m < 4; ++m)
#pragma unroll
                    for (int n = 0; n < 2; ++n) acc[a][b][m][n] = (f32x4){0.f, 0.f, 0.f, 0.f};
        cur = nxt; cA = nA; cB = nB; ++ui;
    }
    PG8_WAIT_V(0);
    if (wr == 0) PG8_BAR;
    PG8_BAR;
#undef PG8_SA
#undef PG8_SB
#undef PG8_STAGE
#undef PG8_LDA
#undef PG8_LDB
#undef PG8_MMA
#undef PG8_WAIT_V
#undef PG8_WAIT_L
#undef PG8_BAR
#undef PG8_SCHED
}

typedef float f32x2 __attribute__((ext_vector_type(2)));
__device__ __forceinline__ f32x2 gelu_pk(f32x2 v) {
    const f32x2 av = __builtin_elementwise_abs(v), d = av * 0.2316418882f + 1.0f;
    f32x2 t; t.x = __builtin_amdgcn_rcpf(d.x); t.y = __builtin_amdgcn_rcpf(d.y);
    f32x2 q = t * 0.5307027145f + (-0.7265760135f); q = q * t + 0.7107068705f; q = q * t + (-0.142248368f); q = q * t + 0.127414796f; q = q * t;
    const f32x2 s = (v * v) * (-0.72134752044f);
    f32x2 e; e.x = __builtin_amdgcn_exp2f(s.x); e.y = __builtin_amdgcn_exp2f(s.y);
    const f32x2 m = v * (q * e), r = v - m;
    f32x2 o; o.x = v.x < 0.f ? m.x : r.x; o.y = v.y < 0.f ? m.y : r.y; return o;
}
__device__ __forceinline__ f32x4 gelu4(f32x4 v) { f32x2 a = gelu_pk((f32x2){v[0], v[1]}), b = gelu_pk((f32x2){v[2], v[3]}); return (f32x4){a.x, a.y, b.x, b.y}; }

template <int ACT> struct EpiAct {
    static constexpr bool PERM = true;
    bf16_t* O; int ldc; const float* bias; int nb; const float* ssin; float* vss; int vcol0;
    __device__ __forceinline__ void operator()(const f32x4 (&acc)[2][2][4][2], const Unit& u, int wr, int wc, int fr, int fq) const {
        asm volatile("" : "+v"(fr), "+v"(fq));
        const int row0 = u.pm * BM + wr * 64 + fr, col0 = u.pn * BM + wc * 32 + 8 * fq;
        const int seq = seq_of_row(u.pm * BM);
        const float* bp = bias + (size_t)seq * nb + col0;
        f32x4 bv[2][2]; float rsv[2][4];
#pragma unroll
        for (int bj = 0; bj < 2; ++bj)
#pragma unroll
            for (int n = 0; n < 2; ++n) bv[bj][n] = *(const f32x4*)(bp + bj * HALF + 4 * n);
#pragma unroll
        for (int ai = 0; ai < 2; ++ai)
#pragma unroll
            for (int m = 0; m < 4; ++m) rsv[ai][m] = ssin[row0 + ai * HALF + m * 16];
#pragma unroll
        for (int ai = 0; ai < 2; ++ai)
#pragma unroll
            for (int m = 0; m < 4; ++m) rsv[ai][m] = __builtin_amdgcn_rsqf(rsv[ai][m] * (1.0f / DM) + EPSN);
        const bool dov = (ACT == 1) && (u.pn * BM >= vcol0);
#pragma unroll
        for (int ai = 0; ai < 2; ++ai)
#pragma unroll
            for (int m = 0; m < 4; ++m) {
                const int r = row0 + ai * HALF + m * 16;
                const float rs = rsv[ai][m];
                bf16_t* rowp = O + (size_t)r * ldc + col0; float s = 0.f;
#pragma unroll
                for (int bj = 0; bj < 2; ++bj) { f32x4 v0 = acc[ai][bj][m][0] * rs + bv[bj][0], v1 = acc[ai][bj][m][1] * rs + bv[bj][1];
                    if (ACT == 1) { v0 = gelu4(v0); v1 = gelu4(v1); s += (v0[0] * v0[0] + v0[1] * v0[1]) + (v0[2] * v0[2] + v0[3] * v0[3]) + (v1[0] * v1[0] + v1[1] * v1[1]) + (v1[2] * v1[2] + v1[3] * v1[3]); }
                    u32x4 w; w.x = cvt_pk_bf16_asm(v0[0], v0[1]); w.y = cvt_pk_bf16_asm(v0[2], v0[3]); w.z = cvt_pk_bf16_asm(v1[0], v1[1]); w.w = cvt_pk_bf16_asm(v1[2], v1[3]);
                    *(u32x4*)(rowp + bj * HALF) = w; }
                if (ACT == 1) { s += __shfl_xor(s, 16); s += __shfl_xor(s, 32); if (dov && fq == 0) unsafeAtomicAdd(vss + r, s); }
            }
    }
};

struct EpiRes {
    static constexpr bool PERM = false;
    const float* base0; const float* base1; float* xout; const float* gate; const float* gs; bf16_t* xb; float* ssn;
    __device__ __forceinline__ void operator()(const f32x4 (&acc)[2][2][4][2], const Unit& u, int wr, int wc, int fr, int fq) const {
        asm volatile("" : "+v"(fr), "+v"(fq));
        const int row0 = u.pm * BM + wr * 64 + fr, col0 = u.pn * BM + wc * 32 + 4 * fq;
        const int seq = seq_of_row(u.pm * BM);
        const float* gp = gate + (size_t)seq * MODW + col0; const float* gsp = gs + (size_t)seq * DM + col0;
        f32x4 gv[2][2], gsv[2][2];
#pragma unroll
        for (int bj = 0; bj < 2; ++bj)
#pragma unroll
            for (int n = 0; n < 2; ++n) { gv[bj][n] = *(const f32x4*)(gp + bj * HALF + n * 16); gsv[bj][n] = *(const f32x4*)(gsp + bj * HALF + n * 16); }
        const float* bbase = (u.pm * BM < 16384 ? base0 + (size_t)row0 * DM : base1 + (size_t)(row0 - 16384) * DM) + col0;
        f32x4 xc[2][2], xn2[2][2];
#pragma unroll
        for (int bj = 0; bj < 2; ++bj)
#pragma unroll
            for (int n = 0; n < 2; ++n) xc[bj][n] = *(const f32x4*)(bbase + bj * HALF + n * 16);
#pragma unroll
        for (int g8 = 0; g8 < 8; ++g8) { const int ai = g8 >> 2, m = g8 & 3;
            if (g8 < 7) { const int an = (g8 + 1) >> 2, mn = (g8 + 1) & 3; const float* bp = bbase + (size_t)(an * HALF + mn * 16) * DM;
#pragma unroll
                for (int bj = 0; bj < 2; ++bj)
#pragma unroll
                    for (int n = 0; n < 2; ++n) xn2[bj][n] = *(const f32x4*)(bp + bj * HALF + n * 16); }
            const int r = row0 + ai * HALF + m * 16;
            float* op = xout + (size_t)r * DM + col0; float s = 0.f;
#pragma unroll
            for (int bj = 0; bj < 2; ++bj)
#pragma unroll
                for (int n = 0; n < 2; ++n) { const f32x4 xn = xc[bj][n] + gv[bj][n] * acc[ai][bj][m][n];
                    *(f32x4*)(op + bj * HALF + n * 16) = xn; s += (xn[0] * xn[0] + xn[1] * xn[1]) + (xn[2] * xn[2] + xn[3] * xn[3]);
                    if (xb) { const f32x4 h = xn * gsv[bj][n]; u32x2 w; w.x = cvt_pk_bf16_asm(h[0], h[1]); w.y = cvt_pk_bf16_asm(h[2], h[3]);
                        *(u32x2*)(xb + (size_t)r * DM + col0 + bj * HALF + n * 16) = w; } }
            s += __shfl_xor(s, 16); s += __shfl_xor(s, 32); if (fq == 0) unsafeAtomicAdd(ssn + r, s);
#pragma unroll
            for (int bj = 0; bj < 2; ++bj)
#pragma unroll
                for (int n = 0; n < 2; ++n) xc[bj][n] = xn2[bj][n];
        }
    }
};

struct EpiUp {
    static constexpr bool PERM = true;
    bf16_t* act; const float* bias; const float* cw; const float* ssin; float* edge;
    __device__ __forceinline__ void operator()(const f32x4 (&acc)[2][2][4][2], const Unit& u, int wr, int wc, int fr, int fq) const {
        asm volatile("" : "+v"(fr), "+v"(fq));
        const int row0 = u.pm * BM + wr * 64 + fr, colt = u.pn * BM + wc * 32 + 8 * fq;
        const int seq = seq_of_row(u.pm * BM);
        const float* biasp = bias + (size_t)seq * NUP + colt; const float* cwp = cw + colt;
        float rs[2][4];
#pragma unroll
        for (int ai = 0; ai < 2; ++ai)
#pragma unroll
            for (int m = 0; m < 4; ++m) rs[ai][m] = ssin[row0 + ai * HALF + m * 16];
#pragma unroll
        for (int ai = 0; ai < 2; ++ai)
#pragma unroll
            for (int m = 0; m < 4; ++m) rs[ai][m] = __builtin_amdgcn_rsqf(rs[ai][m] * (1.0f / DM) + EPSN);
#pragma unroll
        for (int n = 0; n < 2; ++n) {
            f32x4 prm[2][5];
#pragma unroll
            for (int bj = 0; bj < 2; ++bj) { const int co = bj * HALF + 4 * n;
                prm[bj][0] = *(const f32x4*)(biasp + co); prm[bj][1] = *(const f32x4*)(cwp + co); prm[bj][2] = *(const f32x4*)(cwp + NUP + co); prm[bj][3] = *(const f32x4*)(cwp + 2 * NUP + co); prm[bj][4] = *(const f32x4*)(cwp + 3 * NUP + co); }
#pragma unroll
            for (int ai = 0; ai < 2; ++ai) {
                float* ep = edge + (size_t)(u.pm * 4 + ai * 2 + wr) * 4 * NUP + colt;
                f32x4 SG[4];
#pragma unroll
                for (int bjr = 0; bjr < 2; ++bjr) { const int bj = 1 - bjr; const int co = bj * HALF + 4 * n;
                    f32x4 U[4];
#pragma unroll
                    for (int m = 0; m < 4; ++m) U[m] = acc[ai][bj][m][n] * rs[ai][m] + prm[bj][0];
                    if (fr < 2) *(f32x4*)(ep + (size_t)fr * NUP + co) = U[0];
                    if (fr >= 14) *(f32x4*)(ep + (size_t)(fr - 12) * NUP + co) = U[3];
#pragma unroll
                    for (int m = 0; m < 4; ++m) { const f32x4 sp = (fr == 15 && m > 0) ? U[m > 0 ? m - 1 : 0] : U[m]; const f32x4 sn = (fr == 0 && m < 3) ? U[m < 3 ? m + 1 : 3] : U[m];
                        f32x4 pv, nv;
#pragma unroll
                        for (int j = 0; j < 4; ++j) { pv[j] = __int_as_float(__builtin_amdgcn_update_dpp(0, __float_as_int(sp[j]), 0x121, 0xf, 0xf, false)); nv[j] = __int_as_float(__builtin_amdgcn_update_dpp(0, __float_as_int(sn[j]), 0x12F, 0xf, 0xf, false)); }
                        const f32x4 R = prm[bj][1] * pv + prm[bj][2] * U[m] + prm[bj][3] * nv + prm[bj][4];
                        if (bj == 1) {
#pragma unroll
                            for (int j = 0; j < 4; ++j) SG[m][j] = R[j] * __builtin_amdgcn_rcpf(1.0f + __expf(-R[j])); }
                        else { const int r = row0 + ai * HALF + m * 16; const bool skip = (m == 0 && fr == 0) || (m == 3 && fr == 15);
                            const f32x4 o = R * SG[m]; u32x2 w; w.x = cvt_pk_bf16_asm(o[0], o[1]); w.y = cvt_pk_bf16_asm(o[2], o[3]);
                            if (!skip) *(u32x2*)(act + (size_t)r * FFD + u.pn * 128 + wc * 32 + 8 * fq + 4 * n) = w; } } } }
        }
    }
};
}

__device__ __forceinline__ float silu_f(float x) { return x / (1.0f + __expf(-x)); }

__device__ void mod_task(int wv, const Params& p, int tk, float* ldsf) {
    const int tid = otid(wv), i = tk / 48, cgp = tk % 48;
    float* csL = ldsf; float* red = ldsf + 3072;
    for (int idx = tid; idx < 3072; idx += NTHR) { const int seq = idx >> 10, k = idx & 1023; const float c = seq < 2 ? p.cp[seq * DM + k] : p.csm[k]; csL[idx] = silu_f(c); }
    __syncthreads();
    const int quad = tid & 31, ksl = tid >> 5;
    const float* W = p.w_ada + (size_t)i * DM * MODW + (size_t)ksl * 64 * MODW + 128 * cgp + 4 * quad;
    f32x4 a0 = {0, 0, 0, 0}, a1 = {0, 0, 0, 0}, a2 = {0, 0, 0, 0};
#pragma unroll 8
    for (int kk = 0; kk < 64; ++kk) { const f32x4 w = *(const f32x4*)(W + (size_t)kk * MODW); const int k = ksl * 64 + kk;
        a0 += w * csL[k]; a1 += w * csL[1024 + k]; a2 += w * csL[2048 + k]; }
    float* rp = red + (ksl * 32 + quad) * 12;
    *(f32x4*)(rp) = a0; *(f32x4*)(rp + 4) = a1; *(f32x4*)(rp + 8) = a2;
    __syncthreads();
    if (tid < 384) { const int q = tid & 31, e = tid >> 5; float s = 0.f;
        for (int k = 0; k < 16; ++k) s += red[(k * 32 + q) * 12 + e];
        const int seq = e >> 2, col = 128 * cgp + 4 * q + (e & 3);
        float* mod = (float*)(p.ws + WS_MOD);
        mod[((size_t)i * 3 + seq) * MODW + col] = s + p.b_ada[i * MODW + col]; }
    __syncthreads();
}

__device__ void wf_task(int wv, const Params& p, int task, float* ldsf) {
    const int tid = otid(wv), g = task >> 4, n0 = (task & 15) * 64;
    float* tile = ldsf; float* ct = ldsf + 128 * 64;
    for (int idx = tid; idx < 128 * 16; idx += NTHR) { const int cp_ = idx >> 4, n4 = (idx & 15) * 4;
        *(f32x4*)(tile + cp_ * 64 + n4) = *(const f32x4*)(p.c_w_out + (size_t)(g * 128 + cp_) * DM + n0 + n4); }
    if (tid < 128) ct[tid] = cospif(2.0f * tid / 128.0f) * 0.08838834764831845f;
    __syncthreads();
    const int n = tid & 63, wvl = __builtin_amdgcn_readfirstlane(tid >> 6);
    float ac[16], as[16];
#pragma unroll
    for (int c = 0; c < 16; ++c) { ac[c] = 0.f; as[c] = 0.f; }
    for (int cq = 0; cq < 128; ++cq) { const float v = tile[cq * 64 + n];
#pragma unroll
        for (int cc = 0; cc < 16; ++cc) { const int idx = ((wvl * 16 + cc) * cq) & 127; ac[cc] += ct[idx] * v; as[cc] += ct[(idx + 96) & 127] * v; } }
    float* Wf = (float*)(p.ws + WS_WF32);
#pragma unroll
    for (int cc = 0; cc < 16; ++cc) { const int c = wvl * 16 + cc; Wf[(size_t)(g * 128 + c) * DM + n0 + n] = ac[cc]; Wf[(size_t)(1024 + g * 128 + c) * DM + n0 + n] = as[cc]; }
    __syncthreads();
}

__device__ void convert_matrix(int wv, const float* src, int K, int N, int ld, int perm, bf16_t* dst, float* tileL, int rot) {
    const int tid = otid(wv), G = gridDim.x, ntk = K >> 6, ntiles = ntk * (N >> 8);
    for (int t = (blockIdx.x + G - (rot % G)) % G; t < ntiles; t += G) {
        const int k0 = (t % ntk) * 64, n0 = (t / ntk) * 256;
        f32x4 v[8];
#pragma unroll
        for (int ps = 0; ps < 8; ++ps) { const int idx = tid + ps * NTHR, kk = idx >> 6, n4 = (idx & 63) * 4; const int sc = perm ? upcol(n0 + n4) : n0 + n4;
            v[ps] = *(const f32x4*)(src + (size_t)(k0 + kk) * ld + sc); }
#pragma unroll
        for (int ps = 0; ps < 8; ++ps) { const int idx = tid + ps * NTHR, kk = idx >> 6, n4 = (idx & 63) * 4;
            float* tp = tileL + kk * 257 + n4; tp[0] = v[ps][0]; tp[1] = v[ps][1]; tp[2] = v[ps][2]; tp[3] = v[ps][3]; }
        __syncthreads();
        { const int n = tid >> 1, kh = (tid & 1) * 32;
#pragma unroll
            for (int q = 0; q < 4; ++q) { float e[8];
#pragma unroll
                for (int j = 0; j < 8; ++j) e[j] = tileL[(kh + 8 * q + j) * 257 + n];
                u32x4 w; w.x = cvt_pk_bf16(e[0], e[1]); w.y = cvt_pk_bf16(e[2], e[3]); w.z = cvt_pk_bf16(e[4], e[5]); w.w = cvt_pk_bf16(e[6], e[7]);
                *(u32x4*)(dst + (size_t)(n0 + n) * K + k0 + kh + 8 * q) = w; } }
        __syncthreads();
    }
}

__device__ void bias_task(int wv, const float* W, int ld, int perm, const float* sh, float* bias, int nb, int grp, float* red) {
    const int tid = otid(wv), quad = tid & 63, ksl = __builtin_amdgcn_readfirstlane(tid >> 6);
    const int nn = 256 * grp + 4 * quad, sc = perm ? upcol(nn) : nn;
    f32x4 a0 = {0, 0, 0, 0}, a1 = {0, 0, 0, 0}, a2 = {0, 0, 0, 0};
    const float* wp = W + (size_t)ksl * 128 * ld + sc; const float* s0 = sh + ksl * 128;
#pragma unroll 16
    for (int kk = 0; kk < 128; ++kk) { const f32x4 w = *(const f32x4*)(wp + (size_t)kk * ld); a0 += w * s0[kk]; a1 += w * s0[MODW + kk]; a2 += w * s0[2 * MODW + kk]; }
    float* rp = red + (ksl * 64 + quad) * 12;
    *(f32x4*)(rp) = a0; *(f32x4*)(rp + 4) = a1; *(f32x4*)(rp + 8) = a2;
    __syncthreads();
    for (int idx = tid; idx < 768; idx += NTHR) { const int q = idx & 63, e = idx >> 6; float s = 0.f;
        for (int k = 0; k < 8; ++k) s += red[(k * 64 + q) * 12 + e];
        bias[(size_t)(e >> 2) * nb + 256 * grp + 4 * q + (e & 3)] = s; }
    __syncthreads();
}

__device__ __forceinline__ f32x4 mfma16(bf16x8 a, bf16x8 b, f32x4 c) { return __builtin_amdgcn_mfma_f32_16x16x32_bf16(a, b, c, 0, 0, 0); }

__device__ void sg_phase(int wv, const Params& p, int jl, unsigned char* lds) {
    const int tid = otid(wv), lane = tid & 63, w = __builtin_amdgcn_readfirstlane(tid >> 6), lr = lane & 15, lq = lane >> 4;
    bf16_t* uv = (bf16_t*)(p.ws + WS_BIG1);
    const float* vss = (const float*)(p.ws + WS_SS) + (size_t)(9 + jl) * MTOK;
    constexpr int PW = 136;
    bf16_t* WsL = (bf16_t*)lds; bf16_t* VTL = WsL + 128 * PW; float* rsL = (float*)(VTL + 128 * PW);
    for (int unit = blockIdx.x; unit < 2048; unit += gridDim.x) {
        const int ch = unit >> 3, g = unit & 7, t0 = ch * 128;
        if (tid < 128) rsL[tid] = 1.0f / sqrtf(vss[t0 + tid] * (1.0f / DM) + EPSN);
        __syncthreads();
        const float* ws = p.a_w_s + ((size_t)jl * 8 + g) * 128 * 128;
#pragma unroll
        for (int ps = 0; ps < 8; ++ps) { const int idx = tid + ps * NTHR, t = idx >> 5, s4 = (idx & 31) * 4;
            const f32x4 wv = *(const f32x4*)(ws + t * 128 + s4); const f32x4 r4 = *(const f32x4*)(rsL + s4); const f32x4 x = wv * r4;
            u32x2 pk; pk.x = cvt_pk_bf16(x[0], x[1]); pk.y = cvt_pk_bf16(x[2], x[3]); *(u32x2*)(WsL + t * PW + s4) = pk; }
#pragma unroll
        for (int ps = 0; ps < 4; ++ps) { const int idx = tid + ps * NTHR, s = idx >> 4, d8 = (idx & 15) * 8;
            const bf16x8 v = *(const bf16x8*)(uv + (size_t)(t0 + s) * 2048 + 1024 + g * 128 + d8);
#pragma unroll
            for (int e = 0; e < 8; ++e) VTL[(d8 + e) * PW + s] = (bf16_t)v[e]; }
        __syncthreads();
        bf16x8 af[4];
#pragma unroll
        for (int kk = 0; kk < 4; ++kk) af[kk] = *(const bf16x8*)(WsL + (16 * w + lr) * PW + 32 * kk + 8 * lq);
        const int tok = t0 + 16 * w + lr; const float bs = p.a_b_s[((size_t)jl * 8 + g) * 128 + 16 * w + lr];
#pragma unroll
        for (int db = 0; db < 8; ++db) { f32x4 acc = {0, 0, 0, 0};
#pragma unroll
            for (int kk = 0; kk < 4; ++kk) { const bf16x8 bf = *(const bf16x8*)(VTL + (16 * db + lr) * PW + 32 * kk + 8 * lq); acc = mfma16(bf, af[kk], acc); }
            const int col = g * 128 + 16 * db + 4 * lq; const f32x4 gv = *(const f32x4*)(p.a_g_v + jl * DM + col);
            bf16_t* up = uv + (size_t)tok * 2048 + col; const u32x2 uu = *(const u32x2*)up;
            const float u0 = __uint_as_float(uu.x << 16), u1 = __uint_as_float(uu.x & 0xffff0000u), u2 = __uint_as_float(uu.y << 16), u3 = __uint_as_float(uu.y & 0xffff0000u);
            const f32x4 sv = acc * gv + bs; u32x2 o; o.x = cvt_pk_bf16(u0 * sv[0], u1 * sv[1]); o.y = cvt_pk_bf16(u2 * sv[2], u3 * sv[3]);
            *(u32x2*)up = o; }
        __syncthreads();
    }
}

__device__ void att_phase(int wv, const Params& p, unsigned char* lds) {
    const int tid = otid(wv), lane = tid & 63, w = __builtin_amdgcn_readfirstlane(tid >> 6), lr = lane & 15, lq = lane >> 4;
    bf16_t* qkv = (bf16_t*)(p.ws + WS_BIG1);
    constexpr int KP = 72, VP = 392;
    bf16_t* KL = (bf16_t*)lds; bf16_t* VTL = KL + 384 * KP;
    for (int unit = blockIdx.x; unit < 1024; unit += gridDim.x) {
        const int B = unit >> 2, kh = unit & 3;
        const int sb = B < 64 ? 0 : (B < 128 ? 64 : 128), se = B < 64 ? 64 : (B < 128 ? 128 : 256);
#pragma unroll
        for (int ps = 0; ps < 6; ++ps) { const int idx = tid + ps * NTHR, s = idx >> 3, c8 = (idx & 7) * 8; const int kb = B - 1 + (s >> 7);
            bf16x8 kv = {0, 0, 0, 0, 0, 0, 0, 0}, vv = {0, 0, 0, 0, 0, 0, 0, 0};
            if (kb >= sb && kb < se) { const bf16_t* rp = qkv + (size_t)(kb * 128 + (s & 127)) * 1536 + 64 * kh + c8; kv = *(const bf16x8*)(rp + 1024); vv = *(const bf16x8*)(rp + 1280); }
            *(bf16x8*)(KL + s * KP + c8) = kv;
#pragma unroll
            for (int e = 0; e < 8; ++e) VTL[(c8 + e) * VP + s] = (bf16_t)vv[e]; }
        __syncthreads();
        const int gq = w >> 1, h = 4 * kh + gq;
        const float slope = exp2f(-0.5f * (float)(h + 1)), sink = p.b_sinks[h];
        for (int rb = 0; rb < 4; ++rb) {
            const int qrow = 64 * (w & 1) + 16 * rb + lr;
            const size_t tokq = (size_t)B * 128 + qrow;
            bf16x8 qf[2];
#pragma unroll
            for (int kk = 0; kk < 2; ++kk) qf[kk] = *(const bf16x8*)(qkv + tokq * 1536 + 64 * h + 32 * kk + 8 * lq);
            f32x4 sc[24];
#pragma unroll
            for (int cb = 0; cb < 24; ++cb) { f32x4 a = {0, 0, 0, 0};
#pragma unroll
                for (int kk = 0; kk < 2; ++kk) { const bf16x8 kf = *(const bf16x8*)(KL + (16 * cb + lr) * KP + 32 * kk + 8 * lq); a = mfma16(kf, qf[kk], a); }
                sc[cb] = a; }
            float mx = sink;
#pragma unroll
            for (int cb = 0; cb < 24; ++cb) { const int kb = B - 1 + (cb >> 3); const bool bval = (kb >= sb && kb < se);
#pragma unroll
                for (int j = 0; j < 4; ++j) { const int krel = 16 * cb + 4 * lq + j - 128;
                    int dist = qrow - krel; dist = dist < 0 ? -dist : dist;
                    const float v = (bval && dist <= 128) ? sc[cb][j] * 0.125f - slope * (float)dist : -1e30f;
                    sc[cb][j] = v; mx = fmaxf(mx, v); } }
            mx = fmaxf(mx, __shfl_xor(mx, 16)); mx = fmaxf(mx, __shfl_xor(mx, 32));
            float sum = 0.f;
#pragma unroll
            for (int cb = 0; cb < 24; ++cb)
#pragma unroll
                for (int j = 0; j < 4; ++j) { const float e = __expf(sc[cb][j] - mx); sc[cb][j] = e; sum += e; }
            sum += __shfl_xor(sum, 16); sum += __shfl_xor(sum, 32);
            sum += __expf(sink - mx);
            const float inv = 1.0f / sum;
            f32x4 oa[4];
#pragma unroll
            for (int db = 0; db < 4; ++db) oa[db] = (f32x4){0, 0, 0, 0};
#pragma unroll
            for (int ks = 0; ks < 12; ++ks) {
                union { bf16x8 v; unsigned u[4]; } pf;
                pf.u[0] = cvt_pk_bf16_asm(sc[2 * ks][0], sc[2 * ks][1]); pf.u[1] = cvt_pk_bf16_asm(sc[2 * ks][2], sc[2 * ks][3]);
                pf.u[2] = cvt_pk_bf16_asm(sc[2 * ks + 1][0], sc[2 * ks + 1][1]); pf.u[3] = cvt_pk_bf16_asm(sc[2 * ks + 1][2], sc[2 * ks + 1][3]);
#pragma unroll
                for (int db = 0; db < 4; ++db) {
                    union { bf16x8 v; u32x2 h2[2]; } vf;
                    const bf16_t* vp = VTL + (16 * db + lr) * VP + 32 * ks + 4 * lq;
                    vf.h2[0] = *(const u32x2*)vp; vf.h2[1] = *(const u32x2*)(vp + 16);
                    oa[db] = mfma16(vf.v, pf.v, oa[db]); } }
#pragma unroll
            for (int db = 0; db < 4; ++db) { const f32x4 o = oa[db] * inv; u32x2 wv; wv.x = cvt_pk_bf16_asm(o[0], o[1]); wv.y = cvt_pk_bf16_asm(o[2], o[3]);
                *(u32x2*)(qkv + tokq * 1536 + 64 * h + 16 * db + 4 * lq) = wv; }
        }
        __syncthreads();
    }
}

template <int N1> __device__ void fft1_units(int wv, const Params& p, unsigned char* lds, int seq_lo, int nseq, int part, int nparts) {
    const int tid = otid(wv), lane = tid & 63, w = __builtin_amdgcn_readfirstlane(tid >> 6), lr = lane & 15, lq = lane >> 4;
    constexpr int PW = N1 + 8, NB = N1 / 16, NK = N1 / 32; constexpr int S = N1 * 128;
    const bf16_t* z = (const bf16_t*)(p.ws + WS_BIG1); bf16_t* A1 = (bf16_t*)(p.ws + WS_BIG2);
    const bf16_t* ctg = (const bf16_t*)(p.ws + WS_TAB + (N1 == 64 ? TAB_CT64 : TAB_CT128)); const bf16_t* stg = (const bf16_t*)(p.ws + WS_TAB + (N1 == 64 ? TAB_ST64 : TAB_ST128));
    bf16_t* CT = (bf16_t*)lds; bf16_t* ST = CT + N1 * PW; bf16_t* XT = ST + N1 * PW;
    for (int idx = tid; idx < N1 * N1 / 8; idx += NTHR) { const int r = idx / (N1 / 8), c8 = (idx % (N1 / 8)) * 8;
        *(bf16x8*)(CT + r * PW + c8) = *(const bf16x8*)(ctg + r * N1 + c8); *(bf16x8*)(ST + r * PW + c8) = *(const bf16x8*)(stg + r * N1 + c8); }
    __syncthreads();
    const int nunits = nseq * 128 * 8;
    for (int unit = part; unit < nunits; unit += nparts) {
        const int sq = unit / 1024, b = (unit >> 3) & 127, cb = unit & 7;
        const int seq = seq_lo + sq; const size_t sbase = (size_t)seq * 8192;
        for (int idx = tid; idx < N1 * 16; idx += NTHR) { const int a = idx >> 4, c8 = (idx & 15) * 8;
            const bf16x8 v = *(const bf16x8*)(z + (sbase + 128 * a + b) * DM + cb * 128 + c8);
#pragma unroll
            for (int e = 0; e < 8; ++e) XT[(c8 + e) * PW + a] = (bf16_t)v[e]; }
        __syncthreads();
        bf16x8 xf[NK];
#pragma unroll
        for (int kk = 0; kk < NK; ++kk) xf[kk] = *(const bf16x8*)(XT + (16 * w + lr) * PW + 32 * kk + 8 * lq);
#pragma unroll
        for (int i = 0; i < NB; ++i) { f32x4 ar = {0, 0, 0, 0}, as = {0, 0, 0, 0};
#pragma unroll
            for (int kk = 0; kk < NK; ++kk) { const bf16x8 cf = *(const bf16x8*)(CT + (16 * i + lr) * PW + 32 * kk + 8 * lq), sf = *(const bf16x8*)(ST + (16 * i + lr) * PW + 32 * kk + 8 * lq);
                ar = mfma16(xf[kk], cf, ar); as = mfma16(xf[kk], sf, as); }
            const int ka = 16 * i + lr; float tc, ts; sincospif(2.0f * (float)(b * ka) / (float)S, &ts, &tc);
            const f32x4 re = ar * tc - as * ts, im = -(as * tc) - ar * ts;
            bf16_t* op = A1 + (sbase + (size_t)ka * 128 + b) * 2048 + cb * 128 + 16 * w + 4 * lq;
            u32x2 o; o.x = cvt_pk_bf16(re[0], re[1]); o.y = cvt_pk_bf16(re[2], re[3]); *(u32x2*)op = o;
            o.x = cvt_pk_bf16(im[0], im[1]); o.y = cvt_pk_bf16(im[2], im[3]); *(u32x2*)(op + 1024) = o; }
        __syncthreads();
    }
}
__device__ void fft2_phase(int wv, const Params& p, unsigned char* lds) {
    const int tid = otid(wv), lane = tid & 63, w = __builtin_amdgcn_readfirstlane(tid >> 6), lr = lane & 15, lq = lane >> 4;
    constexpr int PW = 136;
    const bf16_t* A1 = (const bf16_t*)(p.ws + WS_BIG2); bf16_t* Y = (bf16_t*)(p.ws + WS_BIG1);
    const bf16_t* ctg = (const bf16_t*)(p.ws + WS_TAB + TAB_CT128); const bf16_t* stg = (const bf16_t*)(p.ws + WS_TAB + TAB_ST128);
    bf16_t* CT = (bf16_t*)lds; bf16_t* ST = CT + 128 * PW; bf16_t* XR = ST + 128 * PW; bf16_t* XI = XR + 128 * PW;
    for (int idx = tid; idx < 128 * 16; idx += NTHR) { const int r = idx >> 4, c8 = (idx & 15) * 8;
        *(bf16x8*)(CT + r * PW + c8) = *(const bf16x8*)(ctg + r * 128 + c8); *(bf16x8*)(ST + r * PW + c8) = *(const bf16x8*)(stg + r * 128 + c8); }
    __syncthreads();
    for (int unit = blockIdx.x; unit < 2048; unit += gridDim.x) {
        const int gi = unit >> 3, cb = unit & 7;
        const int seq = gi < 64 ? 0 : (gi < 128 ? 1 : 2); const int ka = gi - (seq == 0 ? 0 : (seq == 1 ? 64 : 128)); const int N1 = seq == 2 ? 128 : 64;
        const size_t sbase = (size_t)seq * 8192;
#pragma unroll
        for (int ps = 0; ps < 4; ++ps) { const int idx = tid + ps * NTHR, b = idx >> 4, c8 = (idx & 15) * 8;
            const bf16_t* rp = A1 + ((size_t)gi * 128 + b) * 2048 + cb * 128 + c8; const bf16x8 vr = *(const bf16x8*)rp, vi = *(const bf16x8*)(rp + 1024);
#pragma unroll
            for (int e = 0; e < 8; ++e) { XR[(c8 + e) * PW + b] = (bf16_t)vr[e]; XI[(c8 + e) * PW + b] = (bf16_t)vi[e]; } }
        __syncthreads();
        bf16x8 xr[4], xi[4], nxr[4];
#pragma unroll
        for (int kk = 0; kk < 4; ++kk) { xr[kk] = *(const bf16x8*)(XR + (16 * w + lr) * PW + 32 * kk + 8 * lq); xi[kk] = *(const bf16x8*)(XI + (16 * w + lr) * PW + 32 * kk + 8 * lq);
            union { bf16x8 v; unsigned u[4]; } t; t.v = xr[kk]; t.u[0] ^= 0x80008000u; t.u[1] ^= 0x80008000u; t.u[2] ^= 0x80008000u; t.u[3] ^= 0x80008000u; nxr[kk] = t.v; }
#pragma unroll
        for (int i = 0; i < 8; ++i) { f32x4 re = {0, 0, 0, 0}, im = {0, 0, 0, 0};
#pragma unroll
            for (int kk = 0; kk < 4; ++kk) { const bf16x8 cf = *(const bf16x8*)(CT + (16 * i + lr) * PW + 32 * kk + 8 * lq), sf = *(const bf16x8*)(ST + (16 * i + lr) * PW + 32 * kk + 8 * lq);
                re = mfma16(xr[kk], cf, re); re = mfma16(xi[kk], sf, re); im = mfma16(xi[kk], cf, im); im = mfma16(nxr[kk], sf, im); }
            const int kb = 16 * i + lr;
            bf16_t* op = Y + (sbase + (size_t)N1 * kb + ka) * 2048 + cb * 128 + 16 * w + 4 * lq;
            u32x2 o; o.x = cvt_pk_bf16(re[0], re[1]); o.y = cvt_pk_bf16(re[2], re[3]); *(u32x2*)op = o;
            o.x = cvt_pk_bf16(im[0], im[1]); o.y = cvt_pk_bf16(im[2], im[3]); *(u32x2*)(op + 1024) = o; }
        __syncthreads();
    }
}

__device__ void fix_phase(int wv, const Params& p, int li) {
    const float* edge = (const float*)(p.ws + WS_EDGE); const float* cw = (const float*)(p.ws + WS_CW) + (size_t)li * 4 * NUP; bf16_t* act = (bf16_t*)(p.ws + WS_ACT);
    const int total = 1024 * (FFD / 4);
    const int tid = otid(wv);
    for (int idx = blockIdx.x * NTHR + tid; idx < total; idx += gridDim.x * NTHR) {
        const int e = idx / (FFD / 4), c = (idx % (FFD / 4)) * 4; const int band = e >> 1, hi = e & 1; const int R = band * 64 + (hi ? 63 : 0);
        const int ca = (c >> 7) * 256 + (c & 127), cg_ = ca + 128;
        const bool seqstart = (R == 0 || R == 8192 || R == 16384), seqend = (R == 8191 || R == 16383 || R == 32767);
        const float* ep = edge + (size_t)band * 4 * NUP;
        f32x4 pa, pg, ua, ug, na, ng; const f32x4 zero = {0, 0, 0, 0};
        if (!hi) { pa = seqstart ? zero : *(const f32x4*)(ep - NUP + ca); pg = seqstart ? zero : *(const f32x4*)(ep - NUP + cg_);
            ua = *(const f32x4*)(ep + ca); ug = *(const f32x4*)(ep + cg_); na = *(const f32x4*)(ep + NUP + ca); ng = *(const f32x4*)(ep + NUP + cg_); }
        else { pa = *(const f32x4*)(ep + 2 * NUP + ca); pg = *(const f32x4*)(ep + 2 * NUP + cg_); ua = *(const f32x4*)(ep + 3 * NUP + ca); ug = *(const f32x4*)(ep + 3 * NUP + cg_);
            na = seqend ? zero : *(const f32x4*)(ep + 4 * NUP + ca); ng = seqend ? zero : *(const f32x4*)(ep + 4 * NUP + cg_); }
        const f32x4 a = *(const f32x4*)(cw + ca) * pa + *(const f32x4*)(cw + NUP + ca) * ua + *(const f32x4*)(cw + 2 * NUP + ca) * na + *(const f32x4*)(cw + 3 * NUP + ca);
        const f32x4 g = *(const f32x4*)(cw + cg_) * pg + *(const f32x4*)(cw + NUP + cg_) * ug + *(const f32x4*)(cw + 2 * NUP + cg_) * ng + *(const f32x4*)(cw + 3 * NUP + cg_);
        float o[4];
#pragma unroll
        for (int j = 0; j < 4; ++j) o[j] = a[j] * g[j] / (1.0f + __expf(-g[j]));
        u32x2 wv; wv.x = cvt_pk_bf16(o[0], o[1]); wv.y = cvt_pk_bf16(o[2], o[3]);
        *(u32x2*)(act + (size_t)R * FFD + c) = wv;
    }
}

#define XB_TMO      128
#define XB_XCNT(j)  (256  + 64 * (j))
#define XB_XSUB(j)  (1280 + 64 * (j))
#define XB_XGEN(j)  (2304 + 64 * (j))
#define XB_TOP      3328
#define XB_TOPGEN   3392
#define XCD_BAR_WORDS 3456
#define XB_SPIN_CAP (1u << 18)
__device__ __forceinline__ unsigned xb_ld(unsigned* p)              { return __hip_atomic_load(p, __ATOMIC_RELAXED, __HIP_MEMORY_SCOPE_AGENT); }
__device__ __forceinline__ unsigned xb_add(unsigned* p, unsigned v) { return __hip_atomic_fetch_add(p, v, __ATOMIC_RELAXED, __HIP_MEMORY_SCOPE_AGENT); }
__device__ __forceinline__ unsigned xb_xcc_id() { return (unsigned)__builtin_amdgcn_s_getreg((3 << 11) | 20) & 0xFu; }
#define XB_SPIN(cond, bar) do { unsigned _sp = 0; while (cond) { __builtin_amdgcn_s_sleep(1); \
    if ((++_sp & 255u) == 0u) { if (xb_ld(&(bar)[XB_TMO])) break; if (_sp > XB_SPIN_CAP) { atomicAdd(&(bar)[XB_TMO], 1u); break; } } } } while (0)
struct XcdBarrier { unsigned* bar; unsigned x; volatile LAS unsigned* st; };
__device__ __forceinline__ XcdBarrier xcd_barrier_post(unsigned* bar, volatile LAS unsigned* st) {
    XcdBarrier b; b.bar = bar; b.x = xb_xcc_id(); b.st = st;
    if (threadIdx.x == 0) (void)xb_add(&bar[XB_XCNT(b.x)], 1u);
    return b;
}
__device__ __forceinline__ void xcd_barrier_complete(unsigned* bar, unsigned x, unsigned& nloc, unsigned& nx) {
    const unsigned G = gridDim.x * gridDim.y * gridDim.z;
    unsigned sum, cnt, mine, sp = 0u;
    for (;;) {
        sum = 0u; cnt = 0u; mine = 0u;
#pragma unroll
        for (unsigned j = 0; j < 16; ++j) { const unsigned c = xb_ld(&bar[XB_XCNT(j)]); sum += c; cnt += (c > 0u) ? 1u : 0u; mine = (j == x) ? c : mine; }
        if (sum == G) break;
        __builtin_amdgcn_s_sleep(1);
        if ((++sp & 255u) == 0u) { if (xb_ld(&bar[XB_TMO])) break; if (sp > XB_SPIN_CAP) { atomicAdd(&bar[XB_TMO], 1u); break; } }
    }
    nloc = mine > 0u ? mine : 1u; nx = cnt > 0u ? cnt : 1u;
}
__device__ __forceinline__ void xcd_barrier(const XcdBarrier& b, int wv) {
    asm volatile("s_waitcnt vmcnt(0)" ::: "memory");
    __syncthreads();
    if (otid(wv) == 0) {
        unsigned* bar = b.bar;
        unsigned bx = (unsigned)__builtin_amdgcn_readfirstlane((int)xb_xcc_id()); asm volatile("" : "+s"(bx));
        __builtin_amdgcn_s_waitcnt(0);
        unsigned nloc = b.st[0], nx = b.st[1];
        if (nloc == 0u) { xcd_barrier_complete(bar, bx, nloc, nx); b.st[0] = nloc; b.st[1] = nx; }
        const unsigned old = xb_add(&bar[XB_XSUB(bx)], 1u);
        const unsigned gen = old / nloc;
        if (old + 1u == (gen + 1u) * nloc) {
            __builtin_amdgcn_fence(__ATOMIC_RELEASE, "agent");
            asm volatile("s_waitcnt vmcnt(0)" ::: "memory");
            const unsigned og = xb_add(&bar[XB_TOP], 1u);
            const unsigned tg = og / nx;
            if (og + 1u == (tg + 1u) * nx) xb_add(&bar[XB_TOPGEN], 1u);
            else XB_SPIN(xb_ld(&bar[XB_TOPGEN]) == tg, bar);
            __builtin_amdgcn_fence(__ATOMIC_ACQUIRE, "agent");
            xb_add(&bar[XB_XGEN(bx)], 1u);
            asm volatile("s_waitcnt vmcnt(0)" ::: "memory");
        } else {
            XB_SPIN(xb_ld(&bar[XB_XGEN(bx)]) == gen, bar);
            __builtin_amdgcn_fence(__ATOMIC_ACQUIRE, "agent");
            asm volatile("s_waitcnt vmcnt(0)" ::: "memory");
        }
    }
    __syncthreads();
}

__global__ void __launch_bounds__(NTHR, 2) mega(Params p) {
    extern __shared__ __attribute__((aligned(16))) unsigned char lds[];
    cg::grid_group grid = cg::this_grid();
    const int G = gridDim.x, bid = blockIdx.x;
    const int wv = __builtin_amdgcn_readfirstlane(threadIdx.x >> 6);
    volatile LAS unsigned* xst = (volatile LAS unsigned*)((LAS unsigned char*)lds + (LDS_BYTES - 16));
    if (threadIdx.x == 0) { xst[0] = 0u; xst[1] = 0u; }
    __syncthreads();
    const XcdBarrier xbar = xcd_barrier_post((unsigned*)(p.ws + WS_BAR), xst);
    float* ldsf = (float*)lds;
#define WSPTRS \
    size_t wsoff_ = 0; asm volatile("" : "+s"(wsoff_)); unsigned char* ws = p.ws + wsoff_; \
    float* ssb = (float*)(ws + WS_SS); float* mod = (float*)(ws + WS_MOD); float* gsT = (float*)(ws + WS_GS); \
    float* biasG1 = (float*)(ws + WS_BG1); float* biasUP = (float*)(ws + WS_BUP); float* cwT = (float*)(ws + WS_CW); \
    bf16_t* xb = (bf16_t*)(ws + WS_XB); bf16_t* big1 = (bf16_t*)(ws + WS_BIG1); \
    bf16_t* wain = (bf16_t*)(ws + WS_WAIN); bf16_t* waout = (bf16_t*)(ws + WS_WAOUT); bf16_t* wqkv = (bf16_t*)(ws + WS_WQKV); bf16_t* wo = (bf16_t*)(ws + WS_WO); \
    bf16_t* wcin = (bf16_t*)(ws + WS_WCIN); bf16_t* wf = (bf16_t*)(ws + WS_WF); bf16_t* wup = (bf16_t*)(ws + WS_WUP); bf16_t* wdn = (bf16_t*)(ws + WS_WDN); \
    (void)ssb; (void)mod; (void)gsT; (void)biasG1; (void)biasUP; (void)cwT; (void)xb; (void)big1; (void)wain; (void)waout; (void)wqkv; (void)wo; (void)wcin; (void)wf; (void)wup; (void)wdn;
    {
    WSPTRS
    const int tid = otid(wv);
    for (int idx = bid * NTHR + tid; idx < 10 * MTOK / 4; idx += G * NTHR) *(f32x4*)(ssb + MTOK + 4 * (size_t)idx) = (f32x4){0.f, 0.f, 0.f, 0.f};
    if (bid < 192) mod_task(wv, p, bid, ldsf);
    { bf16_t* tab = (bf16_t*)(ws + WS_TAB);
        for (int idx = bid * NTHR + tid; idx < 4096 + 16384; idx += G * NTHR) {
            if (idx < 4096) { const int ka = idx >> 6, a = idx & 63; const float x = 2.0f * (float)((ka * a) & 63) / 64.0f; tab[TAB_CT64 / 2 + idx] = f2bf(cospif(x) * 0.125f); tab[TAB_ST64 / 2 + idx] = f2bf(sinpif(x) * 0.125f); }
            else { const int i2 = idx - 4096, ka = i2 >> 7, a = i2 & 127; const float x = 2.0f * (float)((ka * a) & 127) / 128.0f; tab[TAB_CT128 / 2 + i2] = f2bf(cospif(x) * 0.08838834764831845f); tab[TAB_ST128 / 2 + i2] = f2bf(sinpif(x) * 0.08838834764831845f); } } }
    if (bid >= G - 128) wf_task(wv, p, bid - (G - 128), ldsf);
    convert_matrix(wv, p.a_w_in, 1024, 2048, 2048, 0, wain, ldsf, 0);
    convert_matrix(wv, p.a_w_in + (size_t)1024 * 2048, 1024, 2048, 2048, 0, wain + (size_t)2048 * 1024, ldsf, 128);
    convert_matrix(wv, p.a_w_out, 1024, 1024, 1024, 0, waout, ldsf, 0);
    convert_matrix(wv, p.a_w_out + (size_t)1024 * 1024, 1024, 1024, 1024, 0, waout + (size_t)1024 * 1024, ldsf, 64);
    convert_matrix(wv, p.b_w_qkv, 1024, 1536, 1536, 0, wqkv, ldsf, 128);
    convert_matrix(wv, p.b_w_o, 1024, 1024, 1024, 0, wo, ldsf, 224);
    convert_matrix(wv, p.c_w_in, 1024, 1024, 1024, 0, wcin, ldsf, 32);
    convert_matrix(wv, p.f_w_up, 1024, NUP, NUP, 1, wup, ldsf, 96);
    convert_matrix(wv, p.f_w_down, FFD, 1024, 1024, 0, wdn, ldsf, 192);
    grid.sync();

    }
    {
    WSPTRS
    const int tid = otid(wv);
    if (bid < 48) {
        if (bid < 8) bias_task(wv, p.a_w_in, 2048, 0, mod, biasG1, 2048, bid, ldsf);
        else if (bid < 14) bias_task(wv, p.b_w_qkv, 1536, 0, mod + 3 * MODW, biasG1 + 3 * 2048, 1536, bid - 8, ldsf);
        else if (bid < 18) bias_task(wv, p.c_w_in, 1024, 0, mod + 6 * MODW, biasG1 + 6 * 2048, 1024, bid - 14, ldsf);
        else if (bid < 26) bias_task(wv, p.a_w_in + (size_t)1024 * 2048, 2048, 0, mod + 9 * MODW, biasG1 + 9 * 2048, 2048, bid - 18, ldsf);
        else bias_task(wv, p.f_w_up, NUP, 1, mod + 3 * DM, biasUP, NUP, bid - 26, ldsf);
    }
    for (int idx = bid * NTHR + tid; idx < 9 * 3 * DM; idx += G * NTHR) { const int ni = idx / (3 * DM), seq = (idx / DM) % 3, c = idx % DM;
        float v; if (ni == 8) v = p.g_final[c]; else { const int i = ni >> 1, t = ni & 1; v = p.norm_g[(i * 2 + t) * DM + c] * (1.0f + mod[((size_t)i * 3 + seq) * MODW + (t ? 4 : 1) * DM + c]); }
        gsT[idx] = v; }
    for (int idx = bid * NTHR + tid; idx < 4 * 4 * NUP; idx += G * NTHR) { const int i = idx / (4 * NUP), q = (idx / NUP) & 3, n = idx % NUP; const int oc = upcol(n);
        cwT[idx] = q < 3 ? p.f_w_conv[((size_t)i * 3 + q) * NUP + oc] : p.f_b_conv[(size_t)i * NUP + oc]; }
    convert_matrix(wv, (const float*)(ws + WS_WF32), 2048, 1024, 1024, 0, wf, ldsf, 48);
    { const int wid = tid >> 6, lane = tid & 63;
        for (int r = bid * 8 + wid; r < MTOK; r += G * 8) { const int seq = seq_of_row(r);
            const float* xr = r < 16384 ? p.xp + (size_t)r * DM : p.xs + (size_t)(r - 16384) * DM; float s = 0.f; f32x4 v[4];
#pragma unroll
            for (int jj = 0; jj < 4; ++jj) { v[jj] = *(const f32x4*)(xr + jj * 256 + 4 * lane); s += (v[jj][0] * v[jj][0] + v[jj][1] * v[jj][1]) + (v[jj][2] * v[jj][2] + v[jj][3] * v[jj][3]); }
#pragma unroll
            for (int o = 32; o >= 1; o >>= 1) s += __shfl_xor(s, o);
            if (lane == 0) ssb[r] = s;
#pragma unroll
            for (int jj = 0; jj < 4; ++jj) { const int c = jj * 256 + 4 * lane; u32x2 wv; float h[4];
#pragma unroll
                for (int j = 0; j < 4; ++j) h[j] = v[jj][j] * (p.norm_g[c + j] * (1.0f + mod[(size_t)seq * MODW + DM + c + j]));
                wv.x = cvt_pk_bf16(h[0], h[1]); wv.y = cvt_pk_bf16(h[2], h[3]); *(u32x2*)(xb + (size_t)r * DM + c) = wv; } } }
    xcd_barrier(xbar, wv);
    }

    LAS unsigned char* ldsl = (LAS unsigned char*)lds;
    for (int i = 0; i < 4; ++i) {
        WSPTRS
        const int kind = i % 3, jl = i / 3;
        {   pg8::StaticOrder S; const float* ssin = ssb + (size_t)(2 * i) * MTOK;
            if (kind == 0) { pg8::Gemm g{xb, wain + (size_t)jl * 2048 * 1024, MTOK, 2048, 1024, 1024}; S.init(MTOK, 2048, G, bid);
                pg8::EpiAct<1> E{big1, 2048, biasG1 + (size_t)i * 3 * 2048, 2048, ssin, ssb + (size_t)(9 + jl) * MTOK, 1024};
#ifndef NO_G1A
                pg8::gemm_phase<pg8::EpiAct<1>>(wv, ldsl, g, S, E);
#endif
 }
            else { const int N = kind == 1 ? 1536 : 1024; pg8::Gemm g{xb, kind == 1 ? wqkv : wcin, MTOK, N, 1024, 1024}; S.init(MTOK, N, G, bid);
                pg8::EpiAct<0> E{big1, N, biasG1 + (size_t)i * 3 * 2048, N, ssin, nullptr, 0};
#ifndef NO_G1B
                pg8::gemm_phase<pg8::EpiAct<0>>(wv, ldsl, g, S, E);
#endif
 }
        }
        xcd_barrier(xbar, wv);
        if (i < 3) {
            convert_matrix(wv, p.f_w_up + (size_t)(i + 1) * 1024 * NUP, 1024, NUP, NUP, 1, wup + (size_t)((i + 1) & 1) * NUP * 1024, ldsf, 0);
            convert_matrix(wv, p.f_w_down + (size_t)(i + 1) * FFD * 1024, FFD, 1024, 1024, 0, wdn + (size_t)((i + 1) & 1) * 1024 * FFD, ldsf, 96);
            if (bid >= G - 22) bias_task(wv, p.f_w_up + (size_t)(i + 1) * 1024 * NUP, NUP, 1, mod + (size_t)(i + 1) * 3 * MODW + 3 * DM, biasUP + (size_t)((i + 1) & 1) * 3 * NUP, NUP, bid - (G - 22), ldsf);
        }
#ifndef NO_SG
        if (kind == 0) sg_phase(wv, p, jl, lds);
#endif
#ifndef NO_ATT
        if (kind == 1) att_phase(wv, p, lds);
#endif
#ifndef NO_FFT
        if (kind == 2) {
#ifndef NO_FFT1
            if (bid < G / 2) fft1_units<64>(wv, p, lds, 0, 2, bid, G / 2); else fft1_units<128>(wv, p, lds, 2, 1, bid - G / 2, G - G / 2);
#endif
            xcd_barrier(xbar, wv);
#ifndef NO_FFT2
            fft2_phase(wv, p, lds);
#endif
        }
#endif
        xcd_barrier(xbar, wv);
        for (int half = 0; half < 2; ++half) {
            if (half == 1) {
                {   pg8::Gemm g{xb, wup + (size_t)(i & 1) * NUP * 1024, MTOK, NUP, 1024, 1024}; pg8::StaticOrder S; S.init(MTOK, NUP, G, bid);
                    pg8::EpiUp E{(bf16_t*)(ws + WS_ACT), biasUP + (size_t)(i & 1) * 3 * NUP, cwT + (size_t)i * 4 * NUP, ssb + (size_t)(2 * i + 1) * MTOK, (float*)(ws + WS_EDGE)};
#ifndef NO_UP
                    pg8::gemm_phase<pg8::EpiUp>(wv, ldsl, g, S, E);
#endif
 }
                xcd_barrier(xbar, wv);
                fix_phase(wv, p, i);
                xcd_barrier(xbar, wv);
            }
            pg8::Gemm g; const float* gate; const float* gsn; bf16_t* xbo = xb; float* ssn; const float* b0 = p.out; const float* b1 = p.out + (size_t)16384 * DM;
            if (half == 0) {
                if (kind == 0) g = pg8::Gemm{big1, waout + (size_t)jl * 1024 * 1024, MTOK, 1024, 1024, 2048};
                else if (kind == 1) g = pg8::Gemm{big1, wo, MTOK, 1024, 1024, 1536};
                else g = pg8::Gemm{big1, wf, MTOK, 1024, 2048, 2048};
                gate = mod + (size_t)i * 3 * MODW + 2 * DM; gsn = gsT + (size_t)(2 * i + 1) * 3 * DM; ssn = ssb + (size_t)(2 * i + 1) * MTOK;
                if (i == 0) { b0 = p.xp; b1 = p.xs; }
            } else {
                g = pg8::Gemm{(const bf16_t*)(ws + WS_ACT), wdn + (size_t)(i & 1) * 1024 * FFD, MTOK, 1024, FFD, FFD};
                gate = mod + (size_t)i * 3 * MODW + 5 * DM; gsn = gsT + (size_t)(2 * i + 2) * 3 * DM; ssn = ssb + (size_t)(2 * i + 2) * MTOK;
                if (i == 3) xbo = nullptr;
            }
            pg8::StaticOrder S; S.init(MTOK, 1024, G, bid);
            pg8::EpiRes E{b0, b1, p.out, gate, gsn, xbo, ssn};
#ifndef NO_RES
            pg8::gemm_phase<pg8::EpiRes>(wv, ldsl, g, S, E);
#endif
            xcd_barrier(xbar, wv);
        }
    }
    { const float* ssF = (const float*)(p.ws + WS_SS) + (size_t)8 * MTOK; const int tid = otid(wv);
        for (size_t idx = (size_t)bid * NTHR + tid; idx < (size_t)MTOK * DM / 4; idx += (size_t)G * NTHR) { const int r = (int)(idx >> 8), c = (int)(idx & 255) * 4;
            const float rs = 1.0f / sqrtf(ssF[r] * (1.0f / DM) + EPSN); f32x4 v = *(const f32x4*)(p.out + (size_t)r * DM + c); const f32x4 gf = *(const f32x4*)(p.g_final + c);
            v = v * rs * gf; *(f32x4*)(p.out + (size_t)r * DM + c) = v; } }
}

extern "C" void kernel_launch(void* const* d_in, const int* in_sizes, int n_in, void* d_out, int out_size, void* d_ws, size_t ws_size, hipStream_t stream) {
    static int grid_blocks = 0;
    if (!grid_blocks) {
        if (ws_size < WS_END) { fprintf(stderr, "kernel_launch: workspace too small: %zu < %zu\n", ws_size, (size_t)WS_END); grid_blocks = -1; return; }
        int dev = 0, cus = 0, per_cu = 0;
        hipGetDevice(&dev);
        hipDeviceGetAttribute(&cus, hipDeviceAttributeMultiprocessorCount, dev);
        hipFuncSetAttribute((const void*)mega, hipFuncAttributeMaxDynamicSharedMemorySize, LDS_BYTES);
        hipOccupancyMaxActiveBlocksPerMultiprocessor(&per_cu, (const void*)mega, NTHR, LDS_BYTES);
        if (per_cu < 1) { fprintf(stderr, "kernel_launch: occupancy query says %d blocks per CU\n", per_cu); per_cu = 1; }
        grid_blocks = cus;
        (void)hipGetLastError();
    }
    if (grid_blocks < 0) return;
    if (hipMemsetAsync((char*)d_ws + WS_BAR, 0, BAR_BYTES, stream) != hipSuccess) { fprintf(stderr, "kernel_launch: memset of the barrier words failed\n"); return; }
    Params p{};
    p.xp = (const float*)d_in[0]; p.xs = (const float*)d_in[1]; p.cp = (const float*)d_in[2]; p.csm = (const float*)d_in[3]; p.w_ada = (const float*)d_in[4]; p.b_ada = (const float*)d_in[5];
    p.norm_g = (const float*)d_in[6]; p.a_w_in = (const float*)d_in[7]; p.a_g_v = (const float*)d_in[8]; p.a_w_s = (const float*)d_in[9]; p.a_b_s = (const float*)d_in[10]; p.a_w_out = (const float*)d_in[11];
    p.b_w_qkv = (const float*)d_in[12]; p.b_sinks = (const float*)d_in[13]; p.b_w_o = (const float*)d_in[14]; p.c_w_in = (const float*)d_in[15]; p.c_w_out = (const float*)d_in[16];
    p.f_w_up = (const float*)d_in[17]; p.f_w_conv = (const float*)d_in[18]; p.f_b_conv = (const float*)d_in[19]; p.f_w_down = (const float*)d_in[20]; p.g_final = (const float*)d_in[21];
    p.out = (float*)d_out; p.ws = (unsigned char*)d_ws;
    void* args[] = {&p};
    hipError_t e = hipLaunchCooperativeKernel((const void*)mega, dim3(grid_blocks), dim3(NTHR), args, LDS_BYTES, stream);
    if (e != hipSuccess) fprintf(stderr, "cooperative launch failed: %s (grid %d)\n", hipGetErrorString(e), grid_blocks);
}
```

```cpp
#include <hip/hip_runtime.h>
#include <hip/hip_cooperative_groups.h>
#include <cstdio>
namespace cg = cooperative_groups;

#define LAS __attribute__((address_space(3)))
typedef unsigned short bf16_t;
typedef short bf16x8 __attribute__((ext_vector_type(8)));
typedef short bf16x4 __attribute__((ext_vector_type(4)));
typedef float f32x4 __attribute__((ext_vector_type(4)));
typedef unsigned u32x4 __attribute__((ext_vector_type(4)));
typedef unsigned u32x2 __attribute__((ext_vector_type(2)));

constexpr int DM = 1024, MTOK = 32768, FFD = 2816, NUP = 5632, MODW = 6144;
constexpr float EPSN = 1e-6f;
constexpr int NTHR = 512;
constexpr int LDS_BYTES = 147456;

constexpr size_t al256(size_t x) { return (x + 255) & ~(size_t)255; }
constexpr size_t WS_SS = 0;
constexpr size_t SS_BYTES = (size_t)11 * MTOK * 4;
constexpr size_t WS_MOD = al256(WS_SS + SS_BYTES);
constexpr size_t WS_GS = al256(WS_MOD + (size_t)4 * 3 * MODW * 4);
constexpr size_t WS_BG1 = al256(WS_GS + (size_t)9 * 3 * DM * 4);
constexpr size_t WS_BUP = al256(WS_BG1 + (size_t)4 * 3 * 2048 * 4);
constexpr size_t WS_CW = al256(WS_BUP + (size_t)2 * 3 * NUP * 4);
constexpr size_t WS_TAB = al256(WS_CW + (size_t)4 * 4 * NUP * 4);
constexpr size_t TAB_CT64 = 0, TAB_ST64 = 8192, TAB_CT128 = 16384, TAB_ST128 = 16384 + 32768;
constexpr size_t WS_BAR = al256(WS_TAB + 81920);
constexpr size_t BAR_BYTES = 3456 * 4;
constexpr size_t WS_WF32 = al256(WS_BAR + BAR_BYTES);
constexpr size_t WS_WAIN = al256(WS_WF32 + (size_t)2048 * 1024 * 4);
constexpr size_t WS_WAOUT = al256(WS_WAIN + (size_t)2 * 2048 * 1024 * 2);
constexpr size_t WS_WQKV = al256(WS_WAOUT + (size_t)2 * 1024 * 1024 * 2);
constexpr size_t WS_WO = al256(WS_WQKV + (size_t)1536 * 1024 * 2);
constexpr size_t WS_WCIN = al256(WS_WO + (size_t)1024 * 1024 * 2);
constexpr size_t WS_WF = al256(WS_WCIN + (size_t)1024 * 1024 * 2);
constexpr size_t WS_WUP = al256(WS_WF + (size_t)1024 * 2048 * 2);
constexpr size_t WS_WDN = al256(WS_WUP + (size_t)2 * NUP * 1024 * 2);
constexpr size_t WS_XB = al256(WS_WDN + (size_t)2 * 1024 * FFD * 2);
constexpr size_t WS_BIG1 = al256(WS_XB + (size_t)MTOK * DM * 2);
constexpr size_t WS_BIG2 = al256(WS_BIG1 + (size_t)MTOK * 2048 * 2);
constexpr size_t WS_ACT = WS_BIG1;
constexpr size_t WS_EDGE = al256(WS_ACT + (size_t)MTOK * FFD * 2);
constexpr size_t WS_END = al256(WS_BIG2 + (size_t)MTOK * 2048 * 2);
static_assert(WS_EDGE + (size_t)512 * 4 * NUP * 4 <= WS_END, "edge buffer must fit");

struct Params {
    const float* xp; const float* xs; const float* cp; const float* csm; const float* w_ada; const float* b_ada; const float* norm_g;
    const float* a_w_in; const float* a_g_v; const float* a_w_s; const float* a_b_s; const float* a_w_out;
    const float* b_w_qkv; const float* b_sinks; const float* b_w_o; const float* c_w_in; const float* c_w_out;
    const float* f_w_up; const float* f_w_conv; const float* f_b_conv; const float* f_w_down; const float* g_final;
    float* out; unsigned char* ws;
};

__device__ __forceinline__ int otid(int wv) { int t; asm volatile("v_mbcnt_lo_u32_b32 %0, -1, 0\n\tv_mbcnt_hi_u32_b32 %0, -1, %0\n\tv_lshl_add_u32 %0, %1, 6, %0" : "=&v"(t) : "s"(wv)); return t; }
typedef __bf16 bf2_t __attribute__((ext_vector_type(2)));
typedef float f2_t __attribute__((ext_vector_type(2)));
__device__ __forceinline__ unsigned cvt_pk_bf16_asm(float lo, float hi) { unsigned r; asm volatile("v_cvt_pk_bf16_f32 %0, %1, %2" : "=v"(r) : "v"(lo), "v"(hi)); return r; }
__device__ __forceinline__ unsigned cvt_pk_bf16(float lo, float hi) { const f2_t v = {lo, hi}; const bf2_t b = __builtin_convertvector(v, bf2_t); return __builtin_bit_cast(unsigned, b); }
__device__ __forceinline__ bf16_t f2bf(float f) { return (bf16_t)(cvt_pk_bf16(f, 0.f) & 0xffffu); }
__device__ __forceinline__ int seq_of_row(int r) { return r < 8192 ? 0 : (r < 16384 ? 1 : 2); }
__device__ __forceinline__ int upcol(int n) { return (n >> 8) * 128 + (n & 127) + ((n & 128) ? FFD : 0); }

namespace pg8 {
constexpr int BM = 256, BK = 64, HALF = 128, HTB = HALF * BK * 2, STAGE_BYTES = 8 * HTB, NXCD = 8, WGM = 8;
__device__ __forceinline__ int lds_byte(int r, int c) { const int st = (r >> 4) * 2 + (c >> 5), rr = r & 15, cc = c & 31, ob = rr * 64 + cc * 2; return st * 1024 + (ob ^ (((ob >> 9) & 1) << 5)); }
__device__ __forceinline__ void stage_rc(int b, int& R, int& C) { const int st = b / 1024, sb = b % 1024, swz = sb ^ (((sb >> 9) & 1) << 5); R = (st >> 1) * 16 + swz / 64; C = (st & 1) * 32 + (swz % 64) / 2; }
__device__ __forceinline__ int perm32(int rho) { const int n = rho >> 4, i = rho & 15; return 8 * (i >> 2) + 4 * n + (i & 3); }
struct Unit { int pm, pn; };
struct Gemm { const bf16_t* A; const bf16_t* Bt; int M, N, K, lda; };
struct StaticOrder {
    int nM, nN, nwg, G, c;
    __device__ void init(int M, int N, int G_, int c_) { nM = M / BM; nN = N / BM; nwg = nM * nN; G = G_; c = c_; }
    __device__ bool next(int i, Unit& u) const {
        const long L = (long)i * G + c; if (L >= nwg) return false;
        int wgid = (int)L; { const int q = nwg / NXCD, r = nwg % NXCD, xcd = wgid % NXCD, off = wgid / NXCD; wgid = (xcd < r ? xcd * (q + 1) : r * (q + 1) + (xcd - r) * q) + off; }
        const int nig = WGM * nN, gid = wgid / nig, fm = gid * WGM, gsz = (nM - fm) < WGM ? (nM - fm) : WGM;
        u.pm = fm + ((wgid % nig) % gsz); u.pn = (wgid % nig) / gsz; return true;
    }
};

template <class Epi>
__device__ __forceinline__ void gemm_phase(int wv, LAS unsigned char* lds, const Gemm g, const StaticOrder& S, const Epi& E) {
    const int tid = otid(wv), wid = __builtin_amdgcn_readfirstlane(tid >> 6), lane = tid & 63, wr = wid >> 2, wc = wid & 3, fr = lane & 15, fq = lane >> 4;
    const int K = g.K, nt = K / BK, lda = g.lda;
    unsigned voffA[2], voffB[2];
#pragma unroll
    for (int i = 0; i < 2; ++i) { int R, C; stage_rc(tid * 16 + i * 8192, R, C); const int Rb = Epi::PERM ? ((R & ~31) + perm32(R & 31)) : R;
        voffA[i] = (unsigned)(R * lda + C) * 2u; voffB[i] = (unsigned)(Rb * K + C) * 2u; }
    const size_t kstep = (size_t)(BK * 2);
    const size_t hstepA = (size_t)HALF * lda * 2, hstepB = (size_t)HALF * K * 2;
    const size_t tstepA = 2 * hstepA, tstepB = 2 * hstepB;
    const unsigned ldsw = (unsigned)wid * 1024u;
    const int aoff = lds_byte(wr * 64 + fr, fq * 8), boff = lds_byte(wc * 32 + fr, fq * 8);
#define PG8_SA(b, h) (((b) * 2 + (h)) * HTB)
#define PG8_SB(b, h) ((4 + (b) * 2 + (h)) * HTB)
#define PG8_STAGE(bufoff, gbase, voff) do { _Pragma("unroll") for (int _i = 0; _i < 2; ++_i) \
        __builtin_amdgcn_global_load_lds((const unsigned*)((const char*)(gbase) + (voff)[_i]), (LAS unsigned*)(lds + (bufoff) + ldsw + _i * 8192), 16, 0, 0); } while (0)
#define PG8_LDA(dst, b, h) do { _Pragma("unroll") for (int m = 0; m < 4; ++m) _Pragma("unroll") for (int k = 0; k < 2; ++k) dst[m][k] = *(const LAS bf16x8*)(lds + PG8_SA(b, h) + aoff + m * 2048 + k * 1024); } while (0)
#define PG8_LDB(dst, b, h) do { _Pragma("unroll") for (int n = 0; n < 2; ++n) _Pragma("unroll") for (int k = 0; k < 2; ++k) dst[n][k] = *(const LAS bf16x8*)(lds + PG8_SB(b, h) + boff + n * 2048 + k * 1024); } while (0)
#define PG8_MMA(ai, bj, At, Bt) do { __builtin_amdgcn_s_setprio(1); _Pragma("unroll") for (int m = 0; m < 4; ++m) _Pragma("unroll") for (int n = 0; n < 2; ++n) _Pragma("unroll") for (int k = 0; k < 2; ++k) \
        acc[ai][bj][m][n] = __builtin_amdgcn_mfma_f32_16x16x32_bf16(Bt[n][k], At[m][k], acc[ai][bj][m][n], 0, 0, 0); __builtin_amdgcn_s_setprio(0); } while (0)
#define PG8_WAIT_V(n) asm volatile("s_waitcnt vmcnt(" #n ")" ::: "memory")
#define PG8_WAIT_L(n) asm volatile("s_waitcnt lgkmcnt(" #n ")" ::: "memory")
#define PG8_BAR __builtin_amdgcn_s_barrier()
#define PG8_SCHED __builtin_amdgcn_sched_barrier(0)
    Unit cur, nxt; int ui = 0;
    if (!S.next(0, cur)) return;
    f32x4 acc[2][2][4][2];
#pragma unroll
    for (int a = 0; a < 2; ++a)
#pragma unroll
        for (int b = 0; b < 2; ++b)
#pragma unroll
            for (int m = 0; m < 4; ++m)
#pragma unroll
                for (int n = 0; n < 2; ++n) acc[a][b][m][n] = (f32x4){0.f, 0.f, 0.f, 0.f};
    bf16x8 At[4][2], B0[2][2], B1[2][2];
    const char* cA = (const char*)g.A + (size_t)cur.pm * tstepA; const char* cB = (const char*)g.Bt + (size_t)cur.pn * tstepB;
    PG8_STAGE(PG8_SB(0, 0), cB, voffB); PG8_STAGE(PG8_SA(0, 0), cA, voffA); PG8_STAGE(PG8_SB(0, 1), cB + hstepB, voffB); PG8_STAGE(PG8_SA(0, 1), cA + hstepA, voffA);
    if (wr == 1) PG8_BAR;
    PG8_WAIT_V(4); PG8_BAR;
    PG8_STAGE(PG8_SB(1, 0), cB + kstep, voffB); PG8_STAGE(PG8_SA(1, 0), cA + kstep, voffA); PG8_STAGE(PG8_SB(1, 1), cB + hstepB + kstep, voffB);
    PG8_WAIT_V(6); PG8_BAR;
    for (;;) {
        const bool has_next = S.next(ui + 1, nxt);
        const char* nA = has_next ? (const char*)g.A + (size_t)nxt.pm * tstepA : cA; const char* nB = has_next ? (const char*)g.Bt + (size_t)nxt.pn * tstepB : cB;
        for (int t = 0; t < nt; t += 2) {
            const bool last = (t == nt - 2);
            const char* a1 = cA + (size_t)(t + 1) * kstep;
            const char* a2 = last ? nA : cA + (size_t)(t + 2) * kstep; const char* b2 = last ? nB : cB + (size_t)(t + 2) * kstep;
            const char* a3 = a2 + kstep; const char* b3 = b2 + kstep;
            PG8_LDB(B0, 0, 0); PG8_SCHED; PG8_LDA(At, 0, 0); PG8_STAGE(PG8_SA(1, 1), a1 + hstepA, voffA);
            PG8_WAIT_L(8); PG8_BAR; PG8_WAIT_L(0); PG8_MMA(0, 0, At, B0); PG8_BAR; PG8_SCHED;
            PG8_LDB(B1, 0, 1); PG8_STAGE(PG8_SB(0, 0), b2, voffB);
            PG8_BAR; PG8_WAIT_L(0); PG8_MMA(0, 1, At, B1); PG8_BAR;
            PG8_LDA(At, 0, 1); PG8_STAGE(PG8_SA(0, 0), a2, voffA);
            PG8_BAR; PG8_WAIT_L(0); PG8_MMA(1, 0, At, B0); PG8_BAR; PG8_SCHED;
            PG8_STAGE(PG8_SB(0, 1), b2 + hstepB, voffB);
            PG8_WAIT_V(6); PG8_BAR; PG8_MMA(1, 1, At, B1); PG8_BAR;
            PG8_LDB(B0, 1, 0); PG8_SCHED; PG8_LDA(At, 1, 0); PG8_STAGE(PG8_SA(0, 1), a2 + hstepA, voffA);
            PG8_WAIT_L(8); PG8_BAR; PG8_WAIT_L(0); PG8_MMA(0, 0, At, B0); PG8_BAR; PG8_SCHED;
            PG8_LDB(B1, 1, 1); PG8_STAGE(PG8_SB(1, 0), b3, voffB);
            PG8_BAR; PG8_WAIT_L(0); PG8_MMA(0, 1, At, B1); PG8_BAR;
            PG8_LDA(At, 1, 1); PG8_STAGE(PG8_SA(1, 0), a3, voffA);
            PG8_BAR; PG8_WAIT_L(0); PG8_MMA(1, 0, At, B0); PG8_BAR; PG8_SCHED;
            PG8_STAGE(PG8_SB(1, 1), b3 + hstepB, voffB);
            PG8_WAIT_V(6); PG8_BAR; PG8_MMA(1, 1, At, B1); PG8_BAR;
        }
        E(acc, cur, wr, wc, fr, fq);
        if (!has_next) break;
#pragma unroll
        for (int a = 0; a < 2; ++a)
#pragma unroll
            for (int b = 0; b < 2; ++b)
#pragma unroll
                for (int m = 0; m < 4; ++m)
#pragma unroll
                    for (int n = 0; n < 2; ++n) acc[a][b][m][n] = (f32x4){0.f, 0.f, 0.f, 0.f};
        cur = nxt; cA = nA; cB = nB; ++ui;
    }
    PG8_WAIT_V(0);
    if (wr == 0) PG8_BAR;
    PG8_BAR;
#undef PG8_SA
#undef PG8_SB
#undef PG8_STAGE
#undef PG8_LDA
#undef PG8_LDB
#undef PG8_MMA
#undef PG8_WAIT_V
#undef PG8_WAIT_L
#undef PG8_BAR
#undef PG8_SCHED
}

typedef float f32x2 __attribute__((ext_vector_type(2)));
__device__ __forceinline__ f32x2 gelu_pk(f32x2 v) {
    const f32x2 av = __builtin_elementwise_abs(v), d = av * 0.2316418882f + 1.0f;
    f32x2 t; t.x = __builtin_amdgcn_rcpf(d.x); t.y = __builtin_amdgcn_rcpf(d.y);
    f32x2 q = t * 0.5307027145f + (-0.7265760135f); q = q * t + 0.7107068705f; q = q * t + (-0.142248368f); q = q * t + 0.127414796f; q = q * t;
    const f32x2 s = (v * v) * (-0.72134752044f);
    f32x2 e; e.x = __builtin_amdgcn_exp2f(s.x); e.y = __builtin_amdgcn_exp2f(s.y);
    const f32x2 m = v * (q * e), r = v - m;
    f32x2 o; o.x = v.x < 0.f ? m.x : r.x; o.y = v.y < 0.f ? m.y : r.y; return o;
}
__device__ __forceinline__ f32x4 gelu4(f32x4 v) { f32x2 a = gelu_pk((f32x2){v[0], v[1]}), b = gelu_pk((f32x2){v[2], v[3]}); return (f32x4){a.x, a.y, b.x, b.y}; }

template <int ACT> struct EpiAct {
    static constexpr bool PERM = true;
    bf16_t* O; int ldc; const float* bias; int nb; const float* ssin; float* vss; int vcol0;
    __device__ __forceinline__ void operator()(const f32x4 (&acc)[2][2][4][2], const Unit& u, int wr, int wc, int fr, int fq) const {
        asm volatile("" : "+v"(fr), "+v"(fq));
        const int row0 = u.pm * BM + wr * 64 + fr, col0 = u.pn * BM + wc * 32 + 8 * fq;
        const int seq = seq_of_row(u.pm * BM);
        const float* bp = bias + (size_t)seq * nb + col0;
        f32x4 bv[2][2]; float rsv[2][4];
#pragma unroll
        for (int bj = 0; bj < 2; ++bj)
#pragma unroll
            for (int n = 0; n < 2; ++n) bv[bj][n] = *(const f32x4*)(bp + bj * HALF + 4 * n);
#pragma unroll
        for (int ai = 0; ai < 2; ++ai)
#pragma unroll
            for (int m = 0; m < 4; ++m) rsv[ai][m] = ssin[row0 + ai * HALF + m * 16];
#pragma unroll
        for (int ai = 0; ai < 2; ++ai)
#pragma unroll
            for (int m = 0; m < 4; ++m) rsv[ai][m] = __builtin_amdgcn_rsqf(rsv[ai][m] * (1.0f / DM) + EPSN);
        const bool dov = (ACT == 1) && (u.pn * BM >= vcol0);
#pragma unroll
        for (int ai = 0; ai < 2; ++ai)
#pragma unroll
            for (int m = 0; m < 4; ++m) {
                const int r = row0 + ai * HALF + m * 16;
                const float rs = rsv[ai][m];
                bf16_t* rowp = O + (size_t)r * ldc + col0; float s = 0.f;
#pragma unroll
                for (int bj = 0; bj < 2; ++bj) { f32x4 v0 = acc[ai][bj][m][0] * rs + bv[bj][0], v1 = acc[ai][bj][m][1] * rs + bv[bj][1];
                    if (ACT == 1) { v0 = gelu4(v0); v1 = gelu4(v1); s += (v0[0] * v0[0] + v0[1] * v0[1]) + (v0[2] * v0[2] + v0[3] * v0[3]) + (v1[0] * v1[0] + v1[1] * v1[1]) + (v1[2] * v1[2] + v1[3] * v1[3]); }
                    u32x4 w; w.x = cvt_pk_bf16_asm(v0[0], v0[1]); w.y = cvt_pk_bf16_asm(v0[2], v0[3]); w.z = cvt_pk_bf16_asm(v1[0], v1[1]); w.w = cvt_pk_bf16_asm(v1[2], v1[3]);
                    *(u32x4*)(rowp + bj * HALF) = w; }
                if (ACT == 1) { s += __shfl_xor(s, 16); s += __shfl_xor(s, 32); if (dov && fq == 0) (void)__hip_atomic_fetch_add(vss + r, s, __ATOMIC_RELAXED, __HIP_MEMORY_SCOPE_AGENT); }
            }
    }
};

struct EpiRes {
    static constexpr bool PERM = false;
    const float* base0; const float* base1; float* xout; const float* gate; const float* gs; bf16_t* xb; float* ssn;
    __device__ __forceinline__ void operator()(const f32x4 (&acc)[2][2][4][2], const Unit& u, int wr, int wc, int fr, int fq) const {
        asm volatile("" : "+v"(fr), "+v"(fq));
        const int row0 = u.pm * BM + wr * 64 + fr, col0 = u.pn * BM + wc * 32 + 4 * fq;
        const int seq = seq_of_row(u.pm * BM);
        const float* gp = gate + (size_t)seq * MODW + col0; const float* gsp = gs + (size_t)seq * DM + col0;
        f32x4 gv[2][2], gsv[2][2];
#pragma unroll
        for (int bj = 0; bj < 2; ++bj)
#pragma unroll
            for (int n = 0; n < 2; ++n) { gv[bj][n] = *(const f32x4*)(gp + bj * HALF + n * 16); gsv[bj][n] = *(const f32x4*)(gsp + bj * HALF + n * 16); }
        const float* bbase = (u.pm * BM < 16384 ? base0 + (size_t)row0 * DM : base1 + (size_t)(row0 - 16384) * DM) + col0;
        f32x4 xr[3][2][2];
#pragma unroll
        for (int g0 = 0; g0 < 2; ++g0) { const float* bp = bbase + (size_t)((g0 >> 2) * HALF + (g0 & 3) * 16) * DM;
#pragma unroll
            for (int bj = 0; bj < 2; ++bj)
#pragma unroll
                for (int n = 0; n < 2; ++n) xr[g0][bj][n] = *(const f32x4*)(bp + bj * HALF + n * 16); }
#pragma unroll
        for (int g8 = 0; g8 < 8; ++g8) { const int ai = g8 >> 2, m = g8 & 3;
            if (g8 < 6) { const int gn = g8 + 2; const float* bp = bbase + (size_t)((gn >> 2) * HALF + (gn & 3) * 16) * DM;
#pragma unroll
                for (int bj = 0; bj < 2; ++bj)
#pragma unroll
                    for (int n = 0; n < 2; ++n) xr[gn % 3][bj][n] = *(const f32x4*)(bp + bj * HALF + n * 16); }
            const int r = row0 + ai * HALF + m * 16;
            float* op = xout + (size_t)r * DM + col0; float s = 0.f;
#pragma unroll
            for (int bj = 0; bj < 2; ++bj)
#pragma unroll
                for (int n = 0; n < 2; ++n) { const f32x4 xn = xr[g8 % 3][bj][n] + gv[bj][n] * acc[ai][bj][m][n];
                    *(f32x4*)(op + bj * HALF + n * 16) = xn; s += (xn[0] * xn[0] + xn[1] * xn[1]) + (xn[2] * xn[2] + xn[3] * xn[3]);
                    if (xb) { const f32x4 h = xn * gsv[bj][n]; u32x2 w; w.x = cvt_pk_bf16_asm(h[0], h[1]); w.y = cvt_pk_bf16_asm(h[2], h[3]);
                        *(u32x2*)(xb + (size_t)r * DM + col0 + bj * HALF + n * 16) = w; } }
            s += __shfl_xor(s, 16); s += __shfl_xor(s, 32); if (fq == 0) (void)__hip_atomic_fetch_add(ssn + r, s, __ATOMIC_RELAXED, __HIP_MEMORY_SCOPE_AGENT);
        }
    }
};

struct EpiUp {
    static constexpr bool PERM = true;
    bf16_t* act; const float* bias; const float* cw; const float* ssin; float* edge;
    __device__ __forceinline__ void operator()(const f32x4 (&acc)[2][2][4][2], const Unit& u, int wr, int wc, int fr, int fq) const {
        asm volatile("" : "+v"(fr), "+v"(fq));
        const int row0 = u.pm * BM + wr * 64 + fr, colt = u.pn * BM + wc * 32 + 8 * fq;
        const int seq = seq_of_row(u.pm * BM);
        const float* biasp = bias + (size_t)seq * NUP + colt; const float* cwp = cw + colt;
        float rs[2][4];
#pragma unroll
        for (int ai = 0; ai < 2; ++ai)
#pragma unroll
            for (int m = 0; m < 4; ++m) rs[ai][m] = ssin[row0 + ai * HALF + m * 16];
#pragma unroll
        for (int ai = 0; ai < 2; ++ai)
#pragma unroll
            for (int m = 0; m < 4; ++m) rs[ai][m] = __builtin_amdgcn_rsqf(rs[ai][m] * (1.0f / DM) + EPSN);
#pragma unroll
        for (int n = 0; n < 2; ++n) {
            f32x4 prm[2][5];
#pragma unroll
            for (int bj = 0; bj < 2; ++bj) { const int co = bj * HALF + 4 * n;
                prm[bj][0] = *(const f32x4*)(biasp + co); prm[bj][1] = *(const f32x4*)(cwp + co); prm[bj][2] = *(const f32x4*)(cwp + NUP + co); prm[bj][3] = *(const f32x4*)(cwp + 2 * NUP + co); prm[bj][4] = *(const f32x4*)(cwp + 3 * NUP + co); }
#pragma unroll
            for (int ai = 0; ai < 2; ++ai) {
                float* ep = edge + (size_t)(u.pm * 4 + ai * 2 + wr) * 4 * NUP + colt;
                f32x4 SG[4];
#pragma unroll
                for (int bjr = 0; bjr < 2; ++bjr) { const int bj = 1 - bjr; const int co = bj * HALF + 4 * n;
                    f32x4 U[4];
#pragma unroll
                    for (int m = 0; m < 4; ++m) U[m] = acc[ai][bj][m][n] * rs[ai][m] + prm[bj][0];
                    if (fr < 2) *(f32x4*)(ep + (size_t)fr * NUP + co) = U[0];
                    if (fr >= 14) *(f32x4*)(ep + (size_t)(fr - 12) * NUP + co) = U[3];
#pragma unroll
                    for (int m = 0; m < 4; ++m) { const f32x4 sp = (fr == 15 && m > 0) ? U[m > 0 ? m - 1 : 0] : U[m]; const f32x4 sn = (fr == 0 && m < 3) ? U[m < 3 ? m + 1 : 3] : U[m];
                        f32x4 pv, nv;
#pragma unroll
                        for (int j = 0; j < 4; ++j) { pv[j] = __int_as_float(__builtin_amdgcn_update_dpp(0, __float_as_int(sp[j]), 0x121, 0xf, 0xf, false)); nv[j] = __int_as_float(__builtin_amdgcn_update_dpp(0, __float_as_int(sn[j]), 0x12F, 0xf, 0xf, false)); }
                        const f32x4 R = prm[bj][1] * pv + prm[bj][2] * U[m] + prm[bj][3] * nv + prm[bj][4];
                        if (bj == 1) {
#pragma unroll
                            for (int j = 0; j < 4; ++j) SG[m][j] = R[j] * __builtin_amdgcn_rcpf(1.0f + __expf(-R[j])); }
                        else { const int r = row0 + ai * HALF + m * 16; const bool skip = (m == 0 && fr == 0) || (m == 3 && fr == 15);
                            const f32x4 o = R * SG[m]; u32x2 w; w.x = cvt_pk_bf16_asm(o[0], o[1]); w.y = cvt_pk_bf16_asm(o[2], o[3]);
                            if (!skip) *(u32x2*)(act + (size_t)r * FFD + u.pn * 128 + wc * 32 + 8 * fq + 4 * n) = w; } } } }
        }
    }
};
}

__device__ __forceinline__ float silu_f(float x) { return x / (1.0f + __expf(-x)); }

__device__ void mod_task(int wv, const Params& p, int tk, float* ldsf) {
    const int tid = otid(wv), i = tk / 48, cgp = tk % 48;
    float* csL = ldsf; float* red = ldsf + 3072;
    for (int idx = tid; idx < 3072; idx += NTHR) { const int seq = idx >> 10, k = idx & 1023; const float c = seq < 2 ? p.cp[seq * DM + k] : p.csm[k]; csL[idx] = silu_f(c); }
    __syncthreads();
    const int quad = tid & 31, ksl = tid >> 5;
    const float* W = p.w_ada + (size_t)i * DM * MODW + (size_t)ksl * 64 * MODW + 128 * cgp + 4 * quad;
    f32x4 a0 = {0, 0, 0, 0}, a1 = {0, 0, 0, 0}, a2 = {0, 0, 0, 0};
#pragma unroll 8
    for (int kk = 0; kk < 64; ++kk) { const f32x4 w = *(const f32x4*)(W + (size_t)kk * MODW); const int k = ksl * 64 + kk;
        a0 += w * csL[k]; a1 += w * csL[1024 + k]; a2 += w * csL[2048 + k]; }
    float* rp = red + (ksl * 32 + quad) * 12;
    *(f32x4*)(rp) = a0; *(f32x4*)(rp + 4) = a1; *(f32x4*)(rp + 8) = a2;
    __syncthreads();
    if (tid < 384) { const int q = tid & 31, e = tid >> 5; float s = 0.f;
        for (int k = 0; k < 16; ++k) s += red[(k * 32 + q) * 12 + e];
        const int seq = e >> 2, col = 128 * cgp + 4 * q + (e & 3);
        float* mod = (float*)(p.ws + WS_MOD);
        mod[((size_t)i * 3 + seq) * MODW + col] = s + p.b_ada[i * MODW + col]; }
    __syncthreads();
}

__device__ void wf_task(int wv, const Params& p, int task, float* ldsf) {
    const int tid = otid(wv), g = task >> 4, n0 = (task & 15) * 64;
    float* tile = ldsf; float* ct = ldsf + 128 * 64;
    for (int idx = tid; idx < 128 * 16; idx += NTHR) { const int cp_ = idx >> 4, n4 = (idx & 15) * 4;
        *(f32x4*)(tile + cp_ * 64 + n4) = *(const f32x4*)(p.c_w_out + (size_t)(g * 128 + cp_) * DM + n0 + n4); }
    if (tid < 128) ct[tid] = cospif(2.0f * tid / 128.0f) * 0.08838834764831845f;
    __syncthreads();
    const int n = tid & 63, wvl = __builtin_amdgcn_readfirstlane(tid >> 6);
    float ac[16], as[16];
#pragma unroll
    for (int c = 0; c < 16; ++c) { ac[c] = 0.f; as[c] = 0.f; }
    for (int cq = 0; cq < 128; ++cq) { const float v = tile[cq * 64 + n];
#pragma unroll
        for (int cc = 0; cc < 16; ++cc) { const int idx = ((wvl * 16 + cc) * cq) & 127; ac[cc] += ct[idx] * v; as[cc] += ct[(idx + 96) & 127] * v; } }
    float* Wf = (float*)(p.ws + WS_WF32);
#pragma unroll
    for (int cc = 0; cc < 16; ++cc) { const int c = wvl * 16 + cc; Wf[(size_t)(g * 128 + c) * DM + n0 + n] = ac[cc]; Wf[(size_t)(1024 + g * 128 + c) * DM + n0 + n] = as[cc]; }
    __syncthreads();
}

__device__ void convert_matrix(int wv, const float* src, int K, int N, int ld, int perm, bf16_t* dst, float* tileL, int rot) {
    const int tid = otid(wv), G = gridDim.x, ntk = K >> 6, ntiles = ntk * (N >> 8);
    for (int t = (blockIdx.x + G - (rot % G)) % G; t < ntiles; t += G) {
        const int k0 = (t % ntk) * 64, n0 = (t / ntk) * 256;
        f32x4 v[8];
#pragma unroll
        for (int ps = 0; ps < 8; ++ps) { const int idx = tid + ps * NTHR, kk = idx >> 6, n4 = (idx & 63) * 4; const int sc = perm ? upcol(n0 + n4) : n0 + n4;
            v[ps] = *(const f32x4*)(src + (size_t)(k0 + kk) * ld + sc); }
#pragma unroll
        for (int ps = 0; ps < 8; ++ps) { const int idx = tid + ps * NTHR, kk = idx >> 6, n4 = (idx & 63) * 4;
            float* tp = tileL + kk * 257 + n4; tp[0] = v[ps][0]; tp[1] = v[ps][1]; tp[2] = v[ps][2]; tp[3] = v[ps][3]; }
        __syncthreads();
        { const int n = tid >> 1, kh = (tid & 1) * 32;
#pragma unroll
            for (int q = 0; q < 4; ++q) { float e[8];
#pragma unroll
                for (int j = 0; j < 8; ++j) e[j] = tileL[(kh + 8 * q + j) * 257 + n];
                u32x4 w; w.x = cvt_pk_bf16(e[0], e[1]); w.y = cvt_pk_bf16(e[2], e[3]); w.z = cvt_pk_bf16(e[4], e[5]); w.w = cvt_pk_bf16(e[6], e[7]);
                *(u32x4*)(dst + (size_t)(n0 + n) * K + k0 + kh + 8 * q) = w; } }
        __syncthreads();
    }
}

__device__ void bias_task(int wv, const float* W, int ld, int perm, const float* sh, float* bias, int nb, int grp, float* red) {
    const int tid = otid(wv), quad = tid & 63, ksl = __builtin_amdgcn_readfirstlane(tid >> 6);
    const int nn = 256 * grp + 4 * quad, sc = perm ? upcol(nn) : nn;
    f32x4 a0 = {0, 0, 0, 0}, a1 = {0, 0, 0, 0}, a2 = {0, 0, 0, 0};
    const float* wp = W + (size_t)ksl * 128 * ld + sc; const float* s0 = sh + ksl * 128;
#pragma unroll 16
    for (int kk = 0; kk < 128; ++kk) { const f32x4 w = *(const f32x4*)(wp + (size_t)kk * ld); a0 += w * s0[kk]; a1 += w * s0[MODW + kk]; a2 += w * s0[2 * MODW + kk]; }
    float* rp = red + (ksl * 64 + quad) * 12;
    *(f32x4*)(rp) = a0; *(f32x4*)(rp + 4) = a1; *(f32x4*)(rp + 8) = a2;
    __syncthreads();
    for (int idx = tid; idx < 768; idx += NTHR) { const int q = idx & 63, e = idx >> 6; float s = 0.f;
        for (int k = 0; k < 8; ++k) s += red[(k * 64 + q) * 12 + e];
        bias[(size_t)(e >> 2) * nb + 256 * grp + 4 * q + (e & 3)] = s; }
    __syncthreads();
}

__device__ __forceinline__ f32x4 mfma16(bf16x8 a, bf16x8 b, f32x4 c) { return __builtin_amdgcn_mfma_f32_16x16x32_bf16(a, b, c, 0, 0, 0); }

__device__ void sg_phase(int wv, const Params& p, int jl, unsigned char* lds) {
    const int tid = otid(wv), lane = tid & 63, w = __builtin_amdgcn_readfirstlane(tid >> 6), lr = lane & 15, lq = lane >> 4;
    bf16_t* uv = (bf16_t*)(p.ws + WS_BIG1);
    const float* vss = (const float*)(p.ws + WS_SS) + (size_t)(9 + jl) * MTOK;
    constexpr int PW = 136;
    bf16_t* WsL = (bf16_t*)lds; bf16_t* VTL = WsL + 128 * PW; float* rsL = (float*)(VTL + 128 * PW);
    for (int unit = blockIdx.x; unit < 2048; unit += gridDim.x) {
        const int ch = unit >> 3, g = unit & 7, t0 = ch * 128;
        if (tid < 128) rsL[tid] = 1.0f / sqrtf(vss[t0 + tid] * (1.0f / DM) + EPSN);
        __syncthreads();
        const float* ws = p.a_w_s + ((size_t)jl * 8 + g) * 128 * 128;
#pragma unroll
        for (int ps = 0; ps < 8; ++ps) { const int idx = tid + ps * NTHR, t = idx >> 5, s4 = (idx & 31) * 4;
            const f32x4 wv = *(const f32x4*)(ws + t * 128 + s4); const f32x4 r4 = *(const f32x4*)(rsL + s4); const f32x4 x = wv * r4;
            u32x2 pk; pk.x = cvt_pk_bf16(x[0], x[1]); pk.y = cvt_pk_bf16(x[2], x[3]); *(u32x2*)(WsL + t * PW + s4) = pk; }
#pragma unroll
        for (int ps = 0; ps < 4; ++ps) { const int idx = tid + ps * NTHR, s = idx & 127, d8 = (idx >> 7) * 8;
            const bf16x8 v = *(const bf16x8*)(uv + (size_t)(t0 + s) * 2048 + 1024 + g * 128 + d8);
#pragma unroll
            for (int e = 0; e < 8; ++e) VTL[(d8 + e) * PW + s] = (bf16_t)v[e]; }
        __syncthreads();
        bf16x8 af[4];
#pragma unroll
        for (int kk = 0; kk < 4; ++kk) af[kk] = *(const bf16x8*)(WsL + (16 * w + lr) * PW + 32 * kk + 8 * lq);
        const int tok = t0 + 16 * w + lr; const float bs = p.a_b_s[((size_t)jl * 8 + g) * 128 + 16 * w + lr];
#pragma unroll
        for (int db = 0; db < 8; ++db) { f32x4 acc = {0, 0, 0, 0};
#pragma unroll
            for (int kk = 0; kk < 4; ++kk) { const bf16x8 bf = *(const bf16x8*)(VTL + (16 * db + lr) * PW + 32 * kk + 8 * lq); acc = mfma16(bf, af[kk], acc); }
            const int col = g * 128 + 16 * db + 4 * lq; const f32x4 gv = *(const f32x4*)(p.a_g_v + jl * DM + col);
            bf16_t* up = uv + (size_t)tok * 2048 + col; const u32x2 uu = *(const u32x2*)up;
            const float u0 = __uint_as_float(uu.x << 16), u1 = __uint_as_float(uu.x & 0xffff0000u), u2 = __uint_as_float(uu.y << 16), u3 = __uint_as_float(uu.y & 0xffff0000u);
            const f32x4 sv = acc * gv + bs; u32x2 o; o.x = cvt_pk_bf16(u0 * sv[0], u1 * sv[1]); o.y = cvt_pk_bf16(u2 * sv[2], u3 * sv[3]);
            *(u32x2*)up = o; }
        __syncthreads();
    }
}

__device__ void att_phase(int wv, const Params& p, unsigned char* lds) {
    const int tid = otid(wv), lane = tid & 63, w = __builtin_amdgcn_readfirstlane(tid >> 6), lr = lane & 15, lq = lane >> 4;
    bf16_t* qkv = (bf16_t*)(p.ws + WS_BIG1);
    constexpr int KP = 72, VP = 392;
    bf16_t* KL = (bf16_t*)lds; bf16_t* VTL = KL + 384 * KP;
    for (int unit = blockIdx.x; unit < 1024; unit += gridDim.x) {
        const int B = unit >> 2, kh = unit & 3;
        const int sb = B < 64 ? 0 : (B < 128 ? 64 : 128), se = B < 64 ? 64 : (B < 128 ? 128 : 256);
#pragma unroll
        for (int ps = 0; ps < 6; ++ps) { const int idx = tid + ps * NTHR, s = idx >> 3, c8 = (idx & 7) * 8; const int kb = B - 1 + (s >> 7);
            bf16x8 kv = {0, 0, 0, 0, 0, 0, 0, 0}, vv = {0, 0, 0, 0, 0, 0, 0, 0};
            if (kb >= sb && kb < se) { const bf16_t* rp = qkv + (size_t)(kb * 128 + (s & 127)) * 1536 + 64 * kh + c8; kv = *(const bf16x8*)(rp + 1024); vv = *(const bf16x8*)(rp + 1280); }
            *(bf16x8*)(KL + s * KP + c8) = kv;
#pragma unroll
            for (int e = 0; e < 8; ++e) VTL[(c8 + e) * VP + s] = (bf16_t)vv[e]; }
        __syncthreads();
        const int gq = w >> 1, h = 4 * kh + gq;
        const float slope = exp2f(-0.5f * (float)(h + 1)), sink = p.b_sinks[h];
        for (int rb = 0; rb < 4; ++rb) {
            const int qrow = 64 * (w & 1) + 16 * rb + lr;
            const size_t tokq = (size_t)B * 128 + qrow;
            bf16x8 qf[2];
#pragma unroll
            for (int kk = 0; kk < 2; ++kk) qf[kk] = *(const bf16x8*)(qkv + tokq * 1536 + 64 * h + 32 * kk + 8 * lq);
            f32x4 sc[24];
#pragma unroll
            for (int cb = 0; cb < 24; ++cb) { f32x4 a = {0, 0, 0, 0};
#pragma unroll
                for (int kk = 0; kk < 2; ++kk) { const bf16x8 kf = *(const bf16x8*)(KL + (16 * cb + lr) * KP + 32 * kk + 8 * lq); a = mfma16(kf, qf[kk], a); }
                sc[cb] = a; }
            float mx = sink;
#pragma unroll
            for (int cb = 0; cb < 24; ++cb) { const int kb = B - 1 + (cb >> 3); const bool bval = (kb >= sb && kb < se);
#pragma unroll
                for (int j = 0; j < 4; ++j) { const int krel = 16 * cb + 4 * lq + j - 128;
                    int dist = qrow - krel; dist = dist < 0 ? -dist : dist;
                    const float v = (bval && dist <= 128) ? sc[cb][j] * 0.125f - slope * (float)dist : -1e30f;
                    sc[cb][j] = v; mx = fmaxf(mx, v); } }
            mx = fmaxf(mx, __shfl_xor(mx, 16)); mx = fmaxf(mx, __shfl_xor(mx, 32));
            float sum = 0.f;
#pragma unroll
            for (int cb = 0; cb < 24; ++cb)
#pragma unroll
                for (int j = 0; j < 4; ++j) { const float e = __expf(sc[cb][j] - mx); sc[cb][j] = e; sum += e; }
            sum += __shfl_xor(sum, 16); sum += __shfl_xor(sum, 32);
            sum += __expf(sink - mx);
            const float inv = 1.0f / sum;
            f32x4 oa[4];
#pragma unroll
            for (int db = 0; db < 4; ++db) oa[db] = (f32x4){0, 0, 0, 0};
#pragma unroll
            for (int ks = 0; ks < 12; ++ks) {
                union { bf16x8 v; unsigned u[4]; } pf;
                pf.u[0] = cvt_pk_bf16_asm(sc[2 * ks][0], sc[2 * ks][1]); pf.u[1] = cvt_pk_bf16_asm(sc[2 * ks][2], sc[2 * ks][3]);
                pf.u[2] = cvt_pk_bf16_asm(sc[2 * ks + 1][0], sc[2 * ks + 1][1]); pf.u[3] = cvt_pk_bf16_asm(sc[2 * ks + 1][2], sc[2 * ks + 1][3]);
#pragma unroll
                for (int db = 0; db < 4; ++db) {
                    union { bf16x8 v; u32x2 h2[2]; } vf;
                    const bf16_t* vp = VTL + (16 * db + lr) * VP + 32 * ks + 4 * lq;
                    vf.h2[0] = *(const u32x2*)vp; vf.h2[1] = *(const u32x2*)(vp + 16);
                    oa[db] = mfma16(vf.v, pf.v, oa[db]); } }
#pragma unroll
            for (int db = 0; db < 4; ++db) { const f32x4 o = oa[db] * inv; u32x2 wv; wv.x = cvt_pk_bf16_asm(o[0], o[1]); wv.y = cvt_pk_bf16_asm(o[2], o[3]);
                *(u32x2*)(qkv + tokq * 1536 + 64 * h + 16 * db + 4 * lq) = wv; }
        }
        __syncthreads();
    }
}

template <int N1> __device__ void fft1_units(int wv, const Params& p, unsigned char* lds, int seq_lo, int nseq, int part, int nparts) {
    const int tid = otid(wv), lane = tid & 63, w = __builtin_amdgcn_readfirstlane(tid >> 6), lr = lane & 15, lq = lane >> 4;
    constexpr int PW = N1 + 8, NB = N1 / 16, NK = N1 / 32; constexpr int S = N1 * 128;
    const bf16_t* z = (const bf16_t*)(p.ws + WS_BIG1); bf16_t* A1 = (bf16_t*)(p.ws + WS_BIG2);
    const bf16_t* ctg = (const bf16_t*)(p.ws + WS_TAB + (N1 == 64 ? TAB_CT64 : TAB_CT128)); const bf16_t* stg = (const bf16_t*)(p.ws + WS_TAB + (N1 == 64 ? TAB_ST64 : TAB_ST128));
    bf16_t* CT = (bf16_t*)lds; bf16_t* ST = CT + N1 * PW; bf16_t* XT = ST + N1 * PW;
    for (int idx = tid; idx < N1 * N1 / 8; idx += NTHR) { const int r = idx / (N1 / 8), c8 = (idx % (N1 / 8)) * 8;
        *(bf16x8*)(CT + r * PW + c8) = *(const bf16x8*)(ctg + r * N1 + c8); *(bf16x8*)(ST + r * PW + c8) = *(const bf16x8*)(stg + r * N1 + c8); }
    __syncthreads();
    const int nunits = nseq * 128 * 8;
    for (int unit = part; unit < nunits; unit += nparts) {
        const int sq = unit / 1024, b = (unit >> 3) & 127, cb = unit & 7;
        const int seq = seq_lo + sq; const size_t sbase = (size_t)seq * 8192;
        for (int idx = tid; idx < N1 * 16; idx += NTHR) { const int a = idx % N1, c8 = (idx / N1) * 8;
            const bf16x8 v = *(const bf16x8*)(z + (sbase + 128 * a + b) * DM + cb * 128 + c8);
#pragma unroll
            for (int e = 0; e < 8; ++e) XT[(c8 + e) * PW + a] = (bf16_t)v[e]; }
        __syncthreads();
        bf16x8 xf[NK];
#pragma unroll
        for (int kk = 0; kk < NK; ++kk) xf[kk] = *(const bf16x8*)(XT + (16 * w + lr) * PW + 32 * kk + 8 * lq);
#pragma unroll
        for (int i = 0; i < NB; ++i) { f32x4 ar = {0, 0, 0, 0}, as = {0, 0, 0, 0};
#pragma unroll
            for (int kk = 0; kk < NK; ++kk) { const bf16x8 cf = *(const bf16x8*)(CT + (16 * i + lr) * PW + 32 * kk + 8 * lq), sf = *(const bf16x8*)(ST + (16 * i + lr) * PW + 32 * kk + 8 * lq);
                ar = mfma16(xf[kk], cf, ar); as = mfma16(xf[kk], sf, as); }
            const int ka = 16 * i + lr; float tc, ts; sincospif(2.0f * (float)(b * ka) / (float)S, &ts, &tc);
            const f32x4 re = ar * tc - as * ts, im = -(as * tc) - ar * ts;
            bf16_t* op = A1 + (sbase + (size_t)ka * 128 + b) * 2048 + cb * 128 + 16 * w + 4 * lq;
            u32x2 o; o.x = cvt_pk_bf16(re[0], re[1]); o.y = cvt_pk_bf16(re[2], re[3]); *(u32x2*)op = o;
            o.x = cvt_pk_bf16(im[0], im[1]); o.y = cvt_pk_bf16(im[2], im[3]); *(u32x2*)(op + 1024) = o; }
        __syncthreads();
    }
}
__device__ void fft2_phase(int wv, const Params& p, unsigned char* lds) {
    const int tid = otid(wv), lane = tid & 63, w = __builtin_amdgcn_readfirstlane(tid >> 6), lr = lane & 15, lq = lane >> 4;
    constexpr int PW = 136;
    const bf16_t* A1 = (const bf16_t*)(p.ws + WS_BIG2); bf16_t* Y = (bf16_t*)(p.ws + WS_BIG1);
    const bf16_t* ctg = (const bf16_t*)(p.ws + WS_TAB + TAB_CT128); const bf16_t* stg = (const bf16_t*)(p.ws + WS_TAB + TAB_ST128);
    bf16_t* CT = (bf16_t*)lds; bf16_t* ST = CT + 128 * PW; bf16_t* XR = ST + 128 * PW; bf16_t* XI = XR + 128 * PW;
    for (int idx = tid; idx < 128 * 16; idx += NTHR) { const int r = idx >> 4, c8 = (idx & 15) * 8;
        *(bf16x8*)(CT + r * PW + c8) = *(const bf16x8*)(ctg + r * 128 + c8); *(bf16x8*)(ST + r * PW + c8) = *(const bf16x8*)(stg + r * 128 + c8); }
    __syncthreads();
    for (int unit = blockIdx.x; unit < 2048; unit += gridDim.x) {
        const int gi = unit >> 3, cb = unit & 7;
        const int seq = gi < 64 ? 0 : (gi < 128 ? 1 : 2); const int ka = gi - (seq == 0 ? 0 : (seq == 1 ? 64 : 128)); const int N1 = seq == 2 ? 128 : 64;
        const size_t sbase = (size_t)seq * 8192;
#pragma unroll
        for (int ps = 0; ps < 4; ++ps) { const int idx = tid + ps * NTHR, b = idx & 127, c8 = (idx >> 7) * 8;
            const bf16_t* rp = A1 + ((size_t)gi * 128 + b) * 2048 + cb * 128 + c8; const bf16x8 vr = *(const bf16x8*)rp, vi = *(const bf16x8*)(rp + 1024);
#pragma unroll
            for (int e = 0; e < 8; ++e) { XR[(c8 + e) * PW + b] = (bf16_t)vr[e]; XI[(c8 + e) * PW + b] = (bf16_t)vi[e]; } }
        __syncthreads();
        bf16x8 xr[4], xi[4], nxr[4];
#pragma unroll
        for (int kk = 0; kk < 4; ++kk) { xr[kk] = *(const bf16x8*)(XR + (16 * w + lr) * PW + 32 * kk + 8 * lq); xi[kk] = *(const bf16x8*)(XI + (16 * w + lr) * PW + 32 * kk + 8 * lq);
            union { bf16x8 v; unsigned u[4]; } t; t.v = xr[kk]; t.u[0] ^= 0x80008000u; t.u[1] ^= 0x80008000u; t.u[2] ^= 0x80008000u; t.u[3] ^= 0x80008000u; nxr[kk] = t.v; }
#pragma unroll
        for (int i = 0; i < 8; ++i) { f32x4 re = {0, 0, 0, 0}, im = {0, 0, 0, 0};
#pragma unroll
            for (int kk = 0; kk < 4; ++kk) { const bf16x8 cf = *(const bf16x8*)(CT + (16 * i + lr) * PW + 32 * kk + 8 * lq), sf = *(const bf16x8*)(ST + (16 * i + lr) * PW + 32 * kk + 8 * lq);
                re = mfma16(xr[kk], cf, re); re = mfma16(xi[kk], sf, re); im = mfma16(xi[kk], cf, im); im = mfma16(nxr[kk], sf, im); }
            const int kb = 16 * i + lr;
            bf16_t* op = Y + (sbase + (size_t)N1 * kb + ka) * 2048 + cb * 128 + 16 * w + 4 * lq;
            u32x2 o; o.x = cvt_pk_bf16(re[0], re[1]); o.y = cvt_pk_bf16(re[2], re[3]); *(u32x2*)op = o;
            o.x = cvt_pk_bf16(im[0], im[1]); o.y = cvt_pk_bf16(im[2], im[3]); *(u32x2*)(op + 1024) = o; }
        __syncthreads();
    }
}

__device__ void fix_phase(int wv, const Params& p, int li) {
    const float* edge = (const float*)(p.ws + WS_EDGE); const float* cw = (const float*)(p.ws + WS_CW) + (size_t)li * 4 * NUP; bf16_t* act = (bf16_t*)(p.ws + WS_ACT);
    const int total = 1024 * (FFD / 4);
    const int tid = otid(wv);
    for (int idx = blockIdx.x * NTHR + tid; idx < total; idx += gridDim.x * NTHR) {
        const int e = idx / (FFD / 4), c = (idx % (FFD / 4)) * 4; const int band = e >> 1, hi = e & 1; const int R = band * 64 + (hi ? 63 : 0);
        const int ca = (c >> 7) * 256 + (c & 127), cg_ = ca + 128;
        const bool seqstart = (R == 0 || R == 8192 || R == 16384), seqend = (R == 8191 || R == 16383 || R == 32767);
        const float* ep = edge + (size_t)band * 4 * NUP;
        f32x4 pa, pg, ua, ug, na, ng; const f32x4 zero = {0, 0, 0, 0};
        if (!hi) { pa = seqstart ? zero : *(const f32x4*)(ep - NUP + ca); pg = seqstart ? zero : *(const f32x4*)(ep - NUP + cg_);
            ua = *(const f32x4*)(ep + ca); ug = *(const f32x4*)(ep + cg_); na = *(const f32x4*)(ep + NUP + ca); ng = *(const f32x4*)(ep + NUP + cg_); }
        else { pa = *(const f32x4*)(ep + 2 * NUP + ca); pg = *(const f32x4*)(ep + 2 * NUP + cg_); ua = *(const f32x4*)(ep + 3 * NUP + ca); ug = *(const f32x4*)(ep + 3 * NUP + cg_);
            na = seqend ? zero : *(const f32x4*)(ep + 4 * NUP + ca); ng = seqend ? zero : *(const f32x4*)(ep + 4 * NUP + cg_); }
        const f32x4 a = *(const f32x4*)(cw + ca) * pa + *(const f32x4*)(cw + NUP + ca) * ua + *(const f32x4*)(cw + 2 * NUP + ca) * na + *(const f32x4*)(cw + 3 * NUP + ca);
        const f32x4 g = *(const f32x4*)(cw + cg_) * pg + *(const f32x4*)(cw + NUP + cg_) * ug + *(const f32x4*)(cw + 2 * NUP + cg_) * ng + *(const f32x4*)(cw + 3 * NUP + cg_);
        float o[4];
#pragma unroll
        for (int j = 0; j < 4; ++j) o[j] = a[j] * g[j] / (1.0f + __expf(-g[j]));
        u32x2 wv; wv.x = cvt_pk_bf16(o[0], o[1]); wv.y = cvt_pk_bf16(o[2], o[3]);
        *(u32x2*)(act + (size_t)R * FFD + c) = wv;
    }
}

#define XB_TMO      128
#define XB_XCNT(j)  (256  + 64 * (j))
#define XB_XSUB(j)  (1280 + 64 * (j))
#define XB_XGEN(j)  (2304 + 64 * (j))
#define XB_TOP      3328
#define XB_TOPGEN   3392
#define XCD_BAR_WORDS 3456
#define XB_SPIN_CAP (1u << 18)
__device__ __forceinline__ unsigned xb_ld(unsigned* p)              { return __hip_atomic_load(p, __ATOMIC_RELAXED, __HIP_MEMORY_SCOPE_AGENT); }
__device__ __forceinline__ unsigned xb_add(unsigned* p, unsigned v) { return __hip_atomic_fetch_add(p, v, __ATOMIC_RELAXED, __HIP_MEMORY_SCOPE_AGENT); }
__device__ __forceinline__ unsigned xb_xcc_id() { return (unsigned)__builtin_amdgcn_s_getreg((3 << 11) | 20) & 0xFu; }
#define XB_SPIN(cond, bar) do { unsigned _sp = 0; while (cond) { __builtin_amdgcn_s_sleep(1); \
    if ((++_sp & 255u) == 0u) { if (xb_ld(&(bar)[XB_TMO])) break; if (_sp > XB_SPIN_CAP) { atomicAdd(&(bar)[XB_TMO], 1u); break; } } } } while (0)
struct XcdBarrier { unsigned* bar; unsigned x; volatile LAS unsigned* st; };
__device__ __forceinline__ XcdBarrier xcd_barrier_post(unsigned* bar, volatile LAS unsigned* st) {
    XcdBarrier b; b.bar = bar; b.x = xb_xcc_id(); b.st = st;
    if (threadIdx.x == 0) (void)xb_add(&bar[XB_XCNT(b.x)], 1u);
    return b;
}
__device__ __forceinline__ void xcd_barrier_complete(unsigned* bar, unsigned x, unsigned& nloc, unsigned& nx) {
    const unsigned G = gridDim.x * gridDim.y * gridDim.z;
    unsigned sum, cnt, mine, sp = 0u;
    for (;;) {
        sum = 0u; cnt = 0u; mine = 0u;
#pragma unroll
        for (unsigned j = 0; j < 16; ++j) { const unsigned c = xb_ld(&bar[XB_XCNT(j)]); sum += c; cnt += (c > 0u) ? 1u : 0u; mine = (j == x) ? c : mine; }
        if (sum == G) break;
        __builtin_amdgcn_s_sleep(1);
        if ((++sp & 255u) == 0u) { if (xb_ld(&bar[XB_TMO])) break; if (sp > XB_SPIN_CAP) { atomicAdd(&bar[XB_TMO], 1u); break; } }
    }
    nloc = mine > 0u ? mine : 1u; nx = cnt > 0u ? cnt : 1u;
}
__device__ __forceinline__ void xcd_barrier(const XcdBarrier& b, int wv) {
    asm volatile("s_waitcnt vmcnt(0)" ::: "memory");
    __syncthreads();
    if (otid(wv) == 0) {
        unsigned* bar = b.bar;
        unsigned bx = (unsigned)__builtin_amdgcn_readfirstlane((int)xb_xcc_id()); asm volatile("" : "+s"(bx));
        __builtin_amdgcn_s_waitcnt(0);
        unsigned nloc = b.st[0], nx = b.st[1];
        if (nloc == 0u) { xcd_barrier_complete(bar, bx, nloc, nx); b.st[0] = nloc; b.st[1] = nx; }
        const unsigned old = xb_add(&bar[XB_XSUB(bx)], 1u);
        const unsigned gen = old / nloc;
        if (old + 1u == (gen + 1u) * nloc) {
            __builtin_amdgcn_fence(__ATOMIC_RELEASE, "agent");
            asm volatile("s_waitcnt vmcnt(0)" ::: "memory");
            const unsigned og = xb_add(&bar[XB_TOP], 1u);
            const unsigned tg = og / nx;
            if (og + 1u == (tg + 1u) * nx) xb_add(&bar[XB_TOPGEN], 1u);
            else XB_SPIN(xb_ld(&bar[XB_TOPGEN]) == tg, bar);
            __builtin_amdgcn_fence(__ATOMIC_ACQUIRE, "agent");
            xb_add(&bar[XB_XGEN(bx)], 1u);
            asm volatile("s_waitcnt vmcnt(0)" ::: "memory");
        } else {
            XB_SPIN(xb_ld(&bar[XB_XGEN(bx)]) == gen, bar);
            __builtin_amdgcn_fence(__ATOMIC_ACQUIRE, "agent");
            asm volatile("s_waitcnt vmcnt(0)" ::: "memory");
        }
    }
    __syncthreads();
}

__global__ void __launch_bounds__(NTHR, 2) mega(Params p) {
    extern __shared__ __attribute__((aligned(16))) unsigned char lds[];
    cg::grid_group grid = cg::this_grid();
    const int G = gridDim.x, bid = blockIdx.x;
    const int wv = __builtin_amdgcn_readfirstlane(threadIdx.x >> 6);
    volatile LAS unsigned* xst = (volatile LAS unsigned*)((LAS unsigned char*)lds + (LDS_BYTES - 16));
    if (threadIdx.x == 0) { xst[0] = 0u; xst[1] = 0u; }
    __syncthreads();
    const XcdBarrier xbar = xcd_barrier_post((unsigned*)(p.ws + WS_BAR), xst);
    float* ldsf = (float*)lds;
#define WSPTRS \
    size_t wsoff_ = 0; asm volatile("" : "+s"(wsoff_)); unsigned char* ws = p.ws + wsoff_; \
    float* ssb = (float*)(ws + WS_SS); float* mod = (float*)(ws + WS_MOD); float* gsT = (float*)(ws + WS_GS); \
    float* biasG1 = (float*)(ws + WS_BG1); float* biasUP = (float*)(ws + WS_BUP); float* cwT = (float*)(ws + WS_CW); \
    bf16_t* xb = (bf16_t*)(ws + WS_XB); bf16_t* big1 = (bf16_t*)(ws + WS_BIG1); \
    bf16_t* wain = (bf16_t*)(ws + WS_WAIN); bf16_t* waout = (bf16_t*)(ws + WS_WAOUT); bf16_t* wqkv = (bf16_t*)(ws + WS_WQKV); bf16_t* wo = (bf16_t*)(ws + WS_WO); \
    bf16_t* wcin = (bf16_t*)(ws + WS_WCIN); bf16_t* wf = (bf16_t*)(ws + WS_WF); bf16_t* wup = (bf16_t*)(ws + WS_WUP); bf16_t* wdn = (bf16_t*)(ws + WS_WDN); \
    (void)ssb; (void)mod; (void)gsT; (void)biasG1; (void)biasUP; (void)cwT; (void)xb; (void)big1; (void)wain; (void)waout; (void)wqkv; (void)wo; (void)wcin; (void)wf; (void)wup; (void)wdn;
    {
    WSPTRS
    const int tid = otid(wv);
    for (int idx = bid * NTHR + tid; idx < 10 * MTOK / 4; idx += G * NTHR) *(f32x4*)(ssb + MTOK + 4 * (size_t)idx) = (f32x4){0.f, 0.f, 0.f, 0.f};
    if (bid < 192) mod_task(wv, p, bid, ldsf);
    { bf16_t* tab = (bf16_t*)(ws + WS_TAB);
        for (int idx = bid * NTHR + tid; idx < 4096 + 16384; idx += G * NTHR) {
            if (idx < 4096) { const int ka = idx >> 6, a = idx & 63; const float x = 2.0f * (float)((ka * a) & 63) / 64.0f; tab[TAB_CT64 / 2 + idx] = f2bf(cospif(x) * 0.125f); tab[TAB_ST64 / 2 + idx] = f2bf(sinpif(x) * 0.125f); }
            else { const int i2 = idx - 4096, ka = i2 >> 7, a = i2 & 127; const float x = 2.0f * (float)((ka * a) & 127) / 128.0f; tab[TAB_CT128 / 2 + i2] = f2bf(cospif(x) * 0.08838834764831845f); tab[TAB_ST128 / 2 + i2] = f2bf(sinpif(x) * 0.08838834764831845f); } } }
    if (bid >= G - 128) wf_task(wv, p, bid - (G - 128), ldsf);
    convert_matrix(wv, p.a_w_in, 1024, 2048, 2048, 0, wain, ldsf, 0);
    convert_matrix(wv, p.a_w_in + (size_t)1024 * 2048, 1024, 2048, 2048, 0, wain + (size_t)2048 * 1024, ldsf, 128);
    convert_matrix(wv, p.a_w_out, 1024, 1024, 1024, 0, waout, ldsf, 0);
    convert_matrix(wv, p.a_w_out + (size_t)1024 * 1024, 1024, 1024, 1024, 0, waout + (size_t)1024 * 1024, ldsf, 64);
    convert_matrix(wv, p.b_w_qkv, 1024, 1536, 1536, 0, wqkv, ldsf, 128);
    convert_matrix(wv, p.b_w_o, 1024, 1024, 1024, 0, wo, ldsf, 224);
    convert_matrix(wv, p.c_w_in, 1024, 1024, 1024, 0, wcin, ldsf, 32);
    convert_matrix(wv, p.f_w_up, 1024, NUP, NUP, 1, wup, ldsf, 96);
    convert_matrix(wv, p.f_w_down, FFD, 1024, 1024, 0, wdn, ldsf, 192);
    grid.sync();

    }
    {
    WSPTRS
    const int tid = otid(wv);
    if (bid < 48) {
        if (bid < 8) bias_task(wv, p.a_w_in, 2048, 0, mod, biasG1, 2048, bid, ldsf);
        else if (bid < 14) bias_task(wv, p.b_w_qkv, 1536, 0, mod + 3 * MODW, biasG1 + 3 * 2048, 1536, bid - 8, ldsf);
        else if (bid < 18) bias_task(wv, p.c_w_in, 1024, 0, mod + 6 * MODW, biasG1 + 6 * 2048, 1024, bid - 14, ldsf);
        else if (bid < 26) bias_task(wv, p.a_w_in + (size_t)1024 * 2048, 2048, 0, mod + 9 * MODW, biasG1 + 9 * 2048, 2048, bid - 18, ldsf);
        else bias_task(wv, p.f_w_up, NUP, 1, mod + 3 * DM, biasUP, NUP, bid - 26, ldsf);
    }
    for (int idx = bid * NTHR + tid; idx < 9 * 3 * DM; idx += G * NTHR) { const int ni = idx / (3 * DM), seq = (idx / DM) % 3, c = idx % DM;
        float v; if (ni == 8) v = p.g_final[c]; else { const int i = ni >> 1, t = ni & 1; v = p.norm_g[(i * 2 + t) * DM + c] * (1.0f + mod[((size_t)i * 3 + seq) * MODW + (t ? 4 : 1) * DM + c]); }
        gsT[idx] = v; }
    for (int idx = bid * NTHR + tid; idx < 4 * 4 * NUP; idx += G * NTHR) { const int i = idx / (4 * NUP), q = (idx / NUP) & 3, n = idx % NUP; const int oc = upcol(n);
        cwT[idx] = q < 3 ? p.f_w_conv[((size_t)i * 3 + q) * NUP + oc] : p.f_b_conv[(size_t)i * NUP + oc]; }
    convert_matrix(wv, (const float*)(ws + WS_WF32), 2048, 1024, 1024, 0, wf, ldsf, 48);
    { const int wid = tid >> 6, lane = tid & 63;
        for (int r = bid * 8 + wid; r < MTOK; r += G * 8) { const int seq = seq_of_row(r);
            const float* xr = r < 16384 ? p.xp + (size_t)r * DM : p.xs + (size_t)(r - 16384) * DM; float s = 0.f; f32x4 v[4];
#pragma unroll
            for (int jj = 0; jj < 4; ++jj) { v[jj] = *(const f32x4*)(xr + jj * 256 + 4 * lane); s += (v[jj][0] * v[jj][0] + v[jj][1] * v[jj][1]) + (v[jj][2] * v[jj][2] + v[jj][3] * v[jj][3]); }
#pragma unroll
            for (int o = 32; o >= 1; o >>= 1) s += __shfl_xor(s, o);
            if (lane == 0) ssb[r] = s;
#pragma unroll
            for (int jj = 0; jj < 4; ++jj) { const int c = jj * 256 + 4 * lane; u32x2 wv; float h[4];
#pragma unroll
                for (int j = 0; j < 4; ++j) h[j] = v[jj][j] * (p.norm_g[c + j] * (1.0f + mod[(size_t)seq * MODW + DM + c + j]));
                wv.x = cvt_pk_bf16(h[0], h[1]); wv.y = cvt_pk_bf16(h[2], h[3]); *(u32x2*)(xb + (size_t)r * DM + c) = wv; } } }
    xcd_barrier(xbar, wv);
    }

    LAS unsigned char* ldsl = (LAS unsigned char*)lds;
    for (int i = 0; i < 4; ++i) {
        WSPTRS
        const int kind = i % 3, jl = i / 3;
        {   pg8::StaticOrder S; const float* ssin = ssb + (size_t)(2 * i) * MTOK;
            if (kind == 0) { pg8::Gemm g{xb, wain + (size_t)jl * 2048 * 1024, MTOK, 2048, 1024, 1024}; S.init(MTOK, 2048, G, bid);
                pg8::EpiAct<1> E{big1, 2048, biasG1 + (size_t)i * 3 * 2048, 2048, ssin, ssb + (size_t)(9 + jl) * MTOK, 1024};
#ifndef NO_G1A
                pg8::gemm_phase<pg8::EpiAct<1>>(wv, ldsl, g, S, E);
#endif
 }
            else { const int N = kind == 1 ? 1536 : 1024; pg8::Gemm g{xb, kind == 1 ? wqkv : wcin, MTOK, N, 1024, 1024}; S.init(MTOK, N, G, bid);
                pg8::EpiAct<0> E{big1, N, biasG1 + (size_t)i * 3 * 2048, N, ssin, nullptr, 0};
#ifndef NO_G1B
                pg8::gemm_phase<pg8::EpiAct<0>>(wv, ldsl, g, S, E);
#endif
 }
        }
        xcd_barrier(xbar, wv);
        if (i < 3) {
            convert_matrix(wv, p.f_w_up + (size_t)(i + 1) * 1024 * NUP, 1024, NUP, NUP, 1, wup + (size_t)((i + 1) & 1) * NUP * 1024, ldsf, 0);
            convert_matrix(wv, p.f_w_down + (size_t)(i + 1) * FFD * 1024, FFD, 1024, 1024, 0, wdn + (size_t)((i + 1) & 1) * 1024 * FFD, ldsf, 96);
            if (bid >= G - 22) bias_task(wv, p.f_w_up + (size_t)(i + 1) * 1024 * NUP, NUP, 1, mod + (size_t)(i + 1) * 3 * MODW + 3 * DM, biasUP + (size_t)((i + 1) & 1) * 3 * NUP, NUP, bid - (G - 22), ldsf);
        }
#ifndef NO_SG
        if (kind == 0) sg_phase(wv, p, jl, lds);
#endif
#ifndef NO_ATT
        if (kind == 1) att_phase(wv, p, lds);
#endif
#ifndef NO_FFT
        if (kind == 2) {
#ifndef NO_FFT1
            if (bid < G / 2) fft1_units<64>(wv, p, lds, 0, 2, bid, G / 2); else fft1_units<128>(wv, p, lds, 2, 1, bid - G / 2, G - G / 2);
#endif
            xcd_barrier(xbar, wv);
#ifndef NO_FFT2
            fft2_phase(wv, p, lds);
#endif
        }
#endif
        xcd_barrier(xbar, wv);
        for (int half = 0; half < 2; ++half) {
            if (half == 1) {
                {   pg8::Gemm g{xb, wup + (size_t)(i & 1) * NUP * 1024, MTOK, NUP, 1024, 1024}; pg8::StaticOrder S; S.init(MTOK, NUP, G, bid);
                    pg8::EpiUp E{(bf16_t*)(ws + WS_ACT), biasUP + (size_t)(i & 1) * 3 * NUP, cwT + (size_t)i * 4 * NUP, ssb + (size_t)(2 * i + 1) * MTOK, (float*)(ws + WS_EDGE)};
#ifndef NO_UP
                    pg8::gemm_phase<pg8::EpiUp>(wv, ldsl, g, S, E);
#endif
 }
                xcd_barrier(xbar, wv);
                fix_phase(wv, p, i);
                xcd_barrier(xbar, wv);
            }
            pg8::Gemm g; const float* gate; const float* gsn; bf16_t* xbo = xb; float* ssn; const float* b0 = p.out; const float* b1 = p.out + (size_t)16384 * DM;
            if (half == 0) {
                if (kind == 0) g = pg8::Gemm{big1, waout + (size_t)jl * 1024 * 1024, MTOK, 1024, 1024, 2048};
                else if (kind == 1) g = pg8::Gemm{big1, wo, MTOK, 1024, 1024, 1536};
                else g = pg8::Gemm{big1, wf, MTOK, 1024, 2048, 2048};
                gate = mod + (size_t)i * 3 * MODW + 2 * DM; gsn = gsT + (size_t)(2 * i + 1) * 3 * DM; ssn = ssb + (size_t)(2 * i + 1) * MTOK;
                if (i == 0) { b0 = p.xp; b1 = p.xs; }
            } else {
                g = pg8::Gemm{(const bf16_t*)(ws + WS_ACT), wdn + (size_t)(i & 1) * 1024 * FFD, MTOK, 1024, FFD, FFD};
                gate = mod + (size_t)i * 3 * MODW + 5 * DM; gsn = gsT + (size_t)(2 * i + 2) * 3 * DM; ssn = ssb + (size_t)(2 * i + 2) * MTOK;
                if (i == 3) xbo = nullptr;
            }
            pg8::StaticOrder S; S.init(MTOK, 1024, G, bid);
            pg8::EpiRes E{b0, b1, p.out, gate, gsn, xbo, ssn};
#ifndef NO_RES
            pg8::gemm_phase<pg8::EpiRes>(wv, ldsl, g, S, E);
#endif
            xcd_barrier(xbar, wv);
        }
    }
    { const float* ssF = (const float*)(p.ws + WS_SS) + (size_t)8 * MTOK; const int tid = otid(wv);
        for (size_t idx = (size_t)bid * NTHR + tid; idx < (size_t)MTOK * DM / 4; idx += (size_t)G * NTHR) { const int r = (int)(idx >> 8), c = (int)(idx & 255) * 4;
            const float rs = 1.0f / sqrtf(ssF[r] * (1.0f / DM) + EPSN); f32x4 v = *(const f32x4*)(p.out + (size_t)r * DM + c); const f32x4 gf = *(const f32x4*)(p.g_final + c);
            v = v * rs * gf; *(f32x4*)(p.out + (size_t)r * DM + c) = v; } }
}

extern "C" void kernel_launch(void* const* d_in, const int* in_sizes, int n_in, void* d_out, int out_size, void* d_ws, size_t ws_size, hipStream_t stream) {
    static int grid_blocks = 0;
    if (!grid_blocks) {
        if (ws_size < WS_END) { fprintf(stderr, "kernel_launch: workspace too small: %zu < %zu\n", ws_size, (size_t)WS_END); grid_blocks = -1; return; }
        int dev = 0, cus = 0, per_cu = 0;
        hipGetDevice(&dev);
        hipDeviceGetAttribute(&cus, hipDeviceAttributeMultiprocessorCount, dev);
        hipFuncSetAttribute((const void*)mega, hipFuncAttributeMaxDynamicSharedMemorySize, LDS_BYTES);
        hipOccupancyMaxActiveBlocksPerMultiprocessor(&per_cu, (const void*)mega, NTHR, LDS_BYTES);
        if (per_cu < 1) { fprintf(stderr, "kernel_launch: occupancy query says %d blocks per CU\n", per_cu); per_cu = 1; }
        grid_blocks = cus;
        (void)hipGetLastError();
    }
    if (grid_blocks < 0) return;
    if (hipMemsetAsync((char*)d_ws + WS_BAR, 0, BAR_BYTES, stream) != hipSuccess) { fprintf(stderr, "kernel_launch: memset of the barrier words failed\n"); return; }
    Params p{};
    p.xp = (const float*)d_in[0]; p.xs = (const float*)d_in[1]; p.cp = (const float*)d_in[2]; p.csm = (const float*)d_in[3]; p.w_ada = (const float*)d_in[4]; p.b_ada = (const float*)d_in[5];
    p.norm_g = (const float*)d_in[6]; p.a_w_in = (const float*)d_in[7]; p.a_g_v = (const float*)d_in[8]; p.a_w_s = (const float*)d_in[9]; p.a_b_s = (const float*)d_in[10]; p.a_w_out = (const float*)d_in[11];
    p.b_w_qkv = (const float*)d_in[12]; p.b_sinks = (const float*)d_in[13]; p.b_w_o = (const float*)d_in[14]; p.c_w_in = (const float*)d_in[15]; p.c_w_out = (const float*)d_in[16];
    p.f_w_up = (const float*)d_in[17]; p.f_w_conv = (const float*)d_in[18]; p.f_b_conv = (const float*)d_in[19]; p.f_w_down = (const float*)d_in[20]; p.g_final = (const float*)d_in[21];
    p.out = (float*)d_out; p.ws = (unsigned char*)d_ws;
    void* args[] = {&p};
    hipError_t e = hipLaunchCooperativeKernel((const void*)mega, dim3(grid_blocks), dim3(NTHR), args, LDS_BYTES, stream);
    if (e != hipSuccess) fprintf(stderr, "cooperative launch failed: %s (grid %d)\n", hipGetErrorString(e), grid_blocks);
}
```

```cpp
#include <hip/hip_runtime.h>
#include <hip/hip_cooperative_groups.h>
#include <cstdio>
namespace cg = cooperative_groups;

#define LAS __attribute__((address_space(3)))
typedef unsigned short bf16_t;
typedef short bf16x8 __attribute__((ext_vector_type(8)));
typedef short bf16x4 __attribute__((ext_vector_type(4)));
typedef float f32x4 __attribute__((ext_vector_type(4)));
typedef unsigned u32x4 __attribute__((ext_vector_type(4)));
typedef unsigned u32x2 __attribute__((ext_vector_type(2)));

constexpr int DM = 1024, MTOK = 32768, FFD = 2816, NUP = 5632, MODW = 6144;
constexpr float EPSN = 1e-6f;
constexpr int NTHR = 512;
constexpr int LDS_BYTES = 147456;

constexpr size_t al256(size_t x) { return (x + 255) & ~(size_t)255; }
constexpr size_t WS_SS = 0;
constexpr size_t SS_BYTES = (size_t)11 * MTOK * 4;
constexpr size_t WS_MOD = al256(WS_SS + SS_BYTES);
constexpr size_t WS_GS = al256(WS_MOD + (size_t)4 * 3 * MODW * 4);
constexpr size_t WS_BG1 = al256(WS_GS + (size_t)9 * 3 * DM * 4);
constexpr size_t WS_BUP = al256(WS_BG1 + (size_t)4 * 3 * 2048 * 4);
constexpr size_t WS_CW = al256(WS_BUP + (size_t)2 * 3 * NUP * 4);
constexpr size_t WS_TAB = al256(WS_CW + (size_t)4 * 4 * NUP * 4);
constexpr size_t TAB_CT64 = 0, TAB_ST64 = 8192, TAB_CT128 = 16384, TAB_ST128 = 16384 + 32768;
constexpr size_t WS_BAR = al256(WS_TAB + 81920);
constexpr size_t BAR_BYTES = 3456 * 4;
constexpr size_t WS_WF32 = al256(WS_BAR + BAR_BYTES);
constexpr size_t WS_WAIN = al256(WS_WF32 + (size_t)2048 * 1024 * 4);
constexpr size_t WS_WAOUT = al256(WS_WAIN + (size_t)2 * 2048 * 1024 * 2);
constexpr size_t WS_WQKV = al256(WS_WAOUT + (size_t)2 * 1024 * 1024 * 2);
constexpr size_t WS_WO = al256(WS_WQKV + (size_t)1536 * 1024 * 2);
constexpr size_t WS_WCIN = al256(WS_WO + (size_t)1024 * 1024 * 2);
constexpr size_t WS_WF = al256(WS_WCIN + (size_t)1024 * 1024 * 2);
constexpr size_t WS_WUP = al256(WS_WF + (size_t)1024 * 2048 * 2);
constexpr size_t WS_WDN = al256(WS_WUP + (size_t)2 * NUP * 1024 * 2);
constexpr size_t WS_XB = al256(WS_WDN + (size_t)2 * 1024 * FFD * 2);
constexpr size_t WS_BIG1 = al256(WS_XB + (size_t)MTOK * DM * 2);
constexpr size_t WS_BIG2 = al256(WS_BIG1 + (size_t)MTOK * 2048 * 2);
constexpr size_t WS_ACT = WS_BIG1;
constexpr size_t WS_EDGE = al256(WS_ACT + (size_t)MTOK * FFD * 2);
constexpr size_t WS_END = al256(WS_BIG2 + (size_t)MTOK * 2048 * 2);
static_assert(WS_EDGE + (size_t)512 * 4 * NUP * 4 <= WS_END, "edge buffer must fit");

struct Params {
    const float* xp; const float* xs; const float* cp; const float* csm; const float* w_ada; const float* b_ada; const float* norm_g;
    const float* a_w_in; const float* a_g_v; const float* a_w_s; const float* a_b_s; const float* a_w_out;
    const float* b_w_qkv; const float* b_sinks; const float* b_w_o; const float* c_w_in; const float* c_w_out;
    const float* f_w_up; const float* f_w_conv; const float* f_b_conv; const float* f_w_down; const float* g_final;
    float* out; unsigned char* ws;
};

__device__ __forceinline__ int otid(int wv) { int t; asm volatile("v_mbcnt_lo_u32_b32 %0, -1, 0\n\tv_mbcnt_hi_u32_b32 %0, -1, %0\n\tv_lshl_add_u32 %0, %1, 6, %0" : "=&v"(t) : "s"(wv)); return t; }
typedef __bf16 bf2_t __attribute__((ext_vector_type(2)));
typedef float f2_t __attribute__((ext_vector_type(2)));
__device__ __forceinline__ unsigned cvt_pk_bf16_asm(float lo, float hi) { unsigned r; asm volatile("v_cvt_pk_bf16_f32 %0, %1, %2" : "=v"(r) : "v"(lo), "v"(hi)); return r; }
__device__ __forceinline__ unsigned cvt_pk_bf16(float lo, float hi) { const f2_t v = {lo, hi}; const bf2_t b = __builtin_convertvector(v, bf2_t); return __builtin_bit_cast(unsigned, b); }
__device__ __forceinline__ bf16_t f2bf(float f) { return (bf16_t)(cvt_pk_bf16(f, 0.f) & 0xffffu); }
__device__ __forceinline__ int seq_of_row(int r) { return r < 8192 ? 0 : (r < 16384 ? 1 : 2); }
__device__ __forceinline__ int upcol(int n) { return (n >> 8) * 128 + (n & 127) + ((n & 128) ? FFD : 0); }

namespace pg8 {
constexpr int BM = 256, BK = 64, HALF = 128, HTB = HALF * BK * 2, STAGE_BYTES = 8 * HTB, NXCD = 8, WGM = 8;
__device__ __forceinline__ int lds_byte(int r, int c) { const int st = (r >> 4) * 2 + (c >> 5), rr = r & 15, cc = c & 31, ob = rr * 64 + cc * 2; return st * 1024 + (ob ^ (((ob >> 9) & 1) << 5)); }
__device__ __forceinline__ void stage_rc(int b, int& R, int& C) { const int st = b / 1024, sb = b % 1024, swz = sb ^ (((sb >> 9) & 1) << 5); R = (st >> 1) * 16 + swz / 64; C = (st & 1) * 32 + (swz % 64) / 2; }
__device__ __forceinline__ int perm32(int rho) { const int n = rho >> 4, i = rho & 15; return 8 * (i >> 2) + 4 * n + (i & 3); }
struct Unit { int pm, pn; };
struct Gemm { const bf16_t* A; const bf16_t* Bt; int M, N, K, lda; };
struct StaticOrder {
    int nM, nN, nwg, G, c;
    __device__ void init(int M, int N, int G_, int c_) { nM = M / BM; nN = N / BM; nwg = nM * nN; G = G_; c = c_; }
    __device__ bool next(int i, Unit& u) const {
        const long L = (long)i * G + c; if (L >= nwg) return false;
        int wgid = (int)L; { const int q = nwg / NXCD, r = nwg % NXCD, xcd = wgid % NXCD, off = wgid / NXCD; wgid = (xcd < r ? xcd * (q + 1) : r * (q + 1) + (xcd - r) * q) + off; }
        const int nig = WGM * nN, gid = wgid / nig, fm = gid * WGM, gsz = (nM - fm) < WGM ? (nM - fm) : WGM;
        u.pm = fm + ((wgid % nig) % gsz); u.pn = (wgid % nig) / gsz; return true;
    }
};

template <class Epi>
__device__ __forceinline__ void gemm_phase(int wv, LAS unsigned char* lds, const Gemm g, const StaticOrder& S, const Epi& E) {
    const int tid = otid(wv), wid = __builtin_amdgcn_readfirstlane(tid >> 6), lane = tid & 63, wr = wid >> 2, wc = wid & 3, fr = lane & 15, fq = lane >> 4;
    const int K = g.K, nt = K / BK, lda = g.lda;
    unsigned voffA[2], voffB[2];
#pragma unroll
    for (int i = 0; i < 2; ++i) { int R, C; stage_rc(tid * 16 + i * 8192, R, C); const int Rb = Epi::PERM ? ((R & ~31) + perm32(R & 31)) : R;
        voffA[i] = (unsigned)(R * lda + C) * 2u; voffB[i] = (unsigned)(Rb * K + C) * 2u; }
    const size_t kstep = (size_t)(BK * 2);
    const size_t hstepA = (size_t)HALF * lda * 2, hstepB = (size_t)HALF * K * 2;
    const size_t tstepA = 2 * hstepA, tstepB = 2 * hstepB;
    const unsigned ldsw = (unsigned)wid * 1024u;
    const int aoff = lds_byte(wr * 64 + fr, fq * 8), boff = lds_byte(wc * 32 + fr, fq * 8);
#define PG8_SA(b, h) (((b) * 2 + (h)) * HTB)
#define PG8_SB(b, h) ((4 + (b) * 2 + (h)) * HTB)
#define PG8_STAGE(bufoff, gbase, voff) do { _Pragma("unroll") for (int _i = 0; _i < 2; ++_i) \
        __builtin_amdgcn_global_load_lds((const unsigned*)((const char*)(gbase) + (voff)[_i]), (LAS unsigned*)(lds + (bufoff) + ldsw + _i * 8192), 16, 0, 0); } while (0)
#define PG8_LDA(dst, b, h) do { _Pragma("unroll") for (int m = 0; m < 4; ++m) _Pragma("unroll") for (int k = 0; k < 2; ++k) dst[m][k] = *(const LAS bf16x8*)(lds + PG8_SA(b, h) + aoff + m * 2048 + k * 1024); } while (0)
#define PG8_LDB(dst, b, h) do { _Pragma("unroll") for (int n = 0; n < 2; ++n) _Pragma("unroll") for (int k = 0; k < 2; ++k) dst[n][k] = *(const LAS bf16x8*)(lds + PG8_SB(b, h) + boff + n * 2048 + k * 1024); } while (0)
#define PG8_MMA(ai, bj, At, Bt) do { __builtin_amdgcn_s_setprio(1); _Pragma("unroll") for (int m = 0; m < 4; ++m) _Pragma("unroll") for (int n = 0; n < 2; ++n) _Pragma("unroll") for (int k = 0; k < 2; ++k) \
        acc[ai][bj][m][n] = __builtin_amdgcn_mfma_f32_16x16x32_bf16(Bt[n][k], At[m][k], acc[ai][bj][m][n], 0, 0, 0); __builtin_amdgcn_s_setprio(0); } while (0)
#define PG8_WAIT_V(n) asm volatile("s_waitcnt vmcnt(" #n ")" ::: "memory")
#define PG8_WAIT_L(n) asm volatile("s_waitcnt lgkmcnt(" #n ")" ::: "memory")
#define PG8_BAR __builtin_amdgcn_s_barrier()
#define PG8_SCHED __builtin_amdgcn_sched_barrier(0)
    Unit cur, nxt; int ui = 0;
    if (!S.next(0, cur)) return;
    f32x4 acc[2][2][4][2];
#pragma unroll
    for (int a = 0; a < 2; ++a)
#pragma unroll
        for (int b = 0; b < 2; ++b)
#pragma unroll
            for (int m = 0; m < 4; ++m)
#pragma unroll
                for (int n = 0; n < 2; ++n) acc[a][b][m][n] = (f32x4){0.f, 0.f, 0.f, 0.f};
    bf16x8 At[4][2], B0[2][2], B1[2][2];
    const char* cA = (const char*)g.A + (size_t)cur.pm * tstepA; const char* cB = (const char*)g.Bt + (size_t)cur.pn * tstepB;
    PG8_STAGE(PG8_SB(0, 0), cB, voffB); PG8_STAGE(PG8_SA(0, 0), cA, voffA); PG8_STAGE(PG8_SB(0, 1), cB + hstepB, voffB); PG8_STAGE(PG8_SA(0, 1), cA + hstepA, voffA);
    if (wr == 1) PG8_BAR;
    PG8_WAIT_V(4); PG8_BAR;
    PG8_STAGE(PG8_SB(1, 0), cB + kstep, voffB); PG8_STAGE(PG8_SA(1, 0), cA + kstep, voffA); PG8_STAGE(PG8_SB(1, 1), cB + hstepB + kstep, voffB);
    PG8_WAIT_V(6); PG8_BAR;
    for (;;) {
        const bool has_next = S.next(ui + 1, nxt);
        const char* nA = has_next ? (const char*)g.A + (size_t)nxt.pm * tstepA : cA; const char* nB = has_next ? (const char*)g.Bt + (size_t)nxt.pn * tstepB : cB;
        for (int t = 0; t < nt; t += 2) {
            const bool last = (t == nt - 2);
            const char* a1 = cA + (size_t)(t + 1) * kstep;
            const char* a2 = last ? nA : cA + (size_t)(t + 2) * kstep; const char* b2 = last ? nB : cB + (size_t)(t + 2) * kstep;
            const char* a3 = a2 + kstep; const char* b3 = b2 + kstep;
            PG8_LDB(B0, 0, 0); PG8_SCHED; PG8_LDA(At, 0, 0); PG8_STAGE(PG8_SA(1, 1), a1 + hstepA, voffA);
            PG8_WAIT_L(8); PG8_BAR; PG8_WAIT_L(0); PG8_MMA(0, 0, At, B0); PG8_BAR; PG8_SCHED;
            PG8_LDB(B1, 0, 1); PG8_STAGE(PG8_SB(0, 0), b2, voffB);
            PG8_BAR; PG8_WAIT_L(0); PG8_MMA(0, 1, At, B1); PG8_BAR;
            PG8_LDA(At, 0, 1); PG8_STAGE(PG8_SA(0, 0), a2, voffA);
            PG8_BAR; PG8_WAIT_L(0); PG8_MMA(1, 0, At, B0); PG8_BAR; PG8_SCHED;
            PG8_STAGE(PG8_SB(0, 1), b2 + hstepB, voffB);
            PG8_WAIT_V(6); PG8_BAR; PG8_MMA(1, 1, At, B1); PG8_BAR;
            PG8_LDB(B0, 1, 0); PG8_SCHED; PG8_LDA(At, 1, 0); PG8_STAGE(PG8_SA(0, 1), a2 + hstepA, voffA);
            PG8_WAIT_L(8); PG8_BAR; PG8_WAIT_L(0); PG8_MMA(0, 0, At, B0); PG8_BAR; PG8_SCHED;
            PG8_LDB(B1, 1, 1); PG8_STAGE(PG8_SB(1, 0), b3, voffB);
            PG8_BAR; PG8_WAIT_L(0); PG8_MMA(0, 1, At, B1); PG8_BAR;
            PG8_LDA(At, 1, 1); PG8_STAGE(PG8_SA(1, 0), a3, voffA);
            PG8_BAR; PG8_WAIT_L(0); PG8_MMA(1, 0, At, B0); PG8_BAR; PG8_SCHED;
            PG8_STAGE(PG8_SB(1, 1), b3 + hstepB, voffB);
            PG8_WAIT_V(6); PG8_BAR; PG8_MMA(1, 1, At, B1); PG8_BAR;
        }
        E(acc, cur, wr, wc, fr, fq);
        if (!has_next) break;
#pragma unroll
        for (int a = 0; a < 2; ++a)
#pragma unroll
            for (int b = 0; b < 2; ++b)
#pragma unroll
                for (int m = 0; m < 4; ++m)
#pragma unroll
                    for (int n = 0; n < 2; ++n) acc[a][b][m][n] = (f32x4){0.f, 0.f, 0.f, 0.f};
        cur = nxt; cA = nA; cB = nB; ++ui;
    }
    PG8_WAIT_V(0);
    if (wr == 0) PG8_BAR;
    PG8_BAR;
#undef PG8_SA
#undef PG8_SB
#undef PG8_STAGE
#undef PG8_LDA
#undef PG8_LDB
#undef PG8_MMA
#undef PG8_WAIT_V
#undef PG8_WAIT_L
#undef PG8_BAR
#undef PG8_SCHED
}

typedef float f32x2 __attribute__((ext_vector_type(2)));
__device__ __forceinline__ f32x2 gelu_pk(f32x2 v) {
    const f32x2 av = __builtin_elementwise_abs(v), d = av * 0.2316418882f + 1.0f;
    f32x2 t; t.x = __builtin_amdgcn_rcpf(d.x); t.y = __builtin_amdgcn_rcpf(d.y);
    f32x2 q = t * 0.5307027145f + (-0.7265760135f); q = q * t + 0.7107068705f; q = q * t + (-0.142248368f); q = q * t + 0.127414796f; q = q * t;
    const f32x2 s = (v * v) * (-0.72134752044f);
    f32x2 e; e.x = __builtin_amdgcn_exp2f(s.x); e.y = __builtin_amdgcn_exp2f(s.y);
    const f32x2 m = v * (q * e), r = v - m;
    f32x2 o; o.x = v.x < 0.f ? m.x : r.x; o.y = v.y < 0.f ? m.y : r.y; return o;
}
__device__ __forceinline__ f32x4 gelu4(f32x4 v) { f32x2 a = gelu_pk((f32x2){v[0], v[1]}), b = gelu_pk((f32x2){v[2], v[3]}); return (f32x4){a.x, a.y, b.x, b.y}; }

template <int ACT> struct EpiAct {
    static constexpr bool PERM = true;
    bf16_t* O; int ldc; const float* bias; int nb; const float* ssin; float* vss; int vcol0;
    __device__ __forceinline__ void operator()(const f32x4 (&acc)[2][2][4][2], const Unit& u, int wr, int wc, int fr, int fq) const {
        asm volatile("" : "+v"(fr), "+v"(fq));
        const int row0 = u.pm * BM + wr * 64 + fr, col0 = u.pn * BM + wc * 32 + 8 * fq;
        const int seq = seq_of_row(u.pm * BM);
        const float* bp = bias + (size_t)seq * nb + col0;
        f32x4 bv[2][2]; float rsv[2][4];
#pragma unroll
        for (int bj = 0; bj < 2; ++bj)
#pragma unroll
            for (int n = 0; n < 2; ++n) bv[bj][n] = *(const f32x4*)(bp + bj * HALF + 4 * n);
#pragma unroll
        for (int ai = 0; ai < 2; ++ai)
#pragma unroll
            for (int m = 0; m < 4; ++m) rsv[ai][m] = ssin[row0 + ai * HALF + m * 16];
#pragma unroll
        for (int ai = 0; ai < 2; ++ai)
#pragma unroll
            for (int m = 0; m < 4; ++m) rsv[ai][m] = __builtin_amdgcn_rsqf(rsv[ai][m] * (1.0f / DM) + EPSN);
        const bool dov = (ACT == 1) && (u.pn * BM >= vcol0);
#pragma unroll
        for (int ai = 0; ai < 2; ++ai)
#pragma unroll
            for (int m = 0; m < 4; ++m) {
                const int r = row0 + ai * HALF + m * 16;
                const float rs = rsv[ai][m];
                bf16_t* rowp = O + (size_t)r * ldc + col0; float s = 0.f;
#pragma unroll
                for (int bj = 0; bj < 2; ++bj) { f32x4 v0 = acc[ai][bj][m][0] * rs + bv[bj][0], v1 = acc[ai][bj][m][1] * rs + bv[bj][1];
                    if (ACT == 1) { v0 = gelu4(v0); v1 = gelu4(v1); s += (v0[0] * v0[0] + v0[1] * v0[1]) + (v0[2] * v0[2] + v0[3] * v0[3]) + (v1[0] * v1[0] + v1[1] * v1[1]) + (v1[2] * v1[2] + v1[3] * v1[3]); }
                    u32x4 w; w.x = cvt_pk_bf16_asm(v0[0], v0[1]); w.y = cvt_pk_bf16_asm(v0[2], v0[3]); w.z = cvt_pk_bf16_asm(v1[0], v1[1]); w.w = cvt_pk_bf16_asm(v1[2], v1[3]);
                    *(u32x4*)(rowp + bj * HALF) = w; }
                if (ACT == 1) { s += __shfl_xor(s, 16); s += __shfl_xor(s, 32); if (dov && fq == 0) (void)__hip_atomic_fetch_add(vss + r, s, __ATOMIC_RELAXED, __HIP_MEMORY_SCOPE_AGENT); }
            }
    }
};

struct EpiRes {
    static constexpr bool PERM = false;
    const float* base0; const float* base1; float* xout; const float* gate; const float* gs; bf16_t* xb; float* ssn;
    __device__ __forceinline__ void operator()(const f32x4 (&acc)[2][2][4][2], const Unit& u, int wr, int wc, int fr, int fq) const {
        asm volatile("" : "+v"(fr), "+v"(fq));
        const int row0 = u.pm * BM + wr * 64 + fr, col0 = u.pn * BM + wc * 32 + 4 * fq;
        const int seq = seq_of_row(u.pm * BM);
        const float* gp = gate + (size_t)seq * MODW + col0; const float* gsp = gs + (size_t)seq * DM + col0;
        f32x4 gv[2][2], gsv[2][2];
#pragma unroll
        for (int bj = 0; bj < 2; ++bj)
#pragma unroll
            for (int n = 0; n < 2; ++n) { gv[bj][n] = *(const f32x4*)(gp + bj * HALF + n * 16); gsv[bj][n] = *(const f32x4*)(gsp + bj * HALF + n * 16); }
        const float* bbase = (u.pm * BM < 16384 ? base0 + (size_t)row0 * DM : base1 + (size_t)(row0 - 16384) * DM) + col0;
        f32x4 xr[3][2][2];
#pragma unroll
        for (int g0 = 0; g0 < 2; ++g0) { const float* bp = bbase + (size_t)((g0 >> 2) * HALF + (g0 & 3) * 16) * DM;
#pragma unroll
            for (int bj = 0; bj < 2; ++bj)
#pragma unroll
                for (int n = 0; n < 2; ++n) xr[g0][bj][n] = *(const f32x4*)(bp + bj * HALF + n * 16); }
#pragma unroll
        for (int g8 = 0; g8 < 8; ++g8) { const int ai = g8 >> 2, m = g8 & 3;
            if (g8 < 6) { const int gn = g8 + 2; const float* bp = bbase + (size_t)((gn >> 2) * HALF + (gn & 3) * 16) * DM;
#pragma unroll
                for (int bj = 0; bj < 2; ++bj)
#pragma unroll
                    for (int n = 0; n < 2; ++n) xr[gn % 3][bj][n] = *(const f32x4*)(bp + bj * HALF + n * 16); }
            const int r = row0 + ai * HALF + m * 16;
            float* op = xout + (size_t)r * DM + col0; float s = 0.f;
#pragma unroll
            for (int bj = 0; bj < 2; ++bj)
#pragma unroll
                for (int n = 0; n < 2; ++n) { const f32x4 xn = xr[g8 % 3][bj][n] + gv[bj][n] * acc[ai][bj][m][n];
                    *(f32x4*)(op + bj * HALF + n * 16) = xn; s += (xn[0] * xn[0] + xn[1] * xn[1]) + (xn[2] * xn[2] + xn[3] * xn[3]);
                    if (xb) { const f32x4 h = xn * gsv[bj][n]; u32x2 w; w.x = cvt_pk_bf16_asm(h[0], h[1]); w.y = cvt_pk_bf16_asm(h[2], h[3]);
                        *(u32x2*)(xb + (size_t)r * DM + col0 + bj * HALF + n * 16) = w; } }
            s += __shfl_xor(s, 16); s += __shfl_xor(s, 32); if (fq == 0) (void)__hip_atomic_fetch_add(ssn + r, s, __ATOMIC_RELAXED, __HIP_MEMORY_SCOPE_AGENT);
        }
    }
};

struct EpiUp {
    static constexpr bool PERM = true;
    bf16_t* act; const float* bias; const float* cw; const float* ssin; float* edge;
    __device__ __forceinline__ void operator()(const f32x4 (&acc)[2][2][4][2], const Unit& u, int wr, int wc, int fr, int fq) const {
        asm volatile("" : "+v"(fr), "+v"(fq));
        const int row0 = u.pm * BM + wr * 64 + fr, colt = u.pn * BM + wc * 32 + 8 * fq;
        const int seq = seq_of_row(u.pm * BM);
        const float* biasp = bias + (size_t)seq * NUP + colt; const float* cwp = cw + colt;
        float rs[2][4];
#pragma unroll
        for (int ai = 0; ai < 2; ++ai)
#pragma unroll
            for (int m = 0; m < 4; ++m) rs[ai][m] = ssin[row0 + ai * HALF + m * 16];
#pragma unroll
        for (int ai = 0; ai < 2; ++ai)
#pragma unroll
            for (int m = 0; m < 4; ++m) rs[ai][m] = __builtin_amdgcn_rsqf(rs[ai][m] * (1.0f / DM) + EPSN);
        u32x2 keep[2][4];
#pragma unroll
        for (int n = 0; n < 2; ++n) {
            f32x4 prm[2][5];
#pragma unroll
            for (int bj = 0; bj < 2; ++bj) { const int co = bj * HALF + 4 * n;
                prm[bj][0] = *(const f32x4*)(biasp + co); prm[bj][1] = *(const f32x4*)(cwp + co); prm[bj][2] = *(const f32x4*)(cwp + NUP + co); prm[bj][3] = *(const f32x4*)(cwp + 2 * NUP + co); prm[bj][4] = *(const f32x4*)(cwp + 3 * NUP + co); }
#pragma unroll
            for (int ai = 0; ai < 2; ++ai) {
                float* ep = edge + (size_t)(u.pm * 4 + ai * 2 + wr) * 4 * NUP + colt;
                f32x4 SG[4];
#pragma unroll
                for (int bjr = 0; bjr < 2; ++bjr) { const int bj = 1 - bjr; const int co = bj * HALF + 4 * n;
                    f32x4 U[4];
#pragma unroll
                    for (int m = 0; m < 4; ++m) U[m] = acc[ai][bj][m][n] * rs[ai][m] + prm[bj][0];
                    if (fr < 2) *(f32x4*)(ep + (size_t)fr * NUP + co) = U[0];
                    if (fr >= 14) *(f32x4*)(ep + (size_t)(fr - 12) * NUP + co) = U[3];
#pragma unroll
                    for (int m = 0; m < 4; ++m) { const f32x4 sp = (fr == 15 && m > 0) ? U[m > 0 ? m - 1 : 0] : U[m]; const f32x4 sn = (fr == 0 && m < 3) ? U[m < 3 ? m + 1 : 3] : U[m];
                        f32x4 pv, nv;
#pragma unroll
                        for (int j = 0; j < 4; ++j) { pv[j] = __int_as_float(__builtin_amdgcn_update_dpp(0, __float_as_int(sp[j]), 0x121, 0xf, 0xf, false)); nv[j] = __int_as_float(__builtin_amdgcn_update_dpp(0, __float_as_int(sn[j]), 0x12F, 0xf, 0xf, false)); }
                        const f32x4 R = prm[bj][1] * pv + prm[bj][2] * U[m] + prm[bj][3] * nv + prm[bj][4];
                        if (bj == 1) {
#pragma unroll
                            for (int j = 0; j < 4; ++j) SG[m][j] = R[j] * __builtin_amdgcn_rcpf(1.0f + __expf(-R[j])); }
                        else { const int r = row0 + ai * HALF + m * 16; const bool skip = (m == 0 && fr == 0) || (m == 3 && fr == 15);
                            const f32x4 o = R * SG[m]; u32x2 w; w.x = cvt_pk_bf16_asm(o[0], o[1]); w.y = cvt_pk_bf16_asm(o[2], o[3]);
                            if (n == 0) keep[ai][m] = w;
                            else { u32x4 w4; w4.x = keep[ai][m].x; w4.y = keep[ai][m].y; w4.z = w.x; w4.w = w.y; if (!skip) *(u32x4*)(act + (size_t)r * FFD + u.pn * 128 + wc * 32 + 8 * fq) = w4; } } } } }
        }
    }
};
}

__device__ __forceinline__ float silu_f(float x) { return x / (1.0f + __expf(-x)); }

__device__ void mod_task(int wv, const Params& p, int tk, float* ldsf) {
    const int tid = otid(wv), i = tk / 48, cgp = tk % 48;
    float* csL = ldsf; float* red = ldsf + 3072;
    for (int idx = tid; idx < 3072; idx += NTHR) { const int seq = idx >> 10, k = idx & 1023; const float c = seq < 2 ? p.cp[seq * DM + k] : p.csm[k]; csL[idx] = silu_f(c); }
    __syncthreads();
    const int quad = tid & 31, ksl = tid >> 5;
    const float* W = p.w_ada + (size_t)i * DM * MODW + (size_t)ksl * 64 * MODW + 128 * cgp + 4 * quad;
    f32x4 a0 = {0, 0, 0, 0}, a1 = {0, 0, 0, 0}, a2 = {0, 0, 0, 0};
#pragma unroll 8
    for (int kk = 0; kk < 64; ++kk) { const f32x4 w = *(const f32x4*)(W + (size_t)kk * MODW); const int k = ksl * 64 + kk;
        a0 += w * csL[k]; a1 += w * csL[1024 + k]; a2 += w * csL[2048 + k]; }
    float* rp = red + (ksl * 32 + quad) * 12;
    *(f32x4*)(rp) = a0; *(f32x4*)(rp + 4) = a1; *(f32x4*)(rp + 8) = a2;
    __syncthreads();
    if (tid < 384) { const int q = tid & 31, e = tid >> 5; float s = 0.f;
        for (int k = 0; k < 16; ++k) s += red[(k * 32 + q) * 12 + e];
        const int seq = e >> 2, col = 128 * cgp + 4 * q + (e & 3);
        float* mod = (float*)(p.ws + WS_MOD);
        mod[((size_t)i * 3 + seq) * MODW + col] = s + p.b_ada[i * MODW + col]; }
    __syncthreads();
}

__device__ void wf_task(int wv, const Params& p, int task, float* ldsf) {
    const int tid = otid(wv), g = task >> 4, n0 = (task & 15) * 64;
    float* tile = ldsf; float* ct = ldsf + 128 * 64;
    for (int idx = tid; idx < 128 * 16; idx += NTHR) { const int cp_ = idx >> 4, n4 = (idx & 15) * 4;
        *(f32x4*)(tile + cp_ * 64 + n4) = *(const f32x4*)(p.c_w_out + (size_t)(g * 128 + cp_) * DM + n0 + n4); }
    if (tid < 128) ct[tid] = cospif(2.0f * tid / 128.0f) * 0.08838834764831845f;
    __syncthreads();
    const int n = tid & 63, wvl = __builtin_amdgcn_readfirstlane(tid >> 6);
    float ac[16], as[16];
#pragma unroll
    for (int c = 0; c < 16; ++c) { ac[c] = 0.f; as[c] = 0.f; }
    for (int cq = 0; cq < 128; ++cq) { const float v = tile[cq * 64 + n];
#pragma unroll
        for (int cc = 0; cc < 16; ++cc) { const int idx = ((wvl * 16 + cc) * cq) & 127; ac[cc] += ct[idx] * v; as[cc] += ct[(idx + 96) & 127] * v; } }
    float* Wf = (float*)(p.ws + WS_WF32);
#pragma unroll
    for (int cc = 0; cc < 16; ++cc) { const int c = wvl * 16 + cc; Wf[(size_t)(g * 128 + c) * DM + n0 + n] = ac[cc]; Wf[(size_t)(1024 + g * 128 + c) * DM + n0 + n] = as[cc]; }
    __syncthreads();
}

__device__ void convert_matrix(int wv, const float* src, int K, int N, int ld, int perm, bf16_t* dst, float* tileL, int rot) {
    const int tid = otid(wv), G = gridDim.x, ntk = K >> 6, ntiles = ntk * (N >> 8);
    for (int t = (blockIdx.x + G - (rot % G)) % G; t < ntiles; t += G) {
        const int k0 = (t % ntk) * 64, n0 = (t / ntk) * 256;
        f32x4 v[8];
#pragma unroll
        for (int ps = 0; ps < 8; ++ps) { const int idx = tid + ps * NTHR, kk = idx >> 6, n4 = (idx & 63) * 4; const int sc = perm ? upcol(n0 + n4) : n0 + n4;
            v[ps] = *(const f32x4*)(src + (size_t)(k0 + kk) * ld + sc); }
#pragma unroll
        for (int ps = 0; ps < 8; ++ps) { const int idx = tid + ps * NTHR, kk = idx >> 6, n4 = (idx & 63) * 4;
            float* tp = tileL + kk * 257 + n4; tp[0] = v[ps][0]; tp[1] = v[ps][1]; tp[2] = v[ps][2]; tp[3] = v[ps][3]; }
        __syncthreads();
        { const int n = tid >> 1, kh = (tid & 1) * 32;
#pragma unroll
            for (int q = 0; q < 4; ++q) { float e[8];
#pragma unroll
                for (int j = 0; j < 8; ++j) e[j] = tileL[(kh + 8 * q + j) * 257 + n];
                u32x4 w; w.x = cvt_pk_bf16(e[0], e[1]); w.y = cvt_pk_bf16(e[2], e[3]); w.z = cvt_pk_bf16(e[4], e[5]); w.w = cvt_pk_bf16(e[6], e[7]);
                *(u32x4*)(dst + (size_t)(n0 + n) * K + k0 + kh + 8 * q) = w; } }
        __syncthreads();
    }
}

__device__ void bias_task(int wv, const float* W, int ld, int perm, const float* sh, float* bias, int nb, int grp, float* red) {
    const int tid = otid(wv), quad = tid & 63, ksl = __builtin_amdgcn_readfirstlane(tid >> 6);
    const int nn = 256 * grp + 4 * quad, sc = perm ? upcol(nn) : nn;
    f32x4 a0 = {0, 0, 0, 0}, a1 = {0, 0, 0, 0}, a2 = {0, 0, 0, 0};
    const float* wp = W + (size_t)ksl * 128 * ld + sc; const float* s0 = sh + ksl * 128;
#pragma unroll 16
    for (int kk = 0; kk < 128; ++kk) { const f32x4 w = *(const f32x4*)(wp + (size_t)kk * ld); a0 += w * s0[kk]; a1 += w * s0[MODW + kk]; a2 += w * s0[2 * MODW + kk]; }
    float* rp = red + (ksl * 64 + quad) * 12;
    *(f32x4*)(rp) = a0; *(f32x4*)(rp + 4) = a1; *(f32x4*)(rp + 8) = a2;
    __syncthreads();
    for (int idx = tid; idx < 768; idx += NTHR) { const int q = idx & 63, e = idx >> 6; float s = 0.f;
        for (int k = 0; k < 8; ++k) s += red[(k * 64 + q) * 12 + e];
        bias[(size_t)(e >> 2) * nb + 256 * grp + 4 * q + (e & 3)] = s; }
    __syncthreads();
}

__device__ __forceinline__ f32x4 mfma16(bf16x8 a, bf16x8 b, f32x4 c) { return __builtin_amdgcn_mfma_f32_16x16x32_bf16(a, b, c, 0, 0, 0); }

__device__ void sg_phase(int wv, const Params& p, int jl, unsigned char* lds) {
    const int tid = otid(wv), lane = tid & 63, w = __builtin_amdgcn_readfirstlane(tid >> 6), lr = lane & 15, lq = lane >> 4;
    bf16_t* uv = (bf16_t*)(p.ws + WS_BIG1);
    const float* vss = (const float*)(p.ws + WS_SS) + (size_t)(9 + jl) * MTOK;
    constexpr int PW = 136;
    bf16_t* WsL = (bf16_t*)lds; bf16_t* VTL = WsL + 128 * PW; float* rsL = (float*)(VTL + 128 * PW);
    for (int unit = blockIdx.x; unit < 2048; unit += gridDim.x) {
        const int ch = unit >> 3, g = unit & 7, t0 = ch * 128;
        if (tid < 128) rsL[tid] = 1.0f / sqrtf(vss[t0 + tid] * (1.0f / DM) + EPSN);
        __syncthreads();
        const float* ws = p.a_w_s + ((size_t)jl * 8 + g) * 128 * 128;
#pragma unroll
        for (int ps = 0; ps < 8; ++ps) { const int idx = tid + ps * NTHR, t = idx >> 5, s4 = (idx & 31) * 4;
            const f32x4 wv = *(const f32x4*)(ws + t * 128 + s4); const f32x4 r4 = *(const f32x4*)(rsL + s4); const f32x4 x = wv * r4;
            u32x2 pk; pk.x = cvt_pk_bf16(x[0], x[1]); pk.y = cvt_pk_bf16(x[2], x[3]); *(u32x2*)(WsL + t * PW + s4) = pk; }
#pragma unroll
        for (int ps = 0; ps < 4; ++ps) { const int idx = tid + ps * NTHR, s = idx & 127, d8 = (idx >> 7) * 8;
            const bf16x8 v = *(const bf16x8*)(uv + (size_t)(t0 + s) * 2048 + 1024 + g * 128 + d8);
#pragma unroll
            for (int e = 0; e < 8; ++e) VTL[(d8 + e) * PW + s] = (bf16_t)v[e]; }
        __syncthreads();
        bf16x8 af[4];
#pragma unroll
        for (int kk = 0; kk < 4; ++kk) af[kk] = *(const bf16x8*)(WsL + (16 * w + lr) * PW + 32 * kk + 8 * lq);
        const int tok = t0 + 16 * w + lr; const float bs = p.a_b_s[((size_t)jl * 8 + g) * 128 + 16 * w + lr];
#pragma unroll
        for (int db = 0; db < 8; ++db) { f32x4 acc = {0, 0, 0, 0};
#pragma unroll
            for (int kk = 0; kk < 4; ++kk) { const bf16x8 bf = *(const bf16x8*)(VTL + (16 * db + lr) * PW + 32 * kk + 8 * lq); acc = mfma16(bf, af[kk], acc); }
            const int col = g * 128 + 16 * db + 4 * lq; const f32x4 gv = *(const f32x4*)(p.a_g_v + jl * DM + col);
            bf16_t* up = uv + (size_t)tok * 2048 + col; const u32x2 uu = *(const u32x2*)up;
            const float u0 = __uint_as_float(uu.x << 16), u1 = __uint_as_float(uu.x & 0xffff0000u), u2 = __uint_as_float(uu.y << 16), u3 = __uint_as_float(uu.y & 0xffff0000u);
            const f32x4 sv = acc * gv + bs; u32x2 o; o.x = cvt_pk_bf16(u0 * sv[0], u1 * sv[1]); o.y = cvt_pk_bf16(u2 * sv[2], u3 * sv[3]);
            *(u32x2*)up = o; }
        __syncthreads();
    }
}

__device__ void att_phase(int wv, const Params& p, unsigned char* lds) {
    const int tid = otid(wv), lane = tid & 63, w = __builtin_amdgcn_readfirstlane(tid >> 6), lr = lane & 15, lq = lane >> 4;
    bf16_t* qkv = (bf16_t*)(p.ws + WS_BIG1);
    constexpr int KP = 72, VP = 392;
    bf16_t* KL = (bf16_t*)lds; bf16_t* VTL = KL + 384 * KP;
    for (int unit = blockIdx.x; unit < 1024; unit += gridDim.x) {
        const int B = unit >> 2, kh = unit & 3;
        const int sb = B < 64 ? 0 : (B < 128 ? 64 : 128), se = B < 64 ? 64 : (B < 128 ? 128 : 256);
#pragma unroll
        for (int ps = 0; ps < 6; ++ps) { const int idx = tid + ps * NTHR, s = idx >> 3, c8 = (idx & 7) * 8; const int kb = B - 1 + (s >> 7);
            bf16x8 kv = {0, 0, 0, 0, 0, 0, 0, 0}, vv = {0, 0, 0, 0, 0, 0, 0, 0};
            if (kb >= sb && kb < se) { const bf16_t* rp = qkv + (size_t)(kb * 128 + (s & 127)) * 1536 + 64 * kh + c8; kv = *(const bf16x8*)(rp + 1024); vv = *(const bf16x8*)(rp + 1280); }
            *(bf16x8*)(KL + s * KP + c8) = kv;
#pragma unroll
            for (int e = 0; e < 8; ++e) VTL[(c8 + e) * VP + s] = (bf16_t)vv[e]; }
        __syncthreads();
        const int gq = w >> 1, h = 4 * kh + gq;
        const float slope = exp2f(-0.5f * (float)(h + 1)), sink = p.b_sinks[h];
        for (int rb = 0; rb < 4; ++rb) {
            const int qrow = 64 * (w & 1) + 16 * rb + lr;
            const size_t tokq = (size_t)B * 128 + qrow;
            bf16x8 qf[2];
#pragma unroll
            for (int kk = 0; kk < 2; ++kk) qf[kk] = *(const bf16x8*)(qkv + tokq * 1536 + 64 * h + 32 * kk + 8 * lq);
            f32x4 sc[24];
#pragma unroll
            for (int cb = 0; cb < 24; ++cb) { f32x4 a = {0, 0, 0, 0};
#pragma unroll
                for (int kk = 0; kk < 2; ++kk) { const bf16x8 kf = *(const bf16x8*)(KL + (16 * cb + lr) * KP + 32 * kk + 8 * lq); a = mfma16(kf, qf[kk], a); }
                sc[cb] = a; }
            float mx = sink;
#pragma unroll
            for (int cb = 0; cb < 24; ++cb) { const int kb = B - 1 + (cb >> 3); const bool bval = (kb >= sb && kb < se);
#pragma unroll
                for (int j = 0; j < 4; ++j) { const int krel = 16 * cb + 4 * lq + j - 128;
                    int dist = qrow - krel; dist = dist < 0 ? -dist : dist;
                    const float v = (bval && dist <= 128) ? sc[cb][j] * 0.125f - slope * (float)dist : -1e30f;
                    sc[cb][j] = v; mx = fmaxf(mx, v); } }
            mx = fmaxf(mx, __shfl_xor(mx, 16)); mx = fmaxf(mx, __shfl_xor(mx, 32));
            float sum = 0.f;
#pragma unroll
            for (int cb = 0; cb < 24; ++cb)
#pragma unroll
                for (int j = 0; j < 4; ++j) { const float e = __expf(sc[cb][j] - mx); sc[cb][j] = e; sum += e; }
            sum += __shfl_xor(sum, 16); sum += __shfl_xor(sum, 32);
            sum += __expf(sink - mx);
            const float inv = 1.0f / sum;
            f32x4 oa[4];
#pragma unroll
            for (int db = 0; db < 4; ++db) oa[db] = (f32x4){0, 0, 0, 0};
#pragma unroll
            for (int ks = 0; ks < 12; ++ks) {
                union { bf16x8 v; unsigned u[4]; } pf;
                pf.u[0] = cvt_pk_bf16_asm(sc[2 * ks][0], sc[2 * ks][1]); pf.u[1] = cvt_pk_bf16_asm(sc[2 * ks][2], sc[2 * ks][3]);
                pf.u[2] = cvt_pk_bf16_asm(sc[2 * ks + 1][0], sc[2 * ks + 1][1]); pf.u[3] = cvt_pk_bf16_asm(sc[2 * ks + 1][2], sc[2 * ks + 1][3]);
#pragma unroll
                for (int db = 0; db < 4; ++db) {
                    union { bf16x8 v; u32x2 h2[2]; } vf;
                    const bf16_t* vp = VTL + (16 * db + lr) * VP + 32 * ks + 4 * lq;
                    vf.h2[0] = *(const u32x2*)vp; vf.h2[1] = *(const u32x2*)(vp + 16);
                    oa[db] = mfma16(vf.v, pf.v, oa[db]); } }
#pragma unroll
            for (int db = 0; db < 4; ++db) { const f32x4 o = oa[db] * inv; u32x2 wv; wv.x = cvt_pk_bf16_asm(o[0], o[1]); wv.y = cvt_pk_bf16_asm(o[2], o[3]);
                *(u32x2*)(qkv + tokq * 1536 + 64 * h + 16 * db + 4 * lq) = wv; }
        }
        __syncthreads();
    }
}

template <int N1> __device__ void fft1_units(int wv, const Params& p, unsigned char* lds, int seq_lo, int nseq, int part, int nparts) {
    const int tid = otid(wv), lane = tid & 63, w = __builtin_amdgcn_readfirstlane(tid >> 6), lr = lane & 15, lq = lane >> 4;
    constexpr int PW = N1 + 8, NB = N1 / 16, NK = N1 / 32; constexpr int S = N1 * 128;
    const bf16_t* z = (const bf16_t*)(p.ws + WS_BIG1); bf16_t* A1 = (bf16_t*)(p.ws + WS_BIG2);
    const bf16_t* ctg = (const bf16_t*)(p.ws + WS_TAB + (N1 == 64 ? TAB_CT64 : TAB_CT128)); const bf16_t* stg = (const bf16_t*)(p.ws + WS_TAB + (N1 == 64 ? TAB_ST64 : TAB_ST128));
    bf16_t* CT = (bf16_t*)lds; bf16_t* ST = CT + N1 * PW; bf16_t* XT = ST + N1 * PW;
    for (int idx = tid; idx < N1 * N1 / 8; idx += NTHR) { const int r = idx / (N1 / 8), c8 = (idx % (N1 / 8)) * 8;
        *(bf16x8*)(CT + r * PW + c8) = *(const bf16x8*)(ctg + r * N1 + c8); *(bf16x8*)(ST + r * PW + c8) = *(const bf16x8*)(stg + r * N1 + c8); }
    __syncthreads();
    const int nunits = nseq * 128 * 8;
    for (int unit = part; unit < nunits; unit += nparts) {
        const int sq = unit / 1024, b = (unit >> 3) & 127, cb = unit & 7;
        const int seq = seq_lo + sq; const size_t sbase = (size_t)seq * 8192;
        for (int idx = tid; idx < N1 * 16; idx += NTHR) { const int a = idx % N1, c8 = (idx / N1) * 8;
            const bf16x8 v = *(const bf16x8*)(z + (sbase + 128 * a + b) * DM + cb * 128 + c8);
#pragma unroll
            for (int e = 0; e < 8; ++e) XT[(c8 + e) * PW + a] = (bf16_t)v[e]; }
        __syncthreads();
        bf16x8 xf[NK];
#pragma unroll
        for (int kk = 0; kk < NK; ++kk) xf[kk] = *(const bf16x8*)(XT + (16 * w + lr) * PW + 32 * kk + 8 * lq);
#pragma unroll
        for (int i = 0; i < NB; ++i) { f32x4 ar = {0, 0, 0, 0}, as = {0, 0, 0, 0};
#pragma unroll
            for (int kk = 0; kk < NK; ++kk) { const bf16x8 cf = *(const bf16x8*)(CT + (16 * i + lr) * PW + 32 * kk + 8 * lq), sf = *(const bf16x8*)(ST + (16 * i + lr) * PW + 32 * kk + 8 * lq);
                ar = mfma16(xf[kk], cf, ar); as = mfma16(xf[kk], sf, as); }
            const int ka = 16 * i + lr; float tc, ts; sincospif(2.0f * (float)(b * ka) / (float)S, &ts, &tc);
            const f32x4 re = ar * tc - as * ts, im = -(as * tc) - ar * ts;
            bf16_t* op = A1 + (sbase + (size_t)ka * 128 + b) * 2048 + cb * 128 + 16 * w + 4 * lq;
            u32x2 o; o.x = cvt_pk_bf16(re[0], re[1]); o.y = cvt_pk_bf16(re[2], re[3]); *(u32x2*)op = o;
            o.x = cvt_pk_bf16(im[0], im[1]); o.y = cvt_pk_bf16(im[2], im[3]); *(u32x2*)(op + 1024) = o; }
        __syncthreads();
    }
}
__device__ void fft2_phase(int wv, const Params& p, unsigned char* lds) {
    const int tid = otid(wv), lane = tid & 63, w = __builtin_amdgcn_readfirstlane(tid >> 6), lr = lane & 15, lq = lane >> 4;
    constexpr int PW = 136;
    const bf16_t* A1 = (const bf16_t*)(p.ws + WS_BIG2); bf16_t* Y = (bf16_t*)(p.ws + WS_BIG1);
    const bf16_t* ctg = (const bf16_t*)(p.ws + WS_TAB + TAB_CT128); const bf16_t* stg = (const bf16_t*)(p.ws + WS_TAB + TAB_ST128);
    bf16_t* CT = (bf16_t*)lds; bf16_t* ST = CT + 128 * PW; bf16_t* XR = ST + 128 * PW; bf16_t* XI = XR + 128 * PW;
    for (int idx = tid; idx < 128 * 16; idx += NTHR) { const int r = idx >> 4, c8 = (idx & 15) * 8;
        *(bf16x8*)(CT + r * PW + c8) = *(const bf16x8*)(ctg + r * 128 + c8); *(bf16x8*)(ST + r * PW + c8) = *(const bf16x8*)(stg + r * 128 + c8); }
    __syncthreads();
    for (int unit = blockIdx.x; unit < 2048; unit += gridDim.x) {
        const int gi = unit >> 3, cb = unit & 7;
        const int seq = gi < 64 ? 0 : (gi < 128 ? 1 : 2); const int ka = gi - (seq == 0 ? 0 : (seq == 1 ? 64 : 128)); const int N1 = seq == 2 ? 128 : 64;
        const size_t sbase = (size_t)seq * 8192;
#pragma unroll
        for (int ps = 0; ps < 4; ++ps) { const int idx = tid + ps * NTHR, b = idx & 127, c8 = (idx >> 7) * 8;
            const bf16_t* rp = A1 + ((size_t)gi * 128 + b) * 2048 + cb * 128 + c8; const bf16x8 vr = *(const bf16x8*)rp, vi = *(const bf16x8*)(rp + 1024);
#pragma unroll
            for (int e = 0; e < 8; ++e) { XR[(c8 + e) * PW + b] = (bf16_t)vr[e]; XI[(c8 + e) * PW + b] = (bf16_t)vi[e]; } }
        __syncthreads();
        bf16x8 xr[4], xi[4], nxr[4];
#pragma unroll
        for (int kk = 0; kk < 4; ++kk) { xr[kk] = *(const bf16x8*)(XR + (16 * w + lr) * PW + 32 * kk + 8 * lq); xi[kk] = *(const bf16x8*)(XI + (16 * w + lr) * PW + 32 * kk + 8 * lq);
            union { bf16x8 v; unsigned u[4]; } t; t.v = xr[kk]; t.u[0] ^= 0x80008000u; t.u[1] ^= 0x80008000u; t.u[2] ^= 0x80008000u; t.u[3] ^= 0x80008000u; nxr[kk] = t.v; }
#pragma unroll
        for (int i = 0; i < 8; ++i) { f32x4 re = {0, 0, 0, 0}, im = {0, 0, 0, 0};
#pragma unroll
            for (int kk = 0; kk < 4; ++kk) { const bf16x8 cf = *(const bf16x8*)(CT + (16 * i + lr) * PW + 32 * kk + 8 * lq), sf = *(const bf16x8*)(ST + (16 * i + lr) * PW + 32 * kk + 8 * lq);
                re = mfma16(xr[kk], cf, re); re = mfma16(xi[kk], sf, re); im = mfma16(xi[kk], cf, im); im = mfma16(nxr[kk], sf, im); }
            const int kb = 16 * i + lr;
            bf16_t* op = Y + (sbase + (size_t)N1 * kb + ka) * 2048 + cb * 128 + 16 * w + 4 * lq;
            u32x2 o; o.x = cvt_pk_bf16(re[0], re[1]); o.y = cvt_pk_bf16(re[2], re[3]); *(u32x2*)op = o;
            o.x = cvt_pk_bf16(im[0], im[1]); o.y = cvt_pk_bf16(im[2], im[3]); *(u32x2*)(op + 1024) = o; }
        __syncthreads();
    }
}

__device__ void fix_phase(int wv, const Params& p, int li) {
    const float* edge = (const float*)(p.ws + WS_EDGE); const float* cw = (const float*)(p.ws + WS_CW) + (size_t)li * 4 * NUP; bf16_t* act = (bf16_t*)(p.ws + WS_ACT);
    const int total = 1024 * (FFD / 4);
    const int tid = otid(wv);
    for (int idx = blockIdx.x * NTHR + tid; idx < total; idx += gridDim.x * NTHR) {
        const int e = idx / (FFD / 4), c = (idx % (FFD / 4)) * 4; const int band = e >> 1, hi = e & 1; const int R = band * 64 + (hi ? 63 : 0);
        const int ca = (c >> 7) * 256 + (c & 127), cg_ = ca + 128;
        const bool seqstart = (R == 0 || R == 8192 || R == 16384), seqend = (R == 8191 || R == 16383 || R == 32767);
        const float* ep = edge + (size_t)band * 4 * NUP;
        f32x4 pa, pg, ua, ug, na, ng; const f32x4 zero = {0, 0, 0, 0};
        if (!hi) { pa = seqstart ? zero : *(const f32x4*)(ep - NUP + ca); pg = seqstart ? zero : *(const f32x4*)(ep - NUP + cg_);
            ua = *(const f32x4*)(ep + ca); ug = *(const f32x4*)(ep + cg_); na = *(const f32x4*)(ep + NUP + ca); ng = *(const f32x4*)(ep + NUP + cg_); }
        else { pa = *(const f32x4*)(ep + 2 * NUP + ca); pg = *(const f32x4*)(ep + 2 * NUP + cg_); ua = *(const f32x4*)(ep + 3 * NUP + ca); ug = *(const f32x4*)(ep + 3 * NUP + cg_);
            na = seqend ? zero : *(const f32x4*)(ep + 4 * NUP + ca); ng = seqend ? zero : *(const f32x4*)(ep + 4 * NUP + cg_); }
        const f32x4 a = *(const f32x4*)(cw + ca) * pa + *(const f32x4*)(cw + NUP + ca) * ua + *(const f32x4*)(cw + 2 * NUP + ca) * na + *(const f32x4*)(cw + 3 * NUP + ca);
        const f32x4 g = *(const f32x4*)(cw + cg_) * pg + *(const f32x4*)(cw + NUP + cg_) * ug + *(const f32x4*)(cw + 2 * NUP + cg_) * ng + *(const f32x4*)(cw + 3 * NUP + cg_);
        float o[4];
#pragma unroll
        for (int j = 0; j < 4; ++j) o[j] = a[j] * g[j] / (1.0f + __expf(-g[j]));
        u32x2 wv; wv.x = cvt_pk_bf16(o[0], o[1]); wv.y = cvt_pk_bf16(o[2], o[3]);
        *(u32x2*)(act + (size_t)R * FFD + c) = wv;
    }
}

#define XB_TMO      128
#define XB_XCNT(j)  (256  + 64 * (j))
#define XB_XSUB(j)  (1280 + 64 * (j))
#define XB_XGEN(j)  (2304 + 64 * (j))
#define XB_TOP      3328
#define XB_TOPGEN   3392
#define XCD_BAR_WORDS 3456
#define XB_SPIN_CAP (1u << 18)
__device__ __forceinline__ unsigned xb_ld(unsigned* p)              { return __hip_atomic_load(p, __ATOMIC_RELAXED, __HIP_MEMORY_SCOPE_AGENT); }
__device__ __forceinline__ unsigned xb_add(unsigned* p, unsigned v) { return __hip_atomic_fetch_add(p, v, __ATOMIC_RELAXED, __HIP_MEMORY_SCOPE_AGENT); }
__device__ __forceinline__ unsigned xb_xcc_id() { return (unsigned)__builtin_amdgcn_s_getreg((3 << 11) | 20) & 0xFu; }
#define XB_SPIN(cond, bar) do { unsigned _sp = 0; while (cond) { __builtin_amdgcn_s_sleep(1); \
    if ((++_sp & 255u) == 0u) { if (xb_ld(&(bar)[XB_TMO])) break; if (_sp > XB_SPIN_CAP) { atomicAdd(&(bar)[XB_TMO], 1u); break; } } } } while (0)
struct XcdBarrier { unsigned* bar; unsigned x; volatile LAS unsigned* st; };
__device__ __forceinline__ XcdBarrier xcd_barrier_post(unsigned* bar, volatile LAS unsigned* st) {
    XcdBarrier b; b.bar = bar; b.x = xb_xcc_id(); b.st = st;
    if (threadIdx.x == 0) (void)xb_add(&bar[XB_XCNT(b.x)], 1u);
    return b;
}
__device__ __forceinline__ void xcd_barrier_complete(unsigned* bar, unsigned x, unsigned& nloc, unsigned& nx) {
    const unsigned G = gridDim.x * gridDim.y * gridDim.z;
    unsigned sum, cnt, mine, sp = 0u;
    for (;;) {
        sum = 0u; cnt = 0u; mine = 0u;
#pragma unroll
        for (unsigned j = 0; j < 16; ++j) { const unsigned c = xb_ld(&bar[XB_XCNT(j)]); sum += c; cnt += (c > 0u) ? 1u : 0u; mine = (j == x) ? c : mine; }
        if (sum == G) break;
        __builtin_amdgcn_s_sleep(1);
        if ((++sp & 255u) == 0u) { if (xb_ld(&bar[XB_TMO])) break; if (sp > XB_SPIN_CAP) { atomicAdd(&bar[XB_TMO], 1u); break; } }
    }
    nloc = mine > 0u ? mine : 1u; nx = cnt > 0u ? cnt : 1u;
}
__device__ __forceinline__ void xcd_barrier(const XcdBarrier& b, int wv) {
    asm volatile("s_waitcnt vmcnt(0)" ::: "memory");
    __syncthreads();
    if (otid(wv) == 0) {
        unsigned* bar = b.bar;
        unsigned bx = (unsigned)__builtin_amdgcn_readfirstlane((int)xb_xcc_id()); asm volatile("" : "+s"(bx));
        __builtin_amdgcn_s_waitcnt(0);
        unsigned nloc = b.st[0], nx = b.st[1];
        if (nloc == 0u) { xcd_barrier_complete(bar, bx, nloc, nx); b.st[0] = nloc; b.st[1] = nx; }
        const unsigned old = xb_add(&bar[XB_XSUB(bx)], 1u);
        const unsigned gen = old / nloc;
        if (old + 1u == (gen + 1u) * nloc) {
            __builtin_amdgcn_fence(__ATOMIC_RELEASE, "agent");
            asm volatile("s_waitcnt vmcnt(0)" ::: "memory");
            const unsigned og = xb_add(&bar[XB_TOP], 1u);
            const unsigned tg = og / nx;
            if (og + 1u == (tg + 1u) * nx) xb_add(&bar[XB_TOPGEN], 1u);
            else XB_SPIN(xb_ld(&bar[XB_TOPGEN]) == tg, bar);
            __builtin_amdgcn_fence(__ATOMIC_ACQUIRE, "agent");
            xb_add(&bar[XB_XGEN(bx)], 1u);
            asm volatile("s_waitcnt vmcnt(0)" ::: "memory");
        } else {
            XB_SPIN(xb_ld(&bar[XB_XGEN(bx)]) == gen, bar);
            __builtin_amdgcn_fence(__ATOMIC_ACQUIRE, "agent");
            asm volatile("s_waitcnt vmcnt(0)" ::: "memory");
        }
    }
    __syncthreads();
}

__global__ void __launch_bounds__(NTHR, 2) mega(Params p) {
    extern __shared__ __attribute__((aligned(16))) unsigned char lds[];
    cg::grid_group grid = cg::this_grid();
    const int G = gridDim.x, bid = blockIdx.x;
    const int wv = __builtin_amdgcn_readfirstlane(threadIdx.x >> 6);
    volatile LAS unsigned* xst = (volatile LAS unsigned*)((LAS unsigned char*)lds + (LDS_BYTES - 16));
    if (threadIdx.x == 0) { xst[0] = 0u; xst[1] = 0u; }
    __syncthreads();
    const XcdBarrier xbar = xcd_barrier_post((unsigned*)(p.ws + WS_BAR), xst);
    float* ldsf = (float*)lds;
#define WSPTRS \
    size_t wsoff_ = 0; asm volatile("" : "+s"(wsoff_)); unsigned char* ws = p.ws + wsoff_; \
    float* ssb = (float*)(ws + WS_SS); float* mod = (float*)(ws + WS_MOD); float* gsT = (float*)(ws + WS_GS); \
    float* biasG1 = (float*)(ws + WS_BG1); float* biasUP = (float*)(ws + WS_BUP); float* cwT = (float*)(ws + WS_CW); \
    bf16_t* xb = (bf16_t*)(ws + WS_XB); bf16_t* big1 = (bf16_t*)(ws + WS_BIG1); \
    bf16_t* wain = (bf16_t*)(ws + WS_WAIN); bf16_t* waout = (bf16_t*)(ws + WS_WAOUT); bf16_t* wqkv = (bf16_t*)(ws + WS_WQKV); bf16_t* wo = (bf16_t*)(ws + WS_WO); \
    bf16_t* wcin = (bf16_t*)(ws + WS_WCIN); bf16_t* wf = (bf16_t*)(ws + WS_WF); bf16_t* wup = (bf16_t*)(ws + WS_WUP); bf16_t* wdn = (bf16_t*)(ws + WS_WDN); \
    (void)ssb; (void)mod; (void)gsT; (void)biasG1; (void)biasUP; (void)cwT; (void)xb; (void)big1; (void)wain; (void)waout; (void)wqkv; (void)wo; (void)wcin; (void)wf; (void)wup; (void)wdn;
    {
    WSPTRS
    const int tid = otid(wv);
    for (int idx = bid * NTHR + tid; idx < 10 * MTOK / 4; idx += G * NTHR) *(f32x4*)(ssb + MTOK + 4 * (size_t)idx) = (f32x4){0.f, 0.f, 0.f, 0.f};
    if (bid < 192) mod_task(wv, p, bid, ldsf);
    { bf16_t* tab = (bf16_t*)(ws + WS_TAB);
        for (int idx = bid * NTHR + tid; idx < 4096 + 16384; idx += G * NTHR) {
            if (idx < 4096) { const int ka = idx >> 6, a = idx & 63; const float x = 2.0f * (float)((ka * a) & 63) / 64.0f; tab[TAB_CT64 / 2 + idx] = f2bf(cospif(x) * 0.125f); tab[TAB_ST64 / 2 + idx] = f2bf(sinpif(x) * 0.125f); }
            else { const int i2 = idx - 4096, ka = i2 >> 7, a = i2 & 127; const float x = 2.0f * (float)((ka * a) & 127) / 128.0f; tab[TAB_CT128 / 2 + i2] = f2bf(cospif(x) * 0.08838834764831845f); tab[TAB_ST128 / 2 + i2] = f2bf(sinpif(x) * 0.08838834764831845f); } } }
    if (bid >= G - 128) wf_task(wv, p, bid - (G - 128), ldsf);
    convert_matrix(wv, p.a_w_in, 1024, 2048, 2048, 0, wain, ldsf, 0);
    convert_matrix(wv, p.a_w_in + (size_t)1024 * 2048, 1024, 2048, 2048, 0, wain + (size_t)2048 * 1024, ldsf, 128);
    convert_matrix(wv, p.a_w_out, 1024, 1024, 1024, 0, waout, ldsf, 0);
    convert_matrix(wv, p.a_w_out + (size_t)1024 * 1024, 1024, 1024, 1024, 0, waout + (size_t)1024 * 1024, ldsf, 64);
    convert_matrix(wv, p.b_w_qkv, 1024, 1536, 1536, 0, wqkv, ldsf, 128);
    convert_matrix(wv, p.b_w_o, 1024, 1024, 1024, 0, wo, ldsf, 224);
    convert_matrix(wv, p.c_w_in, 1024, 1024, 1024, 0, wcin, ldsf, 32);
    convert_matrix(wv, p.f_w_up, 1024, NUP, NUP, 1, wup, ldsf, 96);
    convert_matrix(wv, p.f_w_down, FFD, 1024, 1024, 0, wdn, ldsf, 192);
    grid.sync();

    }
    {
    WSPTRS
    const int tid = otid(wv);
    if (bid < 48) {
        if (bid < 8) bias_task(wv, p.a_w_in, 2048, 0, mod, biasG1, 2048, bid, ldsf);
        else if (bid < 14) bias_task(wv, p.b_w_qkv, 1536, 0, mod + 3 * MODW, biasG1 + 3 * 2048, 1536, bid - 8, ldsf);
        else if (bid < 18) bias_task(wv, p.c_w_in, 1024, 0, mod + 6 * MODW, biasG1 + 6 * 2048, 1024, bid - 14, ldsf);
        else if (bid < 26) bias_task(wv, p.a_w_in + (size_t)1024 * 2048, 2048, 0, mod + 9 * MODW, biasG1 + 9 * 2048, 2048, bid - 18, ldsf);
        else bias_task(wv, p.f_w_up, NUP, 1, mod + 3 * DM, biasUP, NUP, bid - 26, ldsf);
    }
    for (int idx = bid * NTHR + tid; idx < 9 * 3 * DM; idx += G * NTHR) { const int ni = idx / (3 * DM), seq = (idx / DM) % 3, c = idx % DM;
        float v; if (ni == 8) v = p.g_final[c]; else { const int i = ni >> 1, t = ni & 1; v = p.norm_g[(i * 2 + t) * DM + c] * (1.0f + mod[((size_t)i * 3 + seq) * MODW + (t ? 4 : 1) * DM + c]); }
        gsT[idx] = v; }
    for (int idx = bid * NTHR + tid; idx < 4 * 4 * NUP; idx += G * NTHR) { const int i = idx / (4 * NUP), q = (idx / NUP) & 3, n = idx % NUP; const int oc = upcol(n);
        cwT[idx] = q < 3 ? p.f_w_conv[((size_t)i * 3 + q) * NUP + oc] : p.f_b_conv[(size_t)i * NUP + oc]; }
    convert_matrix(wv, (const float*)(ws + WS_WF32), 2048, 1024, 1024, 0, wf, ldsf, 48);
    { const int wid = tid >> 6, lane = tid & 63;
        for (int r = bid * 8 + wid; r < MTOK; r += G * 8) { const int seq = seq_of_row(r);
            const float* xr = r < 16384 ? p.xp + (size_t)r * DM : p.xs + (size_t)(r - 16384) * DM; float s = 0.f; f32x4 v[4];
#pragma unroll
            for (int jj = 0; jj < 4; ++jj) { v[jj] = *(const f32x4*)(xr + jj * 256 + 4 * lane); s += (v[jj][0] * v[jj][0] + v[jj][1] * v[jj][1]) + (v[jj][2] * v[jj][2] + v[jj][3] * v[jj][3]); }
#pragma unroll
            for (int o = 32; o >= 1; o >>= 1) s += __shfl_xor(s, o);
            if (lane == 0) ssb[r] = s;
#pragma unroll
            for (int jj = 0; jj < 4; ++jj) { const int c = jj * 256 + 4 * lane; u32x2 wv; float h[4];
#pragma unroll
                for (int j = 0; j < 4; ++j) h[j] = v[jj][j] * (p.norm_g[c + j] * (1.0f + mod[(size_t)seq * MODW + DM + c + j]));
                wv.x = cvt_pk_bf16(h[0], h[1]); wv.y = cvt_pk_bf16(h[2], h[3]); *(u32x2*)(xb + (size_t)r * DM + c) = wv; } } }
    xcd_barrier(xbar, wv);
    }

    LAS unsigned char* ldsl = (LAS unsigned char*)lds;
    for (int i = 0; i < 4; ++i) {
        WSPTRS
        const int kind = i % 3, jl = i / 3;
        {   pg8::StaticOrder S; const float* ssin = ssb + (size_t)(2 * i) * MTOK;
            if (kind == 0) { pg8::Gemm g{xb, wain + (size_t)jl * 2048 * 1024, MTOK, 2048, 1024, 1024}; S.init(MTOK, 2048, G, bid);
                pg8::EpiAct<1> E{big1, 2048, biasG1 + (size_t)i * 3 * 2048, 2048, ssin, ssb + (size_t)(9 + jl) * MTOK, 1024};
#ifndef NO_G1A
                pg8::gemm_phase<pg8::EpiAct<1>>(wv, ldsl, g, S, E);
#endif
 }
            else { const int N = kind == 1 ? 1536 : 1024; pg8::Gemm g{xb, kind == 1 ? wqkv : wcin, MTOK, N, 1024, 1024}; S.init(MTOK, N, G, bid);
                pg8::EpiAct<0> E{big1, N, biasG1 + (size_t)i * 3 * 2048, N, ssin, nullptr, 0};
#ifndef NO_G1B
                pg8::gemm_phase<pg8::EpiAct<0>>(wv, ldsl, g, S, E);
#endif
 }
        }
        xcd_barrier(xbar, wv);
        if (i < 3) {
            convert_matrix(wv, p.f_w_up + (size_t)(i + 1) * 1024 * NUP, 1024, NUP, NUP, 1, wup + (size_t)((i + 1) & 1) * NUP * 1024, ldsf, 0);
            convert_matrix(wv, p.f_w_down + (size_t)(i + 1) * FFD * 1024, FFD, 1024, 1024, 0, wdn + (size_t)((i + 1) & 1) * 1024 * FFD, ldsf, 96);
            if (bid >= G - 22) bias_task(wv, p.f_w_up + (size_t)(i + 1) * 1024 * NUP, NUP, 1, mod + (size_t)(i + 1) * 3 * MODW + 3 * DM, biasUP + (size_t)((i + 1) & 1) * 3 * NUP, NUP, bid - (G - 22), ldsf);
        }
#ifndef NO_SG
        if (kind == 0) sg_phase(wv, p, jl, lds);
#endif
#ifndef NO_ATT
        if (kind == 1) att_phase(wv, p, lds);
#endif
#ifndef NO_FFT
        if (kind == 2) {
#ifndef NO_FFT1
            if (bid < G / 2) fft1_units<64>(wv, p, lds, 0, 2, bid, G / 2); else fft1_units<128>(wv, p, lds, 2, 1, bid - G / 2, G - G / 2);
#endif
            xcd_barrier(xbar, wv);
#ifndef NO_FFT2
            fft2_phase(wv, p, lds);
#endif
        }
#endif
        xcd_barrier(xbar, wv);
        for (int half = 0; half < 2; ++half) {
            if (half == 1) {
                {   pg8::Gemm g{xb, wup + (size_t)(i & 1) * NUP * 1024, MTOK, NUP, 1024, 1024}; pg8::StaticOrder S; S.init(MTOK, NUP, G, bid);
                    pg8::EpiUp E{(bf16_t*)(ws + WS_ACT), biasUP + (size_t)(i & 1) * 3 * NUP, cwT + (size_t)i * 4 * NUP, ssb + (size_t)(2 * i + 1) * MTOK, (float*)(ws + WS_EDGE)};
#ifndef NO_UP
                    pg8::gemm_phase<pg8::EpiUp>(wv, ldsl, g, S, E);
#endif
 }
                xcd_barrier(xbar, wv);
                fix_phase(wv, p, i);
                xcd_barrier(xbar, wv);
            }
            pg8::Gemm g; const float* gate; const float* gsn; bf16_t* xbo = xb; float* ssn; const float* b0 = p.out; const float* b1 = p.out + (size_t)16384 * DM;
            if (half == 0) {
                if (kind == 0) g = pg8::Gemm{big1, waout + (size_t)jl * 1024 * 1024, MTOK, 1024, 1024, 2048};
                else if (kind == 1) g = pg8::Gemm{big1, wo, MTOK, 1024, 1024, 1536};
                else g = pg8::Gemm{big1, wf, MTOK, 1024, 2048, 2048};
                gate = mod + (size_t)i * 3 * MODW + 2 * DM; gsn = gsT + (size_t)(2 * i + 1) * 3 * DM; ssn = ssb + (size_t)(2 * i + 1) * MTOK;
                if (i == 0) { b0 = p.xp; b1 = p.xs; }
            } else {
                g = pg8::Gemm{(const bf16_t*)(ws + WS_ACT), wdn + (size_t)(i & 1) * 1024 * FFD, MTOK, 1024, FFD, FFD};
                gate = mod + (size_t)i * 3 * MODW + 5 * DM; gsn = gsT + (size_t)(2 * i + 2) * 3 * DM; ssn = ssb + (size_t)(2 * i + 2) * MTOK;
                if (i == 3) xbo = nullptr;
            }
            pg8::StaticOrder S; S.init(MTOK, 1024, G, bid);
            pg8::EpiRes E{b0, b1, p.out, gate, gsn, xbo, ssn};
#ifndef NO_RES
            pg8::gemm_phase<pg8::EpiRes>(wv, ldsl, g, S, E);
#endif
            xcd_barrier(xbar, wv);
        }
    }
    { const float* ssF = (const float*)(p.ws + WS_SS) + (size_t)8 * MTOK; const int tid = otid(wv);
        for (size_t idx = (size_t)bid * NTHR + tid; idx < (size_t)MTOK * DM / 4; idx += (size_t)G * NTHR) { const int r = (int)(idx >> 8), c = (int)(idx & 255) * 4;
            const float rs = 1.0f / sqrtf(ssF[r] * (1.0f / DM) + EPSN); f32x4 v = *(const f32x4*)(p.out + (size_t)r * DM + c); const f32x4 gf = *(const f32x4*)(p.g_final + c);
            v = v * rs * gf; *(f32x4*)(p.out + (size_t)r * DM + c) = v; } }
}

extern "C" void kernel_launch(void* const* d_in, const int* in_sizes, int n_in, void* d_out, int out_size, void* d_ws, size_t ws_size, hipStream_t stream) {
    static int grid_blocks = 0;
    if (!grid_blocks) {
        if (ws_size < WS_END) { fprintf(stderr, "kernel_launch: workspace too small: %zu < %zu\n", ws_size, (size_t)WS_END); grid_blocks = -1; return; }
        int dev = 0, cus = 0, per_cu = 0;
        hipGetDevice(&dev);
        hipDeviceGetAttribute(&cus, hipDeviceAttributeMultiprocessorCount, dev);
        hipFuncSetAttribute((const void*)mega, hipFuncAttributeMaxDynamicSharedMemorySize, LDS_BYTES);
        hipOccupancyMaxActiveBlocksPerMultiprocessor(&per_cu, (const void*)mega, NTHR, LDS_BYTES);
        if (per_cu < 1) { fprintf(stderr, "kernel_launch: occupancy query says %d blocks per CU\n", per_cu); per_cu = 1; }
        grid_blocks = cus;
        (void)hipGetLastError();
    }
    if (grid_blocks < 0) return;
    if (hipMemsetAsync((char*)d_ws + WS_BAR, 0, BAR_BYTES, stream) != hipSuccess) { fprintf(stderr, "kernel_launch: memset of the barrier words failed\n"); return; }
    Params p{};
    p.xp = (const float*)d_in[0]; p.xs = (const float*)d_in[1]; p.cp = (const float*)d_in[2]; p.csm = (const float*)d_in[3]; p.w_ada = (const float*)d_in[4]; p.b_ada = (const float*)d_in[5];
    p.norm_g = (const float*)d_in[6]; p.a_w_in = (const float*)d_in[7]; p.a_g_v = (const float*)d_in[8]; p.a_w_s = (const float*)d_in[9]; p.a_b_s = (const float*)d_in[10]; p.a_w_out = (const float*)d_in[11];
    p.b_w_qkv = (const float*)d_in[12]; p.b_sinks = (const float*)d_in[13]; p.b_w_o = (const float*)d_in[14]; p.c_w_in = (const float*)d_in[15]; p.c_w_out = (const float*)d_in[16];
    p.f_w_up = (const float*)d_in[17]; p.f_w_conv = (const float*)d_in[18]; p.f_b_conv = (const float*)d_in[19]; p.f_w_down = (const float*)d_in[20]; p.g_final = (const float*)d_in[21];
    p.out = (float*)d_out; p.ws = (unsigned char*)d_ws;
    void* args[] = {&p};
    hipError_t e = hipLaunchCooperativeKernel((const void*)mega, dim3(grid_blocks), dim3(NTHR), args, LDS_BYTES, stream);
    if (e != hipSuccess) fprintf(stderr, "cooperative launch failed: %s (grid %d)\n", hipGetErrorString(e), grid_blocks);
}
```

```cpp
#include <hip/hip_runtime.h>
#include <hip/hip_cooperative_groups.h>
#include <cstdio>
namespace cg = cooperative_groups;

#define LAS __attribute__((address_space(3)))
typedef unsigned short bf16_t;
typedef short bf16x8 __attribute__((ext_vector_type(8)));
typedef short bf16x4 __attribute__((ext_vector_type(4)));
typedef float f32x4 __attribute__((ext_vector_type(4)));
typedef unsigned u32x4 __attribute__((ext_vector_type(4)));
typedef unsigned u32x2 __attribute__((ext_vector_type(2)));

constexpr int DM = 1024, MTOK = 32768, FFD = 2816, NUP = 5632, MODW = 6144;
constexpr float EPSN = 1e-6f;
constexpr int NTHR = 512;
constexpr int LDS_BYTES = 147456;

constexpr size_t al256(size_t x) { return (x + 255) & ~(size_t)255; }
constexpr size_t WS_SS = 0;
constexpr size_t SS_BYTES = (size_t)11 * MTOK * 4;
constexpr size_t WS_MOD = al256(WS_SS + SS_BYTES);
constexpr size_t WS_GS = al256(WS_MOD + (size_t)4 * 3 * MODW * 4);
constexpr size_t WS_BG1 = al256(WS_GS + (size_t)9 * 3 * DM * 4);
constexpr size_t WS_BUP = al256(WS_BG1 + (size_t)4 * 3 * 2048 * 4);
constexpr size_t WS_CW = al256(WS_BUP + (size_t)4 * 3 * NUP * 4);
constexpr size_t WS_TAB = al256(WS_CW + (size_t)4 * 4 * NUP * 4);
constexpr size_t TAB_CT64 = 0, TAB_ST64 = 8192, TAB_CT128 = 16384, TAB_ST128 = 16384 + 32768;
constexpr size_t WS_BAR = al256(WS_TAB + 81920);
constexpr size_t BAR_BYTES = 3456 * 4;
constexpr size_t WS_WF32 = al256(WS_BAR + BAR_BYTES);
constexpr size_t WS_WAIN = al256(WS_WF32 + (size_t)2048 * 1024 * 4);
constexpr size_t WS_WAOUT = al256(WS_WAIN + (size_t)2 * 2048 * 1024 * 2);
constexpr size_t WS_WQKV = al256(WS_WAOUT + (size_t)2 * 1024 * 1024 * 2);
constexpr size_t WS_WO = al256(WS_WQKV + (size_t)1536 * 1024 * 2);
constexpr size_t WS_WCIN = al256(WS_WO + (size_t)1024 * 1024 * 2);
constexpr size_t WS_WF = al256(WS_WCIN + (size_t)1024 * 1024 * 2);
constexpr size_t WS_WUP = al256(WS_WF + (size_t)1024 * 2048 * 2);
constexpr size_t WS_WDN = al256(WS_WUP + (size_t)2 * NUP * 1024 * 2);
constexpr size_t WS_XB = al256(WS_WDN + (size_t)2 * 1024 * FFD * 2);
constexpr size_t WS_BIG1 = al256(WS_XB + (size_t)MTOK * DM * 2);
constexpr size_t WS_BIG2 = al256(WS_BIG1 + (size_t)MTOK * 2048 * 2);
constexpr size_t WS_ACT = WS_BIG1;
constexpr size_t WS_EDGE = al256(WS_ACT + (size_t)MTOK * FFD * 2);
constexpr size_t WS_END = al256(WS_BIG2 + (size_t)MTOK * 2048 * 2);
static_assert(WS_EDGE + (size_t)512 * 4 * NUP * 4 <= WS_END, "edge buffer must fit");

struct Params {
    const float* xp; const float* xs; const float* cp; const float* csm; const float* w_ada; const float* b_ada; const float* norm_g;
    const float* a_w_in; const float* a_g_v; const float* a_w_s; const float* a_b_s; const float* a_w_out;
    const float* b_w_qkv; const float* b_sinks; const float* b_w_o; const float* c_w_in; const float* c_w_out;
    const float* f_w_up; const float* f_w_conv; const float* f_b_conv; const float* f_w_down; const float* g_final;
    float* out; unsigned char* ws;
};

__device__ __forceinline__ int otid(int wv) { int t; asm volatile("v_mbcnt_lo_u32_b32 %0, -1, 0\n\tv_mbcnt_hi_u32_b32 %0, -1, %0\n\tv_lshl_add_u32 %0, %1, 6, %0" : "=&v"(t) : "s"(wv)); return t; }
typedef __bf16 bf2_t __attribute__((ext_vector_type(2)));
typedef float f2_t __attribute__((ext_vector_type(2)));
__device__ __forceinline__ unsigned cvt_pk_bf16_asm(float lo, float hi) { unsigned r; asm volatile("v_cvt_pk_bf16_f32 %0, %1, %2" : "=v"(r) : "v"(lo), "v"(hi)); return r; }
__device__ __forceinline__ unsigned cvt_pk_bf16(float lo, float hi) { const f2_t v = {lo, hi}; const bf2_t b = __builtin_convertvector(v, bf2_t); return __builtin_bit_cast(unsigned, b); }
__device__ __forceinline__ bf16_t f2bf(float f) { return (bf16_t)(cvt_pk_bf16(f, 0.f) & 0xffffu); }
__device__ __forceinline__ int seq_of_row(int r) { return r < 8192 ? 0 : (r < 16384 ? 1 : 2); }
__device__ __forceinline__ int upcol(int n) { return (n >> 8) * 128 + (n & 127) + ((n & 128) ? FFD : 0); }

namespace pg8 {
constexpr int BM = 256, BK = 64, HALF = 128, HTB = HALF * BK * 2, STAGE_BYTES = 8 * HTB, NXCD = 8, WGM = 8;
__device__ __forceinline__ int lds_byte(int r, int c) { const int st = (r >> 4) * 2 + (c >> 5), rr = r & 15, cc = c & 31, ob = rr * 64 + cc * 2; return st * 1024 + (ob ^ (((ob >> 9) & 1) << 5)); }
__device__ __forceinline__ void stage_rc(int b, int& R, int& C) { const int st = b / 1024, sb = b % 1024, swz = sb ^ (((sb >> 9) & 1) << 5); R = (st >> 1) * 16 + swz / 64; C = (st & 1) * 32 + (swz % 64) / 2; }
__device__ __forceinline__ int perm32(int rho) { const int n = rho >> 4, i = rho & 15; return 8 * (i >> 2) + 4 * n + (i & 3); }
struct Unit { int pm, pn; };
struct Gemm { const bf16_t* A; const bf16_t* Bt; int M, N, K, lda; };
struct StaticOrder {
    int nM, nN, nwg, G, c;
    __device__ void init(int M, int N, int G_, int c_) { nM = M / BM; nN = N / BM; nwg = nM * nN; G = G_; c = c_; }
    __device__ bool next(int i, Unit& u) const {
        const long L = (long)i * G + c; if (L >= nwg) return false;
        int wgid = (int)L; { const int q = nwg / NXCD, r = nwg % NXCD, xcd = wgid % NXCD, off = wgid / NXCD; wgid = (xcd < r ? xcd * (q + 1) : r * (q + 1) + (xcd - r) * q) + off; }
        const int nig = WGM * nN, gid = wgid / nig, fm = gid * WGM, gsz = (nM - fm) < WGM ? (nM - fm) : WGM;
        u.pm = fm + ((wgid % nig) % gsz); u.pn = (wgid % nig) / gsz; return true;
    }
};

template <class Epi>
__device__ __forceinline__ void gemm_phase(int wv, LAS unsigned char* lds, const Gemm g, const StaticOrder& S, const Epi& E) {
    const int tid = otid(wv), wid = __builtin_amdgcn_readfirstlane(tid >> 6), lane = tid & 63, wr = wid >> 2, wc = wid & 3, fr = lane & 15, fq = lane >> 4;
    const int K = g.K, nt = K / BK, lda = g.lda;
    unsigned voffA[2], voffB[2];
#pragma unroll
    for (int i = 0; i < 2; ++i) { int R, C; stage_rc(tid * 16 + i * 8192, R, C); const int Rb = Epi::PERM ? ((R & ~31) + perm32(R & 31)) : R;
        voffA[i] = (unsigned)(R * lda + C) * 2u; voffB[i] = (unsigned)(Rb * K + C) * 2u; }
    const size_t kstep = (size_t)(BK * 2);
    const size_t hstepA = (size_t)HALF * lda * 2, hstepB = (size_t)HALF * K * 2;
    const size_t tstepA = 2 * hstepA, tstepB = 2 * hstepB;
    const unsigned ldsw = (unsigned)wid * 1024u;
    const int aoff = lds_byte(wr * 64 + fr, fq * 8), boff = lds_byte(wc * 32 + fr, fq * 8);
#define PG8_SA(b, h) (((b) * 2 + (h)) * HTB)
#define PG8_SB(b, h) ((4 + (b) * 2 + (h)) * HTB)
#define PG8_STAGE(bufoff, gbase, voff) do { _Pragma("unroll") for (int _i = 0; _i < 2; ++_i) \
        __builtin_amdgcn_global_load_lds((const unsigned*)((const char*)(gbase) + (voff)[_i]), (LAS unsigned*)(lds + (bufoff) + ldsw + _i * 8192), 16, 0, 0); } while (0)
#define PG8_LDA(dst, b, h) do { _Pragma("unroll") for (int m = 0; m < 4; ++m) _Pragma("unroll") for (int k = 0; k < 2; ++k) dst[m][k] = *(const LAS bf16x8*)(lds + PG8_SA(b, h) + aoff + m * 2048 + k * 1024); } while (0)
#define PG8_LDB(dst, b, h) do { _Pragma("unroll") for (int n = 0; n < 2; ++n) _Pragma("unroll") for (int k = 0; k < 2; ++k) dst[n][k] = *(const LAS bf16x8*)(lds + PG8_SB(b, h) + boff + n * 2048 + k * 1024); } while (0)
#define PG8_MMA(ai, bj, At, Bt) do { __builtin_amdgcn_s_setprio(1); _Pragma("unroll") for (int m = 0; m < 4; ++m) _Pragma("unroll") for (int n = 0; n < 2; ++n) _Pragma("unroll") for (int k = 0; k < 2; ++k) \
        acc[ai][bj][m][n] = __builtin_amdgcn_mfma_f32_16x16x32_bf16(Bt[n][k], At[m][k], acc[ai][bj][m][n], 0, 0, 0); __builtin_amdgcn_s_setprio(0); } while (0)
#define PG8_WAIT_V(n) asm volatile("s_waitcnt vmcnt(" #n ")" ::: "memory")
#define PG8_WAIT_L(n) asm volatile("s_waitcnt lgkmcnt(" #n ")" ::: "memory")
#define PG8_BAR __builtin_amdgcn_s_barrier()
#define PG8_SCHED __builtin_amdgcn_sched_barrier(0)
    Unit cur, nxt; int ui = 0;
    if (!S.next(0, cur)) return;
    f32x4 acc[2][2][4][2];
#pragma unroll
    for (int a = 0; a < 2; ++a)
#pragma unroll
        for (int b = 0; b < 2; ++b)
#pragma unroll
            for (int m = 0; m < 4; ++m)
#pragma unroll
                for (int n = 0; n < 2; ++n) acc[a][b][m][n] = (f32x4){0.f, 0.f, 0.f, 0.f};
    bf16x8 At[4][2], B0[2][2], B1[2][2];
    const char* cA = (const char*)g.A + (size_t)cur.pm * tstepA; const char* cB = (const char*)g.Bt + (size_t)cur.pn * tstepB;
    PG8_STAGE(PG8_SB(0, 0), cB, voffB); PG8_STAGE(PG8_SA(0, 0), cA, voffA); PG8_STAGE(PG8_SB(0, 1), cB + hstepB, voffB); PG8_STAGE(PG8_SA(0, 1), cA + hstepA, voffA);
    if (wr == 1) PG8_BAR;
    PG8_WAIT_V(4); PG8_BAR;
    PG8_STAGE(PG8_SB(1, 0), cB + kstep, voffB); PG8_STAGE(PG8_SA(1, 0), cA + kstep, voffA); PG8_STAGE(PG8_SB(1, 1), cB + hstepB + kstep, voffB);
    PG8_WAIT_V(6); PG8_BAR;
    for (;;) {
        const bool has_next = S.next(ui + 1, nxt);
        const char* nA = has_next ? (const char*)g.A + (size_t)nxt.pm * tstepA : cA; const char* nB = has_next ? (const char*)g.Bt + (size_t)nxt.pn * tstepB : cB;
        for (int t = 0; t < nt; t += 2) {
            const bool last = (t == nt - 2);
            const char* a1 = cA + (size_t)(t + 1) * kstep;
            const char* a2 = last ? nA : cA + (size_t)(t + 2) * kstep; const char* b2 = last ? nB : cB + (size_t)(t + 2) * kstep;
            const char* a3 = a2 + kstep; const char* b3 = b2 + kstep;
            PG8_LDB(B0, 0, 0); PG8_SCHED; PG8_LDA(At, 0, 0); PG8_STAGE(PG8_SA(1, 1), a1 + hstepA, voffA);
            PG8_WAIT_L(8); PG8_BAR; PG8_WAIT_L(0); PG8_MMA(0, 0, At, B0); PG8_BAR; PG8_SCHED;
            PG8_LDB(B1, 0, 1); PG8_STAGE(PG8_SB(0, 0), b2, voffB);
            PG8_BAR; PG8_WAIT_L(0); PG8_MMA(0, 1, At, B1); PG8_BAR;
            PG8_LDA(At, 0, 1); PG8_STAGE(PG8_SA(0, 0), a2, voffA);
            PG8_BAR; PG8_WAIT_L(0); PG8_MMA(1, 0, At, B0); PG8_BAR; PG8_SCHED;
            PG8_STAGE(PG8_SB(0, 1), b2 + hstepB, voffB);
            PG8_WAIT_V(6); PG8_BAR; PG8_MMA(1, 1, At, B1); PG8_BAR;
            PG8_LDB(B0, 1, 0); PG8_SCHED; PG8_LDA(At, 1, 0); PG8_STAGE(PG8_SA(0, 1), a2 + hstepA, voffA);
            PG8_WAIT_L(8); PG8_BAR; PG8_WAIT_L(0); PG8_MMA(0, 0, At, B0); PG8_BAR; PG8_SCHED;
            PG8_LDB(B1, 1, 1); PG8_STAGE(PG8_SB(1, 0), b3, voffB);
            PG8_BAR; PG8_WAIT_L(0); PG8_MMA(0, 1, At, B1); PG8_BAR;
            PG8_LDA(At, 1, 1); PG8_STAGE(PG8_SA(1, 0), a3, voffA);
            PG8_BAR; PG8_WAIT_L(0); PG8_MMA(1, 0, At, B0); PG8_BAR; PG8_SCHED;
            PG8_STAGE(PG8_SB(1, 1), b3 + hstepB, voffB);
            PG8_WAIT_V(6); PG8_BAR; PG8_MMA(1, 1, At, B1); PG8_BAR;
        }
        E(acc, cur, wr, wc, fr, fq);
        if (!has_next) break;
#pragma unroll
        for (int a = 0; a < 2; ++a)
#pragma unroll
            for (int b = 0; b < 2; ++b)
#pragma unroll
                for (int m = 0; m < 4; ++m)
#pragma unroll
                    for (int n = 0; n < 2; ++n) acc[a][b][m][n] = (f32x4){0.f, 0.f, 0.f, 0.f};
        cur = nxt; cA = nA; cB = nB; ++ui;
    }
    PG8_WAIT_V(0);
    if (wr == 0) PG8_BAR;
    PG8_BAR;
#undef PG8_SA
#undef PG8_SB
#undef PG8_STAGE
#undef PG8_LDA
#undef PG8_LDB
#undef PG8_MMA
#undef PG8_WAIT_V
#undef PG8_WAIT_L
#undef PG8_BAR
#undef PG8_SCHED
}

typedef float f32x2 __attribute__((ext_vector_type(2)));
__device__ __forceinline__ f32x2 gelu_pk(f32x2 v) {
    const f32x2 av = __builtin_elementwise_abs(v), d = av * 0.2316418882f + 1.0f;
    f32x2 t; t.x = __builtin_amdgcn_rcpf(d.x); t.y = __builtin_amdgcn_rcpf(d.y);
    f32x2 q = t * 0.5307027145f + (-0.7265760135f); q = q * t + 0.7107068705f; q = q * t + (-0.142248368f); q = q * t + 0.127414796f; q = q * t;
    const f32x2 s = (v * v) * (-0.72134752044f);
    f32x2 e; e.x = __builtin_amdgcn_exp2f(s.x); e.y = __builtin_amdgcn_exp2f(s.y);
    const f32x2 m = v * (q * e), r = v - m;
    f32x2 o; o.x = v.x < 0.f ? m.x : r.x; o.y = v.y < 0.f ? m.y : r.y; return o;
}
__device__ __forceinline__ f32x4 gelu4(f32x4 v) { f32x2 a = gelu_pk((f32x2){v[0], v[1]}), b = gelu_pk((f32x2){v[2], v[3]}); return (f32x4){a.x, a.y, b.x, b.y}; }

template <int ACT> struct EpiAct {
    static constexpr bool PERM = true;
    bf16_t* O; int ldc; const float* bias; int nb; const float* ssin; float* vss; int vcol0;
    __device__ __forceinline__ void operator()(const f32x4 (&acc)[2][2][4][2], const Unit& u, int wr, int wc, int fr, int fq) const {
        asm volatile("" : "+v"(fr), "+v"(fq));
        const int row0 = u.pm * BM + wr * 64 + fr, col0 = u.pn * BM + wc * 32 + 8 * fq;
        const int seq = seq_of_row(u.pm * BM);
        const float* bp = bias + (size_t)seq * nb + col0;
        f32x4 bv[2][2]; float rsv[2][4];
#pragma unroll
        for (int bj = 0; bj < 2; ++bj)
#pragma unroll
            for (int n = 0; n < 2; ++n) bv[bj][n] = *(const f32x4*)(bp + bj * HALF + 4 * n);
#pragma unroll
        for (int ai = 0; ai < 2; ++ai)
#pragma unroll
            for (int m = 0; m < 4; ++m) rsv[ai][m] = ssin[row0 + ai * HALF + m * 16];
#pragma unroll
        for (int ai = 0; ai < 2; ++ai)
#pragma unroll
            for (int m = 0; m < 4; ++m) rsv[ai][m] = __builtin_amdgcn_rsqf(rsv[ai][m] * (1.0f / DM) + EPSN);
        const bool dov = (ACT == 1) && (u.pn * BM >= vcol0);
#pragma unroll
        for (int ai = 0; ai < 2; ++ai)
#pragma unroll
            for (int m = 0; m < 4; ++m) {
                const int r = row0 + ai * HALF + m * 16;
                const float rs = rsv[ai][m];
                bf16_t* rowp = O + (size_t)r * ldc + col0; float s = 0.f;
#pragma unroll
                for (int bj = 0; bj < 2; ++bj) { f32x4 v0 = acc[ai][bj][m][0] * rs + bv[bj][0], v1 = acc[ai][bj][m][1] * rs + bv[bj][1];
                    if (ACT == 1) { v0 = gelu4(v0); v1 = gelu4(v1); s += (v0[0] * v0[0] + v0[1] * v0[1]) + (v0[2] * v0[2] + v0[3] * v0[3]) + (v1[0] * v1[0] + v1[1] * v1[1]) + (v1[2] * v1[2] + v1[3] * v1[3]); }
                    u32x4 w; w.x = cvt_pk_bf16_asm(v0[0], v0[1]); w.y = cvt_pk_bf16_asm(v0[2], v0[3]); w.z = cvt_pk_bf16_asm(v1[0], v1[1]); w.w = cvt_pk_bf16_asm(v1[2], v1[3]);
                    *(u32x4*)(rowp + bj * HALF) = w; }
                if (ACT == 1) { s += __shfl_xor(s, 16); s += __shfl_xor(s, 32); if (dov && fq == 0) (void)__hip_atomic_fetch_add(vss + r, s, __ATOMIC_RELAXED, __HIP_MEMORY_SCOPE_AGENT); }
            }
    }
};

struct EpiRes {
    static constexpr bool PERM = false;
    const float* base0; const float* base1; float* xout; const float* gate; const float* gs; bf16_t* xb; float* ssn;
    __device__ __forceinline__ void operator()(const f32x4 (&acc)[2][2][4][2], const Unit& u, int wr, int wc, int fr, int fq) const {
        asm volatile("" : "+v"(fr), "+v"(fq));
        const int row0 = u.pm * BM + wr * 64 + fr, col0 = u.pn * BM + wc * 32 + 4 * fq;
        const int seq = seq_of_row(u.pm * BM);
        const float* gp = gate + (size_t)seq * MODW + col0; const float* gsp = gs + (size_t)seq * DM + col0;
        f32x4 gv[2][2], gsv[2][2];
#pragma unroll
        for (int bj = 0; bj < 2; ++bj)
#pragma unroll
            for (int n = 0; n < 2; ++n) { gv[bj][n] = *(const f32x4*)(gp + bj * HALF + n * 16); gsv[bj][n] = *(const f32x4*)(gsp + bj * HALF + n * 16); }
        const float* bbase = (u.pm * BM < 16384 ? base0 + (size_t)row0 * DM : base1 + (size_t)(row0 - 16384) * DM) + col0;
        f32x4 xr[3][2][2];
#pragma unroll
        for (int g0 = 0; g0 < 2; ++g0) { const float* bp = bbase + (size_t)((g0 >> 2) * HALF + (g0 & 3) * 16) * DM;
#pragma unroll
            for (int bj = 0; bj < 2; ++bj)
#pragma unroll
                for (int n = 0; n < 2; ++n) xr[g0][bj][n] = *(const f32x4*)(bp + bj * HALF + n * 16); }
#pragma unroll
        for (int g8 = 0; g8 < 8; ++g8) { const int ai = g8 >> 2, m = g8 & 3;
            if (g8 < 6) { const int gn = g8 + 2; const float* bp = bbase + (size_t)((gn >> 2) * HALF + (gn & 3) * 16) * DM;
#pragma unroll
                for (int bj = 0; bj < 2; ++bj)
#pragma unroll
                    for (int n = 0; n < 2; ++n) xr[gn % 3][bj][n] = *(const f32x4*)(bp + bj * HALF + n * 16); }
            const int r = row0 + ai * HALF + m * 16;
            float* op = xout + (size_t)r * DM + col0; float s = 0.f;
#pragma unroll
            for (int bj = 0; bj < 2; ++bj)
#pragma unroll
                for (int n = 0; n < 2; ++n) { const f32x4 xn = xr[g8 % 3][bj][n] + gv[bj][n] * acc[ai][bj][m][n];
                    *(f32x4*)(op + bj * HALF + n * 16) = xn; s += (xn[0] * xn[0] + xn[1] * xn[1]) + (xn[2] * xn[2] + xn[3] * xn[3]);
                    if (xb) { const f32x4 h = xn * gsv[bj][n]; u32x2 w; w.x = cvt_pk_bf16_asm(h[0], h[1]); w.y = cvt_pk_bf16_asm(h[2], h[3]);
                        *(u32x2*)(xb + (size_t)r * DM + col0 + bj * HALF + n * 16) = w; } }
            s += __shfl_xor(s, 16); s += __shfl_xor(s, 32); if (fq == 0) (void)__hip_atomic_fetch_add(ssn + r, s, __ATOMIC_RELAXED, __HIP_MEMORY_SCOPE_AGENT);
        }
    }
};

struct EpiUp {
    static constexpr bool PERM = true;
    bf16_t* act; const float* bias; const float* cw; const float* ssin; float* edge;
    __device__ __forceinline__ void operator()(const f32x4 (&acc)[2][2][4][2], const Unit& u, int wr, int wc, int fr, int fq) const {
        asm volatile("" : "+v"(fr), "+v"(fq));
        const int row0 = u.pm * BM + wr * 64 + fr, colt = u.pn * BM + wc * 32 + 8 * fq;
        const int seq = seq_of_row(u.pm * BM);
        const float* biasp = bias + (size_t)seq * NUP + colt; const float* cwp = cw + colt;
        float rs[2][4];
#pragma unroll
        for (int ai = 0; ai < 2; ++ai)
#pragma unroll
            for (int m = 0; m < 4; ++m) rs[ai][m] = ssin[row0 + ai * HALF + m * 16];
#pragma unroll
        for (int ai = 0; ai < 2; ++ai)
#pragma unroll
            for (int m = 0; m < 4; ++m) rs[ai][m] = __builtin_amdgcn_rsqf(rs[ai][m] * (1.0f / DM) + EPSN);
        u32x2 keep[2][4];
#pragma unroll
        for (int n = 0; n < 2; ++n) {
            f32x4 prm[2][5];
#pragma unroll
            for (int bj = 0; bj < 2; ++bj) { const int co = bj * HALF + 4 * n;
                prm[bj][0] = *(const f32x4*)(biasp + co); prm[bj][1] = *(const f32x4*)(cwp + co); prm[bj][2] = *(const f32x4*)(cwp + NUP + co); prm[bj][3] = *(const f32x4*)(cwp + 2 * NUP + co); prm[bj][4] = *(const f32x4*)(cwp + 3 * NUP + co); }
#pragma unroll
            for (int ai = 0; ai < 2; ++ai) {
                float* ep = edge + (size_t)(u.pm * 4 + ai * 2 + wr) * 4 * NUP + colt;
                f32x4 SG[4];
#pragma unroll
                for (int bjr = 0; bjr < 2; ++bjr) { const int bj = 1 - bjr; const int co = bj * HALF + 4 * n;
                    f32x4 U[4];
#pragma unroll
                    for (int m = 0; m < 4; ++m) U[m] = acc[ai][bj][m][n] * rs[ai][m] + prm[bj][0];
                    if (fr < 2) *(f32x4*)(ep + (size_t)fr * NUP + co) = U[0];
                    if (fr >= 14) *(f32x4*)(ep + (size_t)(fr - 12) * NUP + co) = U[3];
#pragma unroll
                    for (int m = 0; m < 4; ++m) { const f32x4 sp = (fr == 15 && m > 0) ? U[m > 0 ? m - 1 : 0] : U[m]; const f32x4 sn = (fr == 0 && m < 3) ? U[m < 3 ? m + 1 : 3] : U[m];
                        f32x4 pv, nv;
#pragma unroll
                        for (int j = 0; j < 4; ++j) { pv[j] = __int_as_float(__builtin_amdgcn_update_dpp(0, __float_as_int(sp[j]), 0x121, 0xf, 0xf, false)); nv[j] = __int_as_float(__builtin_amdgcn_update_dpp(0, __float_as_int(sn[j]), 0x12F, 0xf, 0xf, false)); }
                        const f32x4 R = prm[bj][1] * pv + prm[bj][2] * U[m] + prm[bj][3] * nv + prm[bj][4];
                        if (bj == 1) {
#pragma unroll
                            for (int j = 0; j < 4; ++j) SG[m][j] = R[j] * __builtin_amdgcn_rcpf(1.0f + __expf(-R[j])); }
                        else { const int r = row0 + ai * HALF + m * 16; const bool skip = (m == 0 && fr == 0) || (m == 3 && fr == 15);
                            const f32x4 o = R * SG[m]; u32x2 w; w.x = cvt_pk_bf16_asm(o[0], o[1]); w.y = cvt_pk_bf16_asm(o[2], o[3]);
                            if (n == 0) keep[ai][m] = w;
                            else { u32x4 w4; w4.x = keep[ai][m].x; w4.y = keep[ai][m].y; w4.z = w.x; w4.w = w.y; if (!skip) *(u32x4*)(act + (size_t)r * FFD + u.pn * 128 + wc * 32 + 8 * fq) = w4; } } } } }
        }
    }
};
}

__device__ __forceinline__ float silu_f(float x) { return x / (1.0f + __expf(-x)); }

__device__ void mod_task(int wv, const Params& p, int tk, float* ldsf) {
    const int tid = otid(wv), i = tk / 48, cgp = tk % 48;
    float* csL = ldsf; float* red = ldsf + 3072;
    for (int idx = tid; idx < 3072; idx += NTHR) { const int seq = idx >> 10, k = idx & 1023; const float c = seq < 2 ? p.cp[seq * DM + k] : p.csm[k]; csL[idx] = silu_f(c); }
    __syncthreads();
    const int quad = tid & 31, ksl = tid >> 5;
    const float* W = p.w_ada + (size_t)i * DM * MODW + (size_t)ksl * 64 * MODW + 128 * cgp + 4 * quad;
    f32x4 a0 = {0, 0, 0, 0}, a1 = {0, 0, 0, 0}, a2 = {0, 0, 0, 0};
#pragma unroll 8
    for (int kk = 0; kk < 64; ++kk) { const f32x4 w = *(const f32x4*)(W + (size_t)kk * MODW); const int k = ksl * 64 + kk;
        a0 += w * csL[k]; a1 += w * csL[1024 + k]; a2 += w * csL[2048 + k]; }
    float* rp = red + (ksl * 32 + quad) * 12;
    *(f32x4*)(rp) = a0; *(f32x4*)(rp + 4) = a1; *(f32x4*)(rp + 8) = a2;
    __syncthreads();
    if (tid < 384) { const int q = tid & 31, e = tid >> 5; float s = 0.f;
        for (int k = 0; k < 16; ++k) s += red[(k * 32 + q) * 12 + e];
        const int seq = e >> 2, col = 128 * cgp + 4 * q + (e & 3);
        float* mod = (float*)(p.ws + WS_MOD);
        mod[((size_t)i * 3 + seq) * MODW + col] = s + p.b_ada[i * MODW + col]; }
    __syncthreads();
}

__device__ void wf_task(int wv, const Params& p, int task, float* ldsf) {
    const int tid = otid(wv), g = task >> 4, n0 = (task & 15) * 64;
    float* tile = ldsf; float* ct = ldsf + 128 * 64;
    for (int idx = tid; idx < 128 * 16; idx += NTHR) { const int cp_ = idx >> 4, n4 = (idx & 15) * 4;
        *(f32x4*)(tile + cp_ * 64 + n4) = *(const f32x4*)(p.c_w_out + (size_t)(g * 128 + cp_) * DM + n0 + n4); }
    if (tid < 128) ct[tid] = cospif(2.0f * tid / 128.0f) * 0.08838834764831845f;
    __syncthreads();
    const int n = tid & 63, wvl = __builtin_amdgcn_readfirstlane(tid >> 6);
    float ac[16], as[16];
#pragma unroll
    for (int c = 0; c < 16; ++c) { ac[c] = 0.f; as[c] = 0.f; }
    for (int cq = 0; cq < 128; ++cq) { const float v = tile[cq * 64 + n];
#pragma unroll
        for (int cc = 0; cc < 16; ++cc) { const int idx = ((wvl * 16 + cc) * cq) & 127; ac[cc] += ct[idx] * v; as[cc] += ct[(idx + 96) & 127] * v; } }
    float* Wf = (float*)(p.ws + WS_WF32);
#pragma unroll
    for (int cc = 0; cc < 16; ++cc) { const int c = wvl * 16 + cc; Wf[(size_t)(g * 128 + c) * DM + n0 + n] = ac[cc]; Wf[(size_t)(1024 + g * 128 + c) * DM + n0 + n] = as[cc]; }
    __syncthreads();
}

__device__ void convert_matrix(int wv, const float* src, int K, int N, int ld, int perm, bf16_t* dst, float* tileL, int rot) {
    const int tid = otid(wv), G = gridDim.x, ntk = K >> 6, ntiles = ntk * (N >> 8);
    for (int t = (blockIdx.x + G - (rot % G)) % G; t < ntiles; t += G) {
        const int k0 = (t % ntk) * 64, n0 = (t / ntk) * 256;
        f32x4 v[8];
#pragma unroll
        for (int ps = 0; ps < 8; ++ps) { const int idx = tid + ps * NTHR, kk = idx >> 6, n4 = (idx & 63) * 4; const int sc = perm ? upcol(n0 + n4) : n0 + n4;
            v[ps] = *(const f32x4*)(src + (size_t)(k0 + kk) * ld + sc); }
#pragma unroll
        for (int ps = 0; ps < 8; ++ps) { const int idx = tid + ps * NTHR, kk = idx >> 6, n4 = (idx & 63) * 4;
            float* tp = tileL + kk * 257 + n4; tp[0] = v[ps][0]; tp[1] = v[ps][1]; tp[2] = v[ps][2]; tp[3] = v[ps][3]; }
        __syncthreads();
        { const int n = tid >> 1, kh = (tid & 1) * 32;
#pragma unroll
            for (int q = 0; q < 4; ++q) { float e[8];
#pragma unroll
                for (int j = 0; j < 8; ++j) e[j] = tileL[(kh + 8 * q + j) * 257 + n];
                u32x4 w; w.x = cvt_pk_bf16(e[0], e[1]); w.y = cvt_pk_bf16(e[2], e[3]); w.z = cvt_pk_bf16(e[4], e[5]); w.w = cvt_pk_bf16(e[6], e[7]);
                *(u32x4*)(dst + (size_t)(n0 + n) * K + k0 + kh + 8 * q) = w; } }
        __syncthreads();
    }
}

__device__ void bias_task(int wv, const float* W, int ld, int perm, const float* sh, float* bias, int nb, int grp, float* red) {
    const int tid = otid(wv), quad = tid & 63, ksl = __builtin_amdgcn_readfirstlane(tid >> 6);
    const int nn = 256 * grp + 4 * quad, sc = perm ? upcol(nn) : nn;
    f32x4 a0 = {0, 0, 0, 0}, a1 = {0, 0, 0, 0}, a2 = {0, 0, 0, 0};
    const float* wp = W + (size_t)ksl * 128 * ld + sc; const float* s0 = sh + ksl * 128;
#pragma unroll 16
    for (int kk = 0; kk < 128; ++kk) { const f32x4 w = *(const f32x4*)(wp + (size_t)kk * ld); a0 += w * s0[kk]; a1 += w * s0[MODW + kk]; a2 += w * s0[2 * MODW + kk]; }
    float* rp = red + (ksl * 64 + quad) * 12;
    *(f32x4*)(rp) = a0; *(f32x4*)(rp + 4) = a1; *(f32x4*)(rp + 8) = a2;
    __syncthreads();
    for (int idx = tid; idx < 768; idx += NTHR) { const int q = idx & 63, e = idx >> 6; float s = 0.f;
        for (int k = 0; k < 8; ++k) s += red[(k * 64 + q) * 12 + e];
        bias[(size_t)(e >> 2) * nb + 256 * grp + 4 * q + (e & 3)] = s; }
    __syncthreads();
}

__device__ __forceinline__ f32x4 mfma16(bf16x8 a, bf16x8 b, f32x4 c) { return __builtin_amdgcn_mfma_f32_16x16x32_bf16(a, b, c, 0, 0, 0); }

__device__ void sg_phase(int wv, const Params& p, int jl, unsigned char* lds) {
    const int tid = otid(wv), lane = tid & 63, w = __builtin_amdgcn_readfirstlane(tid >> 6), lr = lane & 15, lq = lane >> 4;
    bf16_t* uv = (bf16_t*)(p.ws + WS_BIG1);
    const float* vss = (const float*)(p.ws + WS_SS) + (size_t)(9 + jl) * MTOK;
    constexpr int PW = 136;
    bf16_t* WsL = (bf16_t*)lds; bf16_t* VTL = WsL + 128 * PW; float* rsL = (float*)(VTL + 128 * PW);
    for (int unit = blockIdx.x; unit < 2048; unit += gridDim.x) {
        const int ch = unit >> 3, g = unit & 7, t0 = ch * 128;
        if (tid < 128) rsL[tid] = 1.0f / sqrtf(vss[t0 + tid] * (1.0f / DM) + EPSN);
        __syncthreads();
        const float* ws = p.a_w_s + ((size_t)jl * 8 + g) * 128 * 128;
#pragma unroll
        for (int ps = 0; ps < 8; ++ps) { const int idx = tid + ps * NTHR, t = idx >> 5, s4 = (idx & 31) * 4;
            const f32x4 wv = *(const f32x4*)(ws + t * 128 + s4); const f32x4 r4 = *(const f32x4*)(rsL + s4); const f32x4 x = wv * r4;
            u32x2 pk; pk.x = cvt_pk_bf16(x[0], x[1]); pk.y = cvt_pk_bf16(x[2], x[3]); *(u32x2*)(WsL + t * PW + s4) = pk; }
#pragma unroll
        for (int ps = 0; ps < 4; ++ps) { const int idx = tid + ps * NTHR, s = idx & 127, d8 = (idx >> 7) * 8;
            const bf16x8 v = *(const bf16x8*)(uv + (size_t)(t0 + s) * 2048 + 1024 + g * 128 + d8);
#pragma unroll
            for (int e = 0; e < 8; ++e) VTL[(d8 + e) * PW + s] = (bf16_t)v[e]; }
        __syncthreads();
        bf16x8 af[4];
#pragma unroll
        for (int kk = 0; kk < 4; ++kk) af[kk] = *(const bf16x8*)(WsL + (16 * w + lr) * PW + 32 * kk + 8 * lq);
        const int tok = t0 + 16 * w + lr; const float bs = p.a_b_s[((size_t)jl * 8 + g) * 128 + 16 * w + lr];
#pragma unroll
        for (int db = 0; db < 8; ++db) { f32x4 acc = {0, 0, 0, 0};
#pragma unroll
            for (int kk = 0; kk < 4; ++kk) { const bf16x8 bf = *(const bf16x8*)(VTL + (16 * db + lr) * PW + 32 * kk + 8 * lq); acc = mfma16(bf, af[kk], acc); }
            const int col = g * 128 + 16 * db + 4 * lq; const f32x4 gv = *(const f32x4*)(p.a_g_v + jl * DM + col);
            bf16_t* up = uv + (size_t)tok * 2048 + col; const u32x2 uu = *(const u32x2*)up;
            const float u0 = __uint_as_float(uu.x << 16), u1 = __uint_as_float(uu.x & 0xffff0000u), u2 = __uint_as_float(uu.y << 16), u3 = __uint_as_float(uu.y & 0xffff0000u);
            const f32x4 sv = acc * gv + bs; u32x2 o; o.x = cvt_pk_bf16(u0 * sv[0], u1 * sv[1]); o.y = cvt_pk_bf16(u2 * sv[2], u3 * sv[3]);
            *(u32x2*)up = o; }
        __syncthreads();
    }
}

__device__ void att_phase(int wv, const Params& p, unsigned char* lds) {
    const int tid = otid(wv), lane = tid & 63, w = __builtin_amdgcn_readfirstlane(tid >> 6), lr = lane & 15, lq = lane >> 4;
    bf16_t* qkv = (bf16_t*)(p.ws + WS_BIG1);
    constexpr int KP = 72, VP = 392;
    bf16_t* KL = (bf16_t*)lds; bf16_t* VTL = KL + 384 * KP;
    for (int unit = blockIdx.x; unit < 1024; unit += gridDim.x) {
        const int B = unit >> 2, kh = unit & 3;
        const int sb = B < 64 ? 0 : (B < 128 ? 64 : 128), se = B < 64 ? 64 : (B < 128 ? 128 : 256);
#pragma unroll
        for (int ps = 0; ps < 6; ++ps) { const int idx = tid + ps * NTHR, s = idx >> 3, c8 = (idx & 7) * 8; const int kb = B - 1 + (s >> 7);
            bf16x8 kv = {0, 0, 0, 0, 0, 0, 0, 0}, vv = {0, 0, 0, 0, 0, 0, 0, 0};
            if (kb >= sb && kb < se) { const bf16_t* rp = qkv + (size_t)(kb * 128 + (s & 127)) * 1536 + 64 * kh + c8; kv = *(const bf16x8*)(rp + 1024); vv = *(const bf16x8*)(rp + 1280); }
            *(bf16x8*)(KL + s * KP + c8) = kv;
#pragma unroll
            for (int e = 0; e < 8; ++e) VTL[(c8 + e) * VP + s] = (bf16_t)vv[e]; }
        __syncthreads();
        const int gq = w >> 1, h = 4 * kh + gq;
        const float slope = exp2f(-0.5f * (float)(h + 1)), sink = p.b_sinks[h];
        for (int rb = 0; rb < 4; ++rb) {
            const int qrow = 64 * (w & 1) + 16 * rb + lr;
            const size_t tokq = (size_t)B * 128 + qrow;
            bf16x8 qf[2];
#pragma unroll
            for (int kk = 0; kk < 2; ++kk) qf[kk] = *(const bf16x8*)(qkv + tokq * 1536 + 64 * h + 32 * kk + 8 * lq);
            f32x4 sc[24];
#pragma unroll
            for (int cb = 0; cb < 24; ++cb) { f32x4 a = {0, 0, 0, 0};
#pragma unroll
                for (int kk = 0; kk < 2; ++kk) { const bf16x8 kf = *(const bf16x8*)(KL + (16 * cb + lr) * KP + 32 * kk + 8 * lq); a = mfma16(kf, qf[kk], a); }
                sc[cb] = a; }
            float mx = sink;
#pragma unroll
            for (int cb = 0; cb < 24; ++cb) { const int kb = B - 1 + (cb >> 3); const bool bval = (kb >= sb && kb < se);
#pragma unroll
                for (int j = 0; j < 4; ++j) { const int krel = 16 * cb + 4 * lq + j - 128;
                    int dist = qrow - krel; dist = dist < 0 ? -dist : dist;
                    const float v = (bval && dist <= 128) ? sc[cb][j] * 0.125f - slope * (float)dist : -1e30f;
                    sc[cb][j] = v; mx = fmaxf(mx, v); } }
            mx = fmaxf(mx, __shfl_xor(mx, 16)); mx = fmaxf(mx, __shfl_xor(mx, 32));
            float sum = 0.f;
#pragma unroll
            for (int cb = 0; cb < 24; ++cb)
#pragma unroll
                for (int j = 0; j < 4; ++j) { const float e = __expf(sc[cb][j] - mx); sc[cb][j] = e; sum += e; }
            sum += __shfl_xor(sum, 16); sum += __shfl_xor(sum, 32);
            sum += __expf(sink - mx);
            const float inv = 1.0f / sum;
            f32x4 oa[4];
#pragma unroll
            for (int db = 0; db < 4; ++db) oa[db] = (f32x4){0, 0, 0, 0};
#pragma unroll
            for (int ks = 0; ks < 12; ++ks) {
                union { bf16x8 v; unsigned u[4]; } pf;
                pf.u[0] = cvt_pk_bf16_asm(sc[2 * ks][0], sc[2 * ks][1]); pf.u[1] = cvt_pk_bf16_asm(sc[2 * ks][2], sc[2 * ks][3]);
                pf.u[2] = cvt_pk_bf16_asm(sc[2 * ks + 1][0], sc[2 * ks + 1][1]); pf.u[3] = cvt_pk_bf16_asm(sc[2 * ks + 1][2], sc[2 * ks + 1][3]);
#pragma unroll
                for (int db = 0; db < 4; ++db) {
                    union { bf16x8 v; u32x2 h2[2]; } vf;
                    const bf16_t* vp = VTL + (16 * db + lr) * VP + 32 * ks + 4 * lq;
                    vf.h2[0] = *(const u32x2*)vp; vf.h2[1] = *(const u32x2*)(vp + 16);
                    oa[db] = mfma16(vf.v, pf.v, oa[db]); } }
#pragma unroll
            for (int db = 0; db < 4; ++db) { const f32x4 o = oa[db] * inv; u32x2 wv; wv.x = cvt_pk_bf16_asm(o[0], o[1]); wv.y = cvt_pk_bf16_asm(o[2], o[3]);
                *(u32x2*)(qkv + tokq * 1536 + 64 * h + 16 * db + 4 * lq) = wv; }
        }
        __syncthreads();
    }
}

template <int N1> __device__ void fft1_units(int wv, const Params& p, unsigned char* lds, int seq_lo, int nseq, int part, int nparts) {
    const int tid = otid(wv), lane = tid & 63, w = __builtin_amdgcn_readfirstlane(tid >> 6), lr = lane & 15, lq = lane >> 4;
    constexpr int PW = N1 + 8, NB = N1 / 16, NK = N1 / 32; constexpr int S = N1 * 128;
    const bf16_t* z = (const bf16_t*)(p.ws + WS_BIG1); bf16_t* A1 = (bf16_t*)(p.ws + WS_BIG2);
    const bf16_t* ctg = (const bf16_t*)(p.ws + WS_TAB + (N1 == 64 ? TAB_CT64 : TAB_CT128)); const bf16_t* stg = (const bf16_t*)(p.ws + WS_TAB + (N1 == 64 ? TAB_ST64 : TAB_ST128));
    bf16_t* CT = (bf16_t*)lds; bf16_t* ST = CT + N1 * PW; bf16_t* XT = ST + N1 * PW;
    for (int idx = tid; idx < N1 * N1 / 8; idx += NTHR) { const int r = idx / (N1 / 8), c8 = (idx % (N1 / 8)) * 8;
        *(bf16x8*)(CT + r * PW + c8) = *(const bf16x8*)(ctg + r * N1 + c8); *(bf16x8*)(ST + r * PW + c8) = *(const bf16x8*)(stg + r * N1 + c8); }
    __syncthreads();
    const int nunits = nseq * 128 * 8;
    for (int unit = part; unit < nunits; unit += nparts) {
        const int sq = unit / 1024, b = (unit >> 3) & 127, cb = unit & 7;
        const int seq = seq_lo + sq; const size_t sbase = (size_t)seq * 8192;
        for (int idx = tid; idx < N1 * 16; idx += NTHR) { const int a = idx % N1, c8 = (idx / N1) * 8;
            const bf16x8 v = *(const bf16x8*)(z + (sbase + 128 * a + b) * DM + cb * 128 + c8);
#pragma unroll
            for (int e = 0; e < 8; ++e) XT[(c8 + e) * PW + a] = (bf16_t)v[e]; }
        __syncthreads();
        bf16x8 xf[NK];
#pragma unroll
        for (int kk = 0; kk < NK; ++kk) xf[kk] = *(const bf16x8*)(XT + (16 * w + lr) * PW + 32 * kk + 8 * lq);
#pragma unroll
        for (int i = 0; i < NB; ++i) { f32x4 ar = {0, 0, 0, 0}, as = {0, 0, 0, 0};
#pragma unroll
            for (int kk = 0; kk < NK; ++kk) { const bf16x8 cf = *(const bf16x8*)(CT + (16 * i + lr) * PW + 32 * kk + 8 * lq), sf = *(const bf16x8*)(ST + (16 * i + lr) * PW + 32 * kk + 8 * lq);
                ar = mfma16(xf[kk], cf, ar); as = mfma16(xf[kk], sf, as); }
            const int ka = 16 * i + lr; float tc, ts; sincospif(2.0f * (float)(b * ka) / (float)S, &ts, &tc);
            const f32x4 re = ar * tc - as * ts, im = -(as * tc) - ar * ts;
            bf16_t* op = A1 + (sbase + (size_t)ka * 128 + b) * 2048 + cb * 128 + 16 * w + 4 * lq;
            u32x2 o; o.x = cvt_pk_bf16(re[0], re[1]); o.y = cvt_pk_bf16(re[2], re[3]); *(u32x2*)op = o;
            o.x = cvt_pk_bf16(im[0], im[1]); o.y = cvt_pk_bf16(im[2], im[3]); *(u32x2*)(op + 1024) = o; }
        __syncthreads();
    }
}
__device__ void fft2_phase(int wv, const Params& p, unsigned char* lds) {
    const int tid = otid(wv), lane = tid & 63, w = __builtin_amdgcn_readfirstlane(tid >> 6), lr = lane & 15, lq = lane >> 4;
    constexpr int PW = 136;
    const bf16_t* A1 = (const bf16_t*)(p.ws + WS_BIG2); bf16_t* Y = (bf16_t*)(p.ws + WS_BIG1);
    const bf16_t* ctg = (const bf16_t*)(p.ws + WS_TAB + TAB_CT128); const bf16_t* stg = (const bf16_t*)(p.ws + WS_TAB + TAB_ST128);
    bf16_t* CT = (bf16_t*)lds; bf16_t* ST = CT + 128 * PW; bf16_t* XR = ST + 128 * PW; bf16_t* XI = XR + 128 * PW;
    for (int idx = tid; idx < 128 * 16; idx += NTHR) { const int r = idx >> 4, c8 = (idx & 15) * 8;
        *(bf16x8*)(CT + r * PW + c8) = *(const bf16x8*)(ctg + r * 128 + c8); *(bf16x8*)(ST + r * PW + c8) = *(const bf16x8*)(stg + r * 128 + c8); }
    __syncthreads();
    for (int unit = blockIdx.x; unit < 2048; unit += gridDim.x) {
        const int gi = unit >> 3, cb = unit & 7;
        const int seq = gi < 64 ? 0 : (gi < 128 ? 1 : 2); const int ka = gi - (seq == 0 ? 0 : (seq == 1 ? 64 : 128)); const int N1 = seq == 2 ? 128 : 64;
        const size_t sbase = (size_t)seq * 8192;
#pragma unroll
        for (int ps = 0; ps < 4; ++ps) { const int idx = tid + ps * NTHR, b = idx & 127, c8 = (idx >> 7) * 8;
            const bf16_t* rp = A1 + ((size_t)gi * 128 + b) * 2048 + cb * 128 + c8; const bf16x8 vr = *(const bf16x8*)rp, vi = *(const bf16x8*)(rp + 1024);
#pragma unroll
            for (int e = 0; e < 8; ++e) { XR[(c8 + e) * PW + b] = (bf16_t)vr[e]; XI[(c8 + e) * PW + b] = (bf16_t)vi[e]; } }
        __syncthreads();
        bf16x8 xr[4], xi[4], nxr[4];
#pragma unroll
        for (int kk = 0; kk < 4; ++kk) { xr[kk] = *(const bf16x8*)(XR + (16 * w + lr) * PW + 32 * kk + 8 * lq); xi[kk] = *(const bf16x8*)(XI + (16 * w + lr) * PW + 32 * kk + 8 * lq);
            union { bf16x8 v; unsigned u[4]; } t; t.v = xr[kk]; t.u[0] ^= 0x80008000u; t.u[1] ^= 0x80008000u; t.u[2] ^= 0x80008000u; t.u[3] ^= 0x80008000u; nxr[kk] = t.v; }
#pragma unroll
        for (int i = 0; i < 8; ++i) { f32x4 re = {0, 0, 0, 0}, im = {0, 0, 0, 0};
#pragma unroll
            for (int kk = 0; kk < 4; ++kk) { const bf16x8 cf = *(const bf16x8*)(CT + (16 * i + lr) * PW + 32 * kk + 8 * lq), sf = *(const bf16x8*)(ST + (16 * i + lr) * PW + 32 * kk + 8 * lq);
                re = mfma16(xr[kk], cf, re); re = mfma16(xi[kk], sf, re); im = mfma16(xi[kk], cf, im); im = mfma16(nxr[kk], sf, im); }
            const int kb = 16 * i + lr;
            bf16_t* op = Y + (sbase + (size_t)N1 * kb + ka) * 2048 + cb * 128 + 16 * w + 4 * lq;
            u32x2 o; o.x = cvt_pk_bf16(re[0], re[1]); o.y = cvt_pk_bf16(re[2], re[3]); *(u32x2*)op = o;
            o.x = cvt_pk_bf16(im[0], im[1]); o.y = cvt_pk_bf16(im[2], im[3]); *(u32x2*)(op + 1024) = o; }
        __syncthreads();
    }
}

__device__ void fix_phase(int wv, const Params& p, int li) {
    const float* edge = (const float*)(p.ws + WS_EDGE); const float* cw = (const float*)(p.ws + WS_CW) + (size_t)li * 4 * NUP; bf16_t* act = (bf16_t*)(p.ws + WS_ACT);
    const int total = 1024 * (FFD / 4);
    const int tid = otid(wv);
    for (int idx = blockIdx.x * NTHR + tid; idx < total; idx += gridDim.x * NTHR) {
        const int e = idx / (FFD / 4), c = (idx % (FFD / 4)) * 4; const int band = e >> 1, hi = e & 1; const int R = band * 64 + (hi ? 63 : 0);
        const int ca = (c >> 7) * 256 + (c & 127), cg_ = ca + 128;
        const bool seqstart = (R == 0 || R == 8192 || R == 16384), seqend = (R == 8191 || R == 16383 || R == 32767);
        const float* ep = edge + (size_t)band * 4 * NUP;
        f32x4 pa, pg, ua, ug, na, ng; const f32x4 zero = {0, 0, 0, 0};
        if (!hi) { pa = seqstart ? zero : *(const f32x4*)(ep - NUP + ca); pg = seqstart ? zero : *(const f32x4*)(ep - NUP + cg_);
            ua = *(const f32x4*)(ep + ca); ug = *(const f32x4*)(ep + cg_); na = *(const f32x4*)(ep + NUP + ca); ng = *(const f32x4*)(ep + NUP + cg_); }
        else { pa = *(const f32x4*)(ep + 2 * NUP + ca); pg = *(const f32x4*)(ep + 2 * NUP + cg_); ua = *(const f32x4*)(ep + 3 * NUP + ca); ug = *(const f32x4*)(ep + 3 * NUP + cg_);
            na = seqend ? zero : *(const f32x4*)(ep + 4 * NUP + ca); ng = seqend ? zero : *(const f32x4*)(ep + 4 * NUP + cg_); }
        const f32x4 a = *(const f32x4*)(cw + ca) * pa + *(const f32x4*)(cw + NUP + ca) * ua + *(const f32x4*)(cw + 2 * NUP + ca) * na + *(const f32x4*)(cw + 3 * NUP + ca);
        const f32x4 g = *(const f32x4*)(cw + cg_) * pg + *(const f32x4*)(cw + NUP + cg_) * ug + *(const f32x4*)(cw + 2 * NUP + cg_) * ng + *(const f32x4*)(cw + 3 * NUP + cg_);
        float o[4];
#pragma unroll
        for (int j = 0; j < 4; ++j) o[j] = a[j] * g[j] / (1.0f + __expf(-g[j]));
        u32x2 wv; wv.x = cvt_pk_bf16(o[0], o[1]); wv.y = cvt_pk_bf16(o[2], o[3]);
        *(u32x2*)(act + (size_t)R * FFD + c) = wv;
    }
}

#define XB_TMO      128
#define XB_XCNT(j)  (256  + 64 * (j))
#define XB_XSUB(j)  (1280 + 64 * (j))
#define XB_XGEN(j)  (2304 + 64 * (j))
#define XB_TOP      3328
#define XB_TOPGEN   3392
#define XCD_BAR_WORDS 3456
#define XB_SPIN_CAP (1u << 18)
__device__ __forceinline__ unsigned xb_ld(unsigned* p)              { return __hip_atomic_load(p, __ATOMIC_RELAXED, __HIP_MEMORY_SCOPE_AGENT); }
__device__ __forceinline__ unsigned xb_add(unsigned* p, unsigned v) { return __hip_atomic_fetch_add(p, v, __ATOMIC_RELAXED, __HIP_MEMORY_SCOPE_AGENT); }
__device__ __forceinline__ unsigned xb_xcc_id() { return (unsigned)__builtin_amdgcn_s_getreg((3 << 11) | 20) & 0xFu; }
#define XB_SPIN(cond, bar) do { unsigned _sp = 0; while (cond) { __builtin_amdgcn_s_sleep(1); \
    if ((++_sp & 255u) == 0u) { if (xb_ld(&(bar)[XB_TMO])) break; if (_sp > XB_SPIN_CAP) { atomicAdd(&(bar)[XB_TMO], 1u); break; } } } } while (0)
struct XcdBarrier { unsigned* bar; unsigned x; volatile LAS unsigned* st; };
__device__ __forceinline__ XcdBarrier xcd_barrier_post(unsigned* bar, volatile LAS unsigned* st) {
    XcdBarrier b; b.bar = bar; b.x = xb_xcc_id(); b.st = st;
    if (threadIdx.x == 0) (void)xb_add(&bar[XB_XCNT(b.x)], 1u);
    return b;
}
__device__ __forceinline__ void xcd_barrier_complete(unsigned* bar, unsigned x, unsigned& nloc, unsigned& nx) {
    const unsigned G = gridDim.x * gridDim.y * gridDim.z;
    unsigned sum, cnt, mine, sp = 0u;
    for (;;) {
        sum = 0u; cnt = 0u; mine = 0u;
#pragma unroll
        for (unsigned j = 0; j < 16; ++j) { const unsigned c = xb_ld(&bar[XB_XCNT(j)]); sum += c; cnt += (c > 0u) ? 1u : 0u; mine = (j == x) ? c : mine; }
        if (sum == G) break;
        __builtin_amdgcn_s_sleep(1);
        if ((++sp & 255u) == 0u) { if (xb_ld(&bar[XB_TMO])) break; if (sp > XB_SPIN_CAP) { atomicAdd(&bar[XB_TMO], 1u); break; } }
    }
    nloc = mine > 0u ? mine : 1u; nx = cnt > 0u ? cnt : 1u;
}
__device__ __forceinline__ void xcd_barrier(const XcdBarrier& b, int wv) {
    asm volatile("s_waitcnt vmcnt(0)" ::: "memory");
    __syncthreads();
    if (otid(wv) == 0) {
        unsigned* bar = b.bar;
        unsigned bx = (unsigned)__builtin_amdgcn_readfirstlane((int)xb_xcc_id()); asm volatile("" : "+s"(bx));
        __builtin_amdgcn_s_waitcnt(0);
        unsigned nloc = b.st[0], nx = b.st[1];
        if (nloc == 0u) { xcd_barrier_complete(bar, bx, nloc, nx); b.st[0] = nloc; b.st[1] = nx; }
        const unsigned old = xb_add(&bar[XB_XSUB(bx)], 1u);
        const unsigned gen = old / nloc;
        if (old + 1u == (gen + 1u) * nloc) {
            __builtin_amdgcn_fence(__ATOMIC_RELEASE, "agent");
            asm volatile("s_waitcnt vmcnt(0)" ::: "memory");
            const unsigned og = xb_add(&bar[XB_TOP], 1u);
            const unsigned tg = og / nx;
            if (og + 1u == (tg + 1u) * nx) xb_add(&bar[XB_TOPGEN], 1u);
            else XB_SPIN(xb_ld(&bar[XB_TOPGEN]) == tg, bar);
            __builtin_amdgcn_fence(__ATOMIC_ACQUIRE, "agent");
            xb_add(&bar[XB_XGEN(bx)], 1u);
            asm volatile("s_waitcnt vmcnt(0)" ::: "memory");
        } else {
            XB_SPIN(xb_ld(&bar[XB_XGEN(bx)]) == gen, bar);
            __builtin_amdgcn_fence(__ATOMIC_ACQUIRE, "agent");
            asm volatile("s_waitcnt vmcnt(0)" ::: "memory");
        }
    }
    __syncthreads();
}

__global__ void __launch_bounds__(NTHR, 2) mega(Params p) {
    extern __shared__ __attribute__((aligned(16))) unsigned char lds[];
    cg::grid_group grid = cg::this_grid();
    const int G = gridDim.x, bid = blockIdx.x;
    const int wv = __builtin_amdgcn_readfirstlane(threadIdx.x >> 6);
    volatile LAS unsigned* xst = (volatile LAS unsigned*)((LAS unsigned char*)lds + (LDS_BYTES - 16));
    if (threadIdx.x == 0) { xst[0] = 0u; xst[1] = 0u; }
    __syncthreads();
    const XcdBarrier xbar = xcd_barrier_post((unsigned*)(p.ws + WS_BAR), xst);
    float* ldsf = (float*)lds;
#define WSPTRS \
    size_t wsoff_ = 0; asm volatile("" : "+s"(wsoff_)); unsigned char* ws = p.ws + wsoff_; \
    float* ssb = (float*)(ws + WS_SS); float* mod = (float*)(ws + WS_MOD); float* gsT = (float*)(ws + WS_GS); \
    float* biasG1 = (float*)(ws + WS_BG1); float* biasUP = (float*)(ws + WS_BUP); float* cwT = (float*)(ws + WS_CW); \
    bf16_t* xb = (bf16_t*)(ws + WS_XB); bf16_t* big1 = (bf16_t*)(ws + WS_BIG1); \
    bf16_t* wain = (bf16_t*)(ws + WS_WAIN); bf16_t* waout = (bf16_t*)(ws + WS_WAOUT); bf16_t* wqkv = (bf16_t*)(ws + WS_WQKV); bf16_t* wo = (bf16_t*)(ws + WS_WO); \
    bf16_t* wcin = (bf16_t*)(ws + WS_WCIN); bf16_t* wf = (bf16_t*)(ws + WS_WF); bf16_t* wup = (bf16_t*)(ws + WS_WUP); bf16_t* wdn = (bf16_t*)(ws + WS_WDN); \
    (void)ssb; (void)mod; (void)gsT; (void)biasG1; (void)biasUP; (void)cwT; (void)xb; (void)big1; (void)wain; (void)waout; (void)wqkv; (void)wo; (void)wcin; (void)wf; (void)wup; (void)wdn;
    {
    WSPTRS
    const int tid = otid(wv);
    for (int idx = bid * NTHR + tid; idx < 10 * MTOK / 4; idx += G * NTHR) *(f32x4*)(ssb + MTOK + 4 * (size_t)idx) = (f32x4){0.f, 0.f, 0.f, 0.f};
    if (bid < 192) mod_task(wv, p, bid, ldsf);
    { bf16_t* tab = (bf16_t*)(ws + WS_TAB);
        for (int idx = bid * NTHR + tid; idx < 4096 + 16384; idx += G * NTHR) {
            if (idx < 4096) { const int ka = idx >> 6, a = idx & 63; const float x = 2.0f * (float)((ka * a) & 63) / 64.0f; tab[TAB_CT64 / 2 + idx] = f2bf(cospif(x) * 0.125f); tab[TAB_ST64 / 2 + idx] = f2bf(sinpif(x) * 0.125f); }
            else { const int i2 = idx - 4096, ka = i2 >> 7, a = i2 & 127; const float x = 2.0f * (float)((ka * a) & 127) / 128.0f; tab[TAB_CT128 / 2 + i2] = f2bf(cospif(x) * 0.08838834764831845f); tab[TAB_ST128 / 2 + i2] = f2bf(sinpif(x) * 0.08838834764831845f); } } }
    if (bid >= G - 128) wf_task(wv, p, bid - (G - 128), ldsf);
    convert_matrix(wv, p.a_w_in, 1024, 2048, 2048, 0, wain, ldsf, 0);
    convert_matrix(wv, p.a_w_in + (size_t)1024 * 2048, 1024, 2048, 2048, 0, wain + (size_t)2048 * 1024, ldsf, 128);
    convert_matrix(wv, p.a_w_out, 1024, 1024, 1024, 0, waout, ldsf, 0);
    convert_matrix(wv, p.a_w_out + (size_t)1024 * 1024, 1024, 1024, 1024, 0, waout + (size_t)1024 * 1024, ldsf, 64);
    convert_matrix(wv, p.b_w_qkv, 1024, 1536, 1536, 0, wqkv, ldsf, 128);
    convert_matrix(wv, p.b_w_o, 1024, 1024, 1024, 0, wo, ldsf, 224);
    convert_matrix(wv, p.c_w_in, 1024, 1024, 1024, 0, wcin, ldsf, 32);
    convert_matrix(wv, p.f_w_up, 1024, NUP, NUP, 1, wup, ldsf, 96);
    convert_matrix(wv, p.f_w_down, FFD, 1024, 1024, 0, wdn, ldsf, 192);
    grid.sync();

    }
    {
    WSPTRS
    const int tid = otid(wv);
    if (bid < 26 + 88) {
        const float* W; int ld, perm = 0, nb, grp; const float* sh; float* bo;
        if (bid < 8) { W = p.a_w_in; ld = 2048; sh = mod; bo = biasG1; nb = 2048; grp = bid; }
        else if (bid < 14) { W = p.b_w_qkv; ld = 1536; sh = mod + 3 * MODW; bo = biasG1 + 3 * 2048; nb = 1536; grp = bid - 8; }
        else if (bid < 18) { W = p.c_w_in; ld = 1024; sh = mod + 6 * MODW; bo = biasG1 + 6 * 2048; nb = 1024; grp = bid - 14; }
        else if (bid < 26) { W = p.a_w_in + (size_t)1024 * 2048; ld = 2048; sh = mod + 9 * MODW; bo = biasG1 + 9 * 2048; nb = 2048; grp = bid - 18; }
        else { const int li = (bid - 26) / 22; W = p.f_w_up + (size_t)li * 1024 * NUP; ld = NUP; perm = 1; sh = mod + (size_t)li * 3 * MODW + 3 * DM; bo = biasUP + (size_t)li * 3 * NUP; nb = NUP; grp = (bid - 26) % 22; }
        bias_task(wv, W, ld, perm, sh, bo, nb, grp, ldsf);
    }
    for (int idx = bid * NTHR + tid; idx < 9 * 3 * DM; idx += G * NTHR) { const int ni = idx / (3 * DM), seq = (idx / DM) % 3, c = idx % DM;
        float v; if (ni == 8) v = p.g_final[c]; else { const int i = ni >> 1, t = ni & 1; v = p.norm_g[(i * 2 + t) * DM + c] * (1.0f + mod[((size_t)i * 3 + seq) * MODW + (t ? 4 : 1) * DM + c]); }
        gsT[idx] = v; }
    for (int idx = bid * NTHR + tid; idx < 4 * 4 * NUP; idx += G * NTHR) { const int i = idx / (4 * NUP), q = (idx / NUP) & 3, n = idx % NUP; const int oc = upcol(n);
        cwT[idx] = q < 3 ? p.f_w_conv[((size_t)i * 3 + q) * NUP + oc] : p.f_b_conv[(size_t)i * NUP + oc]; }
    convert_matrix(wv, (const float*)(ws + WS_WF32), 2048, 1024, 1024, 0, wf, ldsf, 48);
    { const int wid = tid >> 6, lane = tid & 63;
        for (int r = bid * 8 + wid; r < MTOK; r += G * 8) { const int seq = seq_of_row(r);
            const float* xr = r < 16384 ? p.xp + (size_t)r * DM : p.xs + (size_t)(r - 16384) * DM; float s = 0.f; f32x4 v[4];
#pragma unroll
            for (int jj = 0; jj < 4; ++jj) { v[jj] = *(const f32x4*)(xr + jj * 256 + 4 * lane); s += (v[jj][0] * v[jj][0] + v[jj][1] * v[jj][1]) + (v[jj][2] * v[jj][2] + v[jj][3] * v[jj][3]); }
#pragma unroll
            for (int o = 32; o >= 1; o >>= 1) s += __shfl_xor(s, o);
            if (lane == 0) ssb[r] = s;
#pragma unroll
            for (int jj = 0; jj < 4; ++jj) { const int c = jj * 256 + 4 * lane; u32x2 wv; float h[4];
#pragma unroll
                for (int j = 0; j < 4; ++j) h[j] = v[jj][j] * (p.norm_g[c + j] * (1.0f + mod[(size_t)seq * MODW + DM + c + j]));
                wv.x = cvt_pk_bf16(h[0], h[1]); wv.y = cvt_pk_bf16(h[2], h[3]); *(u32x2*)(xb + (size_t)r * DM + c) = wv; } } }
    xcd_barrier(xbar, wv);
    }

    LAS unsigned char* ldsl = (LAS unsigned char*)lds;
    for (int i = 0; i < 4; ++i) {
        WSPTRS
        const int kind = i % 3, jl = i / 3;
        {   pg8::StaticOrder S; const float* ssin = ssb + (size_t)(2 * i) * MTOK;
            if (kind == 0) { pg8::Gemm g{xb, wain + (size_t)jl * 2048 * 1024, MTOK, 2048, 1024, 1024}; S.init(MTOK, 2048, G, bid);
                pg8::EpiAct<1> E{big1, 2048, biasG1 + (size_t)i * 3 * 2048, 2048, ssin, ssb + (size_t)(9 + jl) * MTOK, 1024};
#ifndef NO_G1A
                pg8::gemm_phase<pg8::EpiAct<1>>(wv, ldsl, g, S, E);
#endif
 }
            else { const int N = kind == 1 ? 1536 : 1024; pg8::Gemm g{xb, kind == 1 ? wqkv : wcin, MTOK, N, 1024, 1024}; S.init(MTOK, N, G, bid);
                pg8::EpiAct<0> E{big1, N, biasG1 + (size_t)i * 3 * 2048, N, ssin, nullptr, 0};
#ifndef NO_G1B
                pg8::gemm_phase<pg8::EpiAct<0>>(wv, ldsl, g, S, E);
#endif
 }
        }
        xcd_barrier(xbar, wv);
        if (i < 3) {
            convert_matrix(wv, p.f_w_up + (size_t)(i + 1) * 1024 * NUP, 1024, NUP, NUP, 1, wup + (size_t)((i + 1) & 1) * NUP * 1024, ldsf, 0);
            convert_matrix(wv, p.f_w_down + (size_t)(i + 1) * FFD * 1024, FFD, 1024, 1024, 0, wdn + (size_t)((i + 1) & 1) * 1024 * FFD, ldsf, 96);
        }
#ifndef NO_SG
        if (kind == 0) sg_phase(wv, p, jl, lds);
#endif
#ifndef NO_ATT
        if (kind == 1) att_phase(wv, p, lds);
#endif
#ifndef NO_FFT
        if (kind == 2) {
#ifndef NO_FFT1
            if (bid < G / 2) fft1_units<64>(wv, p, lds, 0, 2, bid, G / 2); else fft1_units<128>(wv, p, lds, 2, 1, bid - G / 2, G - G / 2);
#endif
            xcd_barrier(xbar, wv);
#ifndef NO_FFT2
            fft2_phase(wv, p, lds);
#endif
        }
#endif
        xcd_barrier(xbar, wv);
        for (int half = 0; half < 2; ++half) {
            if (half == 1) {
                {   pg8::Gemm g{xb, wup + (size_t)(i & 1) * NUP * 1024, MTOK, NUP, 1024, 1024}; pg8::StaticOrder S; S.init(MTOK, NUP, G, bid);
                    pg8::EpiUp E{(bf16_t*)(ws + WS_ACT), biasUP + (size_t)i * 3 * NUP, cwT + (size_t)i * 4 * NUP, ssb + (size_t)(2 * i + 1) * MTOK, (float*)(ws + WS_EDGE)};
#ifndef NO_UP
                    pg8::gemm_phase<pg8::EpiUp>(wv, ldsl, g, S, E);
#endif
 }
                xcd_barrier(xbar, wv);
                fix_phase(wv, p, i);
                xcd_barrier(xbar, wv);
            }
            pg8::Gemm g; const float* gate; const float* gsn; bf16_t* xbo = xb; float* ssn; const float* b0 = p.out; const float* b1 = p.out + (size_t)16384 * DM;
            if (half == 0) {
                if (kind == 0) g = pg8::Gemm{big1, waout + (size_t)jl * 1024 * 1024, MTOK, 1024, 1024, 2048};
                else if (kind == 1) g = pg8::Gemm{big1, wo, MTOK, 1024, 1024, 1536};
                else g = pg8::Gemm{big1, wf, MTOK, 1024, 2048, 2048};
                gate = mod + (size_t)i * 3 * MODW + 2 * DM; gsn = gsT + (size_t)(2 * i + 1) * 3 * DM; ssn = ssb + (size_t)(2 * i + 1) * MTOK;
                if (i == 0) { b0 = p.xp; b1 = p.xs; }
            } else {
                g = pg8::Gemm{(const bf16_t*)(ws + WS_ACT), wdn + (size_t)(i & 1) * 1024 * FFD, MTOK, 1024, FFD, FFD};
                gate = mod + (size_t)i * 3 * MODW + 5 * DM; gsn = gsT + (size_t)(2 * i + 2) * 3 * DM; ssn = ssb + (size_t)(2 * i + 2) * MTOK;
                if (i == 3) xbo = nullptr;
            }
            pg8::StaticOrder S; S.init(MTOK, 1024, G, bid);
            pg8::EpiRes E{b0, b1, p.out, gate, gsn, xbo, ssn};
#ifndef NO_RES
            pg8::gemm_phase<pg8::EpiRes>(wv, ldsl, g, S, E);
#endif
            xcd_barrier(xbar, wv);
        }
    }
    { const float* ssF = (const float*)(p.ws + WS_SS) + (size_t)8 * MTOK; const int tid = otid(wv);
        for (size_t idx = (size_t)bid * NTHR + tid; idx < (size_t)MTOK * DM / 4; idx += (size_t)G * NTHR) { const int r = (int)(idx >> 8), c = (int)(idx & 255) * 4;
            const float rs = 1.0f / sqrtf(ssF[r] * (1.0f / DM) + EPSN); f32x4 v = *(const f32x4*)(p.out + (size_t)r * DM + c); const f32x4 gf = *(const f32x4*)(p.g_final + c);
            v = v * rs * gf; *(f32x4*)(p.out + (size_t)r * DM + c) = v; } }
}

extern "C" void kernel_launch(void* const* d_in, const int* in_sizes, int n_in, void* d_out, int out_size, void* d_ws, size_t ws_size, hipStream_t stream) {
    static int grid_blocks = 0;
    if (!grid_blocks) {
        if (ws_size < WS_END) { fprintf(stderr, "kernel_launch: workspace too small: %zu < %zu\n", ws_size, (size_t)WS_END); grid_blocks = -1; return; }
        int dev = 0, cus = 0, per_cu = 0;
        hipGetDevice(&dev);
        hipDeviceGetAttribute(&cus, hipDeviceAttributeMultiprocessorCount, dev);
        hipFuncSetAttribute((const void*)mega, hipFuncAttributeMaxDynamicSharedMemorySize, LDS_BYTES);
        hipOccupancyMaxActiveBlocksPerMultiprocessor(&per_cu, (const void*)mega, NTHR, LDS_BYTES);
        if (per_cu < 1) { fprintf(stderr, "kernel_launch: occupancy query says %d blocks per CU\n", per_cu); per_cu = 1; }
        grid_blocks = cus;
        (void)hipGetLastError();
    }
    if (grid_blocks < 0) return;
    if (hipMemsetAsync((char*)d_ws + WS_BAR, 0, BAR_BYTES, stream) != hipSuccess) { fprintf(stderr, "kernel_launch: memset of the barrier words failed\n"); return; }
    Params p{};
    p.xp = (const float*)d_in[0]; p.xs = (const float*)d_in[1]; p.cp = (const float*)d_in[2]; p.csm = (const float*)d_in[3]; p.w_ada = (const float*)d_in[4]; p.b_ada = (const float*)d_in[5];
    p.norm_g = (const float*)d_in[6]; p.a_w_in = (const float*)d_in[7]; p.a_g_v = (const float*)d_in[8]; p.a_w_s = (const float*)d_in[9]; p.a_b_s = (const float*)d_in[10]; p.a_w_out = (const float*)d_in[11];
    p.b_w_qkv = (const float*)d_in[12]; p.b_sinks = (const float*)d_in[13]; p.b_w_o = (const float*)d_in[14]; p.c_w_in = (const float*)d_in[15]; p.c_w_out = (const float*)d_in[16];
    p.f_w_up = (const float*)d_in[17]; p.f_w_conv = (const float*)d_in[18]; p.f_b_conv = (const float*)d_in[19]; p.f_w_down = (const float*)d_in[20]; p.g_final = (const float*)d_in[21];
    p.out = (float*)d_out; p.ws = (unsigned char*)d_ws;
    void* args[] = {&p};
    hipError_t e = hipLaunchCooperativeKernel((const void*)mega, dim3(grid_blocks), dim3(NTHR), args, LDS_BYTES, stream);
    if (e != hipSuccess) fprintf(stderr, "cooperative launch failed: %s (grid %d)\n", hipGetErrorString(e), grid_blocks);
}
```

```cpp
#include <hip/hip_runtime.h>
#include <hip/hip_cooperative_groups.h>
#include <cstdio>
namespace cg = cooperative_groups;

#define LAS __attribute__((address_space(3)))
typedef unsigned short bf16_t;
typedef short bf16x8 __attribute__((ext_vector_type(8)));
typedef short bf16x4 __attribute__((ext_vector_type(4)));
typedef float f32x4 __attribute__((ext_vector_type(4)));
typedef unsigned u32x4 __attribute__((ext_vector_type(4)));
typedef unsigned u32x2 __attribute__((ext_vector_type(2)));

constexpr int DM = 1024, MTOK = 32768, FFD = 2816, NUP = 5632, MODW = 6144;
constexpr float EPSN = 1e-6f;
typedef unsigned long long u64;
constexpr float SSK = 1048576.0f, SSKI = 1.0f / (1048576.0f * 1024.0f);
constexpr int NTHR = 512;
constexpr int LDS_BYTES = 147456;

constexpr size_t al256(size_t x) { return (x + 255) & ~(size_t)255; }
constexpr size_t WS_SS = 0;
constexpr size_t SS_BYTES = (size_t)11 * MTOK * 8;
constexpr size_t WS_MOD = al256(WS_SS + SS_BYTES);
constexpr size_t WS_GS = al256(WS_MOD + (size_t)4 * 3 * MODW * 4);
constexpr size_t WS_BG1 = al256(WS_GS + (size_t)9 * 3 * DM * 4);
constexpr size_t WS_BUP = al256(WS_BG1 + (size_t)4 * 3 * 2048 * 4);
constexpr size_t WS_CW = al256(WS_BUP + (size_t)4 * 3 * NUP * 4);
constexpr size_t WS_TAB = al256(WS_CW + (size_t)4 * 4 * NUP * 4);
constexpr size_t TAB_CT64 = 0, TAB_ST64 = 8192, TAB_CT128 = 16384, TAB_ST128 = 16384 + 32768;
constexpr size_t WS_BAR = al256(WS_TAB + 81920);
constexpr size_t BAR_BYTES = 3456 * 4;
constexpr size_t WS_WF32 = al256(WS_BAR + BAR_BYTES);
constexpr size_t WS_WAIN = al256(WS_WF32 + (size_t)2048 * 1024 * 4);
constexpr size_t WS_WAOUT = al256(WS_WAIN + (size_t)2 * 2048 * 1024 * 2);
constexpr size_t WS_WQKV = al256(WS_WAOUT + (size_t)2 * 1024 * 1024 * 2);
constexpr size_t WS_WO = al256(WS_WQKV + (size_t)1536 * 1024 * 2);
constexpr size_t WS_WCIN = al256(WS_WO + (size_t)1024 * 1024 * 2);
constexpr size_t WS_WF = al256(WS_WCIN + (size_t)1024 * 1024 * 2);
constexpr size_t WS_WUP = al256(WS_WF + (size_t)1024 * 2048 * 2);
constexpr size_t WS_WDN = al256(WS_WUP + (size_t)2 * NUP * 1024 * 2);
constexpr size_t WS_XB = al256(WS_WDN + (size_t)2 * 1024 * FFD * 2);
constexpr size_t WS_BIG1 = al256(WS_XB + (size_t)MTOK * DM * 2);
constexpr size_t WS_BIG2 = al256(WS_BIG1 + (size_t)MTOK * 2048 * 2);
constexpr size_t WS_ACT = WS_BIG1;
constexpr size_t WS_EDGE = al256(WS_ACT + (size_t)MTOK * FFD * 2);
constexpr size_t WS_END = al256(WS_BIG2 + (size_t)MTOK * 2048 * 2);
static_assert(WS_EDGE + (size_t)512 * 4 * NUP * 4 <= WS_END, "edge buffer must fit");

struct Params {
    const float* xp; const float* xs; const float* cp; const float* csm; const float* w_ada; const float* b_ada; const float* norm_g;
    const float* a_w_in; const float* a_g_v; const float* a_w_s; const float* a_b_s; const float* a_w_out;
    const float* b_w_qkv; const float* b_sinks; const float* b_w_o; const float* c_w_in; const float* c_w_out;
    const float* f_w_up; const float* f_w_conv; const float* f_b_conv; const float* f_w_down; const float* g_final;
    float* out; unsigned char* ws;
};

__device__ __forceinline__ int otid(int wv) { int t; asm volatile("v_mbcnt_lo_u32_b32 %0, -1, 0\n\tv_mbcnt_hi_u32_b32 %0, -1, %0\n\tv_lshl_add_u32 %0, %1, 6, %0" : "=&v"(t) : "s"(wv)); return t; }
typedef __bf16 bf2_t __attribute__((ext_vector_type(2)));
typedef float f2_t __attribute__((ext_vector_type(2)));
__device__ __forceinline__ unsigned cvt_pk_bf16_asm(float lo, float hi) { unsigned r; asm volatile("v_cvt_pk_bf16_f32 %0, %1, %2" : "=v"(r) : "v"(lo), "v"(hi)); return r; }
__device__ __forceinline__ unsigned cvt_pk_bf16(float lo, float hi) { const f2_t v = {lo, hi}; const bf2_t b = __builtin_convertvector(v, bf2_t); return __builtin_bit_cast(unsigned, b); }
__device__ __forceinline__ bf16_t f2bf(float f) { return (bf16_t)(cvt_pk_bf16(f, 0.f) & 0xffffu); }
__device__ __forceinline__ int seq_of_row(int r) { return r < 8192 ? 0 : (r < 16384 ? 1 : 2); }
__device__ __forceinline__ int upcol(int n) { return (n >> 8) * 128 + (n & 127) + ((n & 128) ? FFD : 0); }

namespace pg8 {
constexpr int BM = 256, BK = 64, HALF = 128, HTB = HALF * BK * 2, STAGE_BYTES = 8 * HTB, NXCD = 8, WGM = 8;
__device__ __forceinline__ int lds_byte(int r, int c) { const int st = (r >> 4) * 2 + (c >> 5), rr = r & 15, cc = c & 31, ob = rr * 64 + cc * 2; return st * 1024 + (ob ^ (((ob >> 9) & 1) << 5)); }
__device__ __forceinline__ void stage_rc(int b, int& R, int& C) { const int st = b / 1024, sb = b % 1024, swz = sb ^ (((sb >> 9) & 1) << 5); R = (st >> 1) * 16 + swz / 64; C = (st & 1) * 32 + (swz % 64) / 2; }
__device__ __forceinline__ int perm32(int rho) { const int n = rho >> 4, i = rho & 15; return 8 * (i >> 2) + 4 * n + (i & 3); }
struct Unit { int pm, pn; };
struct Gemm { const bf16_t* A; const bf16_t* Bt; int M, N, K, lda; };
struct StaticOrder {
    int nM, nN, nwg, G, c;
    __device__ void init(int M, int N, int G_, int c_) { nM = M / BM; nN = N / BM; nwg = nM * nN; G = G_; c = c_; }
    __device__ bool next(int i, Unit& u) const {
        const long L = (long)i * G + c; if (L >= nwg) return false;
        int wgid = (int)L; { const int q = nwg / NXCD, r = nwg % NXCD, xcd = wgid % NXCD, off = wgid / NXCD; wgid = (xcd < r ? xcd * (q + 1) : r * (q + 1) + (xcd - r) * q) + off; }
        const int nig = WGM * nN, gid = wgid / nig, fm = gid * WGM, gsz = (nM - fm) < WGM ? (nM - fm) : WGM;
        u.pm = fm + ((wgid % nig) % gsz); u.pn = (wgid % nig) / gsz; return true;
    }
};

template <class Epi>
__device__ __forceinline__ void gemm_phase(int wv, LAS unsigned char* lds, const Gemm g, const StaticOrder& S, const Epi& E) {
    const int tid = otid(wv), wid = __builtin_amdgcn_readfirstlane(tid >> 6), lane = tid & 63, wr = wid >> 2, wc = wid & 3, fr = lane & 15, fq = lane >> 4;
    const int K = g.K, nt = K / BK, lda = g.lda;
    unsigned voffA[2], voffB[2];
#pragma unroll
    for (int i = 0; i < 2; ++i) { int R, C; stage_rc(tid * 16 + i * 8192, R, C); const int Rb = Epi::PERM ? ((R & ~31) + perm32(R & 31)) : R;
        voffA[i] = (unsigned)(R * lda + C) * 2u; voffB[i] = (unsigned)(Rb * K + C) * 2u; }
    const size_t kstep = (size_t)(BK * 2);
    const size_t hstepA = (size_t)HALF * lda * 2, hstepB = (size_t)HALF * K * 2;
    const size_t tstepA = 2 * hstepA, tstepB = 2 * hstepB;
    const unsigned ldsw = (unsigned)wid * 1024u;
    const int aoff = lds_byte(wr * 64 + fr, fq * 8), boff = lds_byte(wc * 32 + fr, fq * 8);
#define PG8_SA(b, h) (((b) * 2 + (h)) * HTB)
#define PG8_SB(b, h) ((4 + (b) * 2 + (h)) * HTB)
#define PG8_STAGE(bufoff, gbase, voff) do { _Pragma("unroll") for (int _i = 0; _i < 2; ++_i) \
        __builtin_amdgcn_global_load_lds((const unsigned*)((const char*)(gbase) + (voff)[_i]), (LAS unsigned*)(lds + (bufoff) + ldsw + _i * 8192), 16, 0, 0); } while (0)
#define PG8_LDA(dst, b, h) do { _Pragma("unroll") for (int m = 0; m < 4; ++m) _Pragma("unroll") for (int k = 0; k < 2; ++k) dst[m][k] = *(const LAS bf16x8*)(lds + PG8_SA(b, h) + aoff + m * 2048 + k * 1024); } while (0)
#define PG8_LDB(dst, b, h) do { _Pragma("unroll") for (int n = 0; n < 2; ++n) _Pragma("unroll") for (int k = 0; k < 2; ++k) dst[n][k] = *(const LAS bf16x8*)(lds + PG8_SB(b, h) + boff + n * 2048 + k * 1024); } while (0)
#define PG8_MMA(ai, bj, At, Bt) do { __builtin_amdgcn_s_setprio(1); _Pragma("unroll") for (int m = 0; m < 4; ++m) _Pragma("unroll") for (int n = 0; n < 2; ++n) _Pragma("unroll") for (int k = 0; k < 2; ++k) \
        acc[ai][bj][m][n] = __builtin_amdgcn_mfma_f32_16x16x32_bf16(Bt[n][k], At[m][k], acc[ai][bj][m][n], 0, 0, 0); __builtin_amdgcn_s_setprio(0); } while (0)
#define PG8_WAIT_V(n) asm volatile("s_waitcnt vmcnt(" #n ")" ::: "memory")
#define PG8_WAIT_L(n) asm volatile("s_waitcnt lgkmcnt(" #n ")" ::: "memory")
#define PG8_BAR __builtin_amdgcn_s_barrier()
#define PG8_SCHED __builtin_amdgcn_sched_barrier(0)
    Unit cur, nxt; int ui = 0;
    if (!S.next(0, cur)) return;
    f32x4 acc[2][2][4][2];
#pragma unroll
    for (int a = 0; a < 2; ++a)
#pragma unroll
        for (int b = 0; b < 2; ++b)
#pragma unroll
            for (int m = 0; m < 4; ++m)
#pragma unroll
                for (int n = 0; n < 2; ++n) acc[a][b][m][n] = (f32x4){0.f, 0.f, 0.f, 0.f};
    bf16x8 At[4][2], B0[2][2], B1[2][2];
    const char* cA = (const char*)g.A + (size_t)cur.pm * tstepA; const char* cB = (const char*)g.Bt + (size_t)cur.pn * tstepB;
    PG8_STAGE(PG8_SB(0, 0), cB, voffB); PG8_STAGE(PG8_SA(0, 0), cA, voffA); PG8_STAGE(PG8_SB(0, 1), cB + hstepB, voffB); PG8_STAGE(PG8_SA(0, 1), cA + hstepA, voffA);
    if (wr == 1) PG8_BAR;
    PG8_WAIT_V(4); PG8_BAR;
    PG8_STAGE(PG8_SB(1, 0), cB + kstep, voffB); PG8_STAGE(PG8_SA(1, 0), cA + kstep, voffA); PG8_STAGE(PG8_SB(1, 1), cB + hstepB + kstep, voffB);
    PG8_WAIT_V(6); PG8_BAR;
    for (;;) {
        const bool has_next = S.next(ui + 1, nxt);
        const char* nA = has_next ? (const char*)g.A + (size_t)nxt.pm * tstepA : cA; const char* nB = has_next ? (const char*)g.Bt + (size_t)nxt.pn * tstepB : cB;
        for (int t = 0; t < nt; t += 2) {
            const bool last = (t == nt - 2);
            const char* a1 = cA + (size_t)(t + 1) * kstep;
            const char* a2 = last ? nA : cA + (size_t)(t + 2) * kstep; const char* b2 = last ? nB : cB + (size_t)(t + 2) * kstep;
            const char* a3 = a2 + kstep; const char* b3 = b2 + kstep;
            PG8_LDB(B0, 0, 0); PG8_SCHED; PG8_LDA(At, 0, 0); PG8_STAGE(PG8_SA(1, 1), a1 + hstepA, voffA);
            PG8_WAIT_L(8); PG8_BAR; PG8_WAIT_L(0); PG8_MMA(0, 0, At, B0); PG8_BAR; PG8_SCHED;
            PG8_LDB(B1, 0, 1); PG8_STAGE(PG8_SB(0, 0), b2, voffB);
            PG8_BAR; PG8_WAIT_L(0); PG8_MMA(0, 1, At, B1); PG8_BAR;
            PG8_LDA(At, 0, 1); PG8_STAGE(PG8_SA(0, 0), a2, voffA);
            PG8_BAR; PG8_WAIT_L(0); PG8_MMA(1, 0, At, B0); PG8_BAR; PG8_SCHED;
            PG8_STAGE(PG8_SB(0, 1), b2 + hstepB, voffB);
            PG8_WAIT_V(6); PG8_BAR; PG8_MMA(1, 1, At, B1); PG8_BAR;
            PG8_LDB(B0, 1, 0); PG8_SCHED; PG8_LDA(At, 1, 0); PG8_STAGE(PG8_SA(0, 1), a2 + hstepA, voffA);
            PG8_WAIT_L(8); PG8_BAR; PG8_WAIT_L(0); PG8_MMA(0, 0, At, B0); PG8_BAR; PG8_SCHED;
            PG8_LDB(B1, 1, 1); PG8_STAGE(PG8_SB(1, 0), b3, voffB);
            PG8_BAR; PG8_WAIT_L(0); PG8_MMA(0, 1, At, B1); PG8_BAR;
            PG8_LDA(At, 1, 1); PG8_STAGE(PG8_SA(1, 0), a3, voffA);
            PG8_BAR; PG8_WAIT_L(0); PG8_MMA(1, 0, At, B0); PG8_BAR; PG8_SCHED;
            PG8_STAGE(PG8_SB(1, 1), b3 + hstepB, voffB);
            PG8_WAIT_V(6); PG8_BAR; PG8_MMA(1, 1, At, B1); PG8_BAR;
        }
        { const int t2_ = otid(wv); E(acc, cur, wr, wc, t2_ & 15, (t2_ & 63) >> 4); }
        if (!has_next) break;
#pragma unroll
        for (int a = 0; a < 2; ++a)
#pragma unroll
            for (int b = 0; b < 2; ++b)
#pragma unroll
                for (int m = 0; m < 4; ++m)
#pragma unroll
                    for (int n = 0; n < 2; ++n) acc[a][b][m][n] = (f32x4){0.f, 0.f, 0.f, 0.f};
        cur = nxt; cA = nA; cB = nB; ++ui;
    }
    PG8_WAIT_V(0);
    if (wr == 0) PG8_BAR;
    PG8_BAR;
#undef PG8_SA
#undef PG8_SB
#undef PG8_STAGE
#undef PG8_LDA
#undef PG8_LDB
#undef PG8_MMA
#undef PG8_WAIT_V
#undef PG8_WAIT_L
#undef PG8_BAR
#undef PG8_SCHED
}

typedef float f32x2 __attribute__((ext_vector_type(2)));
__device__ __forceinline__ f32x2 gelu_pk(f32x2 v) {
    const f32x2 av = __builtin_elementwise_abs(v), d = av * 0.2316418882f + 1.0f;
    f32x2 t; t.x = __builtin_amdgcn_rcpf(d.x); t.y = __builtin_amdgcn_rcpf(d.y);
    f32x2 q = t * 0.5307027145f + (-0.7265760135f); q = q * t + 0.7107068705f; q = q * t + (-0.142248368f); q = q * t + 0.127414796f; q = q * t;
    const f32x2 s = (v * v) * (-0.72134752044f);
    f32x2 e; e.x = __builtin_amdgcn_exp2f(s.x); e.y = __builtin_amdgcn_exp2f(s.y);
    const f32x2 m = v * (q * e), r = v - m;
    f32x2 o; o.x = v.x < 0.f ? m.x : r.x; o.y = v.y < 0.f ? m.y : r.y; return o;
}
__device__ __forceinline__ f32x4 gelu4(f32x4 v) { f32x2 a = gelu_pk((f32x2){v[0], v[1]}), b = gelu_pk((f32x2){v[2], v[3]}); return (f32x4){a.x, a.y, b.x, b.y}; }

template <int ACT> struct EpiAct {
    static constexpr bool PERM = true;
    bf16_t* O; int ldc; const float* bias; int nb; const u64* ssin; u64* vss; int vcol0;
    __device__ __forceinline__ void operator()(const f32x4 (&acc)[2][2][4][2], const Unit& u, int wr, int wc, int fr, int fq) const {
        asm volatile("" : "+v"(fr), "+v"(fq));
        const int row0 = u.pm * BM + wr * 64 + fr, col0 = u.pn * BM + wc * 32 + 8 * fq;
        const int seq = seq_of_row(u.pm * BM);
        const float* bp = bias + (size_t)seq * nb + col0;
        f32x4 bv[2][2]; float rsv[2][4];
#pragma unroll
        for (int bj = 0; bj < 2; ++bj)
#pragma unroll
            for (int n = 0; n < 2; ++n) bv[bj][n] = *(const f32x4*)(bp + bj * HALF + 4 * n);
#pragma unroll
        for (int ai = 0; ai < 2; ++ai)
#pragma unroll
            for (int m = 0; m < 4; ++m) rsv[ai][m] = (float)ssin[row0 + ai * HALF + m * 16];
#pragma unroll
        for (int ai = 0; ai < 2; ++ai)
#pragma unroll
            for (int m = 0; m < 4; ++m) rsv[ai][m] = __builtin_amdgcn_rsqf(rsv[ai][m] * SSKI + EPSN);
        const bool dov = (ACT == 1) && (u.pn * BM >= vcol0);
#pragma unroll
        for (int ai = 0; ai < 2; ++ai)
#pragma unroll
            for (int m = 0; m < 4; ++m) {
                const int r = row0 + ai * HALF + m * 16;
                const float rs = rsv[ai][m];
                bf16_t* rowp = O + (size_t)r * ldc + col0; float s = 0.f;
#pragma unroll
                for (int bj = 0; bj < 2; ++bj) { f32x4 v0 = acc[ai][bj][m][0] * rs + bv[bj][0], v1 = acc[ai][bj][m][1] * rs + bv[bj][1];
                    if (ACT == 1) { v0 = gelu4(v0); v1 = gelu4(v1); s += (v0[0] * v0[0] + v0[1] * v0[1]) + (v0[2] * v0[2] + v0[3] * v0[3]) + (v1[0] * v1[0] + v1[1] * v1[1]) + (v1[2] * v1[2] + v1[3] * v1[3]); }
                    u32x4 w; w.x = cvt_pk_bf16_asm(v0[0], v0[1]); w.y = cvt_pk_bf16_asm(v0[2], v0[3]); w.z = cvt_pk_bf16_asm(v1[0], v1[1]); w.w = cvt_pk_bf16_asm(v1[2], v1[3]);
                    *(u32x4*)(rowp + bj * HALF) = w; }
                if (ACT == 1) { s += __shfl_xor(s, 16); s += __shfl_xor(s, 32); if (dov && fq == 0) (void)__hip_atomic_fetch_add(vss + r, (u64)(s * SSK), __ATOMIC_RELAXED, __HIP_MEMORY_SCOPE_AGENT); }
            }
    }
};

struct EpiRes {
    static constexpr bool PERM = true;
    const float* xf0; const float* xf1; bf16_t* xh; const float* gate; const float* gs; bf16_t* xb; u64* ssn;
    __device__ __forceinline__ void operator()(const f32x4 (&acc)[2][2][4][2], const Unit& u, int wr, int wc, int fr, int fq) const {
        asm volatile("" : "+v"(fr), "+v"(fq));
        const int row0 = u.pm * BM + wr * 64 + fr, col0 = u.pn * BM + wc * 32 + 8 * fq;
        const int seq = seq_of_row(u.pm * BM);
        const float* gp = gate + (size_t)seq * MODW + col0; const float* gsp = gs + (size_t)seq * DM + col0;
        f32x4 gv[2][2], gsv[2][2];
#pragma unroll
        for (int bj = 0; bj < 2; ++bj)
#pragma unroll
            for (int n = 0; n < 2; ++n) { gv[bj][n] = *(const f32x4*)(gp + bj * HALF + 4 * n); gsv[bj][n] = *(const f32x4*)(gsp + bj * HALF + 4 * n); }
        const bool f32in = (xf0 != nullptr);
        const float* fbase = f32in ? ((u.pm * BM < 16384 ? xf0 + (size_t)row0 * DM : xf1 + (size_t)(row0 - 16384) * DM) + col0) : nullptr;
        bf16_t* hbase = xh + (size_t)row0 * DM + col0;
        f32x4 xr[1][2][2];
#define ERES_LOAD(slot, g) do { const size_t ro_ = (size_t)(((g) >> 2) * HALF + ((g) & 3) * 16) * DM; \
            if (f32in) { _Pragma("unroll") for (int bj = 0; bj < 2; ++bj) _Pragma("unroll") for (int n = 0; n < 2; ++n) xr[slot][bj][n] = *(const f32x4*)(fbase + ro_ + bj * HALF + 4 * n); } \
            else { _Pragma("unroll") for (int bj = 0; bj < 2; ++bj) { const u32x4 q_ = *(const u32x4*)(hbase + ro_ + bj * HALF); \
                xr[slot][bj][0] = (f32x4){__uint_as_float(q_.x << 16), __uint_as_float(q_.x & 0xffff0000u), __uint_as_float(q_.y << 16), __uint_as_float(q_.y & 0xffff0000u)}; \
                xr[slot][bj][1] = (f32x4){__uint_as_float(q_.z << 16), __uint_as_float(q_.z & 0xffff0000u), __uint_as_float(q_.w << 16), __uint_as_float(q_.w & 0xffff0000u)}; } } } while (0)
#pragma unroll
        for (int g8 = 0; g8 < 8; ++g8) { const int ai = g8 >> 2, m = g8 & 3;
            ERES_LOAD(0, g8);
            const int r = row0 + ai * HALF + m * 16; float s = 0.f;
#pragma unroll
            for (int bj = 0; bj < 2; ++bj) { const f32x4 x0 = xr[0][bj][0] + gv[bj][0] * acc[ai][bj][m][0], x1 = xr[0][bj][1] + gv[bj][1] * acc[ai][bj][m][1];
                s += (x0[0] * x0[0] + x0[1] * x0[1]) + (x0[2] * x0[2] + x0[3] * x0[3]) + (x1[0] * x1[0] + x1[1] * x1[1]) + (x1[2] * x1[2] + x1[3] * x1[3]);
                u32x4 w; w.x = cvt_pk_bf16_asm(x0[0], x0[1]); w.y = cvt_pk_bf16_asm(x0[2], x0[3]); w.z = cvt_pk_bf16_asm(x1[0], x1[1]); w.w = cvt_pk_bf16_asm(x1[2], x1[3]);
                *(u32x4*)(xh + (size_t)r * DM + col0 + bj * HALF) = w;
                if (xb) { const f32x4 h0 = x0 * gsv[bj][0], h1 = x1 * gsv[bj][1]; u32x4 wb; wb.x = cvt_pk_bf16_asm(h0[0], h0[1]); wb.y = cvt_pk_bf16_asm(h0[2], h0[3]); wb.z = cvt_pk_bf16_asm(h1[0], h1[1]); wb.w = cvt_pk_bf16_asm(h1[2], h1[3]);
                    *(u32x4*)(xb + (size_t)r * DM + col0 + bj * HALF) = wb; } }
            s += __shfl_xor(s, 16); s += __shfl_xor(s, 32); if (fq == 0) (void)__hip_atomic_fetch_add(ssn + r, (u64)(s * SSK), __ATOMIC_RELAXED, __HIP_MEMORY_SCOPE_AGENT);
        }
#undef ERES_LOAD
    }
};

struct EpiUp {
    static constexpr bool PERM = true;
    bf16_t* act; const float* bias; const float* cw; const u64* ssin; float* edge;
    __device__ __forceinline__ void operator()(const f32x4 (&acc)[2][2][4][2], const Unit& u, int wr, int wc, int fr, int fq) const {
        asm volatile("" : "+v"(fr), "+v"(fq));
        const int row0 = u.pm * BM + wr * 64 + fr, colt = u.pn * BM + wc * 32 + 8 * fq;
        const int seq = seq_of_row(u.pm * BM);
        const float* biasp = bias + (size_t)seq * NUP + colt; const float* cwp = cw + colt;
        float rs[2][4];
#pragma unroll
        for (int ai = 0; ai < 2; ++ai)
#pragma unroll
            for (int m = 0; m < 4; ++m) rs[ai][m] = (float)ssin[row0 + ai * HALF + m * 16];
#pragma unroll
        for (int ai = 0; ai < 2; ++ai)
#pragma unroll
            for (int m = 0; m < 4; ++m) rs[ai][m] = __builtin_amdgcn_rsqf(rs[ai][m] * SSKI + EPSN);
#pragma unroll
        for (int n = 0; n < 2; ++n) {
            f32x4 prm[2][5];
#pragma unroll
            for (int bj = 0; bj < 2; ++bj) { const int co = bj * HALF + 4 * n;
                prm[bj][0] = *(const f32x4*)(biasp + co); prm[bj][1] = *(const f32x4*)(cwp + co); prm[bj][2] = *(const f32x4*)(cwp + NUP + co); prm[bj][3] = *(const f32x4*)(cwp + 2 * NUP + co); prm[bj][4] = *(const f32x4*)(cwp + 3 * NUP + co); }
#pragma unroll
            for (int ai = 0; ai < 2; ++ai) {
                float* ep = edge + (size_t)(u.pm * 4 + ai * 2 + wr) * 4 * NUP + colt;
                f32x4 SG[4];
#pragma unroll
                for (int bjr = 0; bjr < 2; ++bjr) { const int bj = 1 - bjr; const int co = bj * HALF + 4 * n;
                    f32x4 U[4];
#pragma unroll
                    for (int m = 0; m < 4; ++m) U[m] = acc[ai][bj][m][n] * rs[ai][m] + prm[bj][0];
                    if (fr < 2) *(f32x4*)(ep + (size_t)fr * NUP + co) = U[0];
                    if (fr >= 14) *(f32x4*)(ep + (size_t)(fr - 12) * NUP + co) = U[3];
#pragma unroll
                    for (int m = 0; m < 4; ++m) { const f32x4 sp = (fr == 15 && m > 0) ? U[m > 0 ? m - 1 : 0] : U[m]; const f32x4 sn = (fr == 0 && m < 3) ? U[m < 3 ? m + 1 : 3] : U[m];
                        f32x4 pv, nv;
#pragma unroll
                        for (int j = 0; j < 4; ++j) { pv[j] = __int_as_float(__builtin_amdgcn_update_dpp(0, __float_as_int(sp[j]), 0x121, 0xf, 0xf, false)); nv[j] = __int_as_float(__builtin_amdgcn_update_dpp(0, __float_as_int(sn[j]), 0x12F, 0xf, 0xf, false)); }
                        const f32x4 R = prm[bj][1] * pv + prm[bj][2] * U[m] + prm[bj][3] * nv + prm[bj][4];
                        if (bj == 1) {
#pragma unroll
                            for (int j = 0; j < 4; ++j) SG[m][j] = R[j] * __builtin_amdgcn_rcpf(1.0f + __expf(-R[j])); }
                        else { const int r = row0 + ai * HALF + m * 16; const bool skip = (m == 0 && fr == 0) || (m == 3 && fr == 15);
                            const f32x4 o = R * SG[m]; u32x2 w; w.x = cvt_pk_bf16_asm(o[0], o[1]); w.y = cvt_pk_bf16_asm(o[2], o[3]);
                            if (!skip) *(u32x2*)(act + (size_t)r * FFD + u.pn * 128 + wc * 32 + 8 * fq + 4 * n) = w; } } } }
        }
    }
};
}

__device__ __forceinline__ float silu_f(float x) { return x / (1.0f + __expf(-x)); }

__device__ void mod_task(int wv, const Params& p, int tk, float* ldsf) {
    const int tid = otid(wv), i = tk / 48, cgp = tk % 48;
    float* csL = ldsf; float* red = ldsf + 3072;
    for (int idx = tid; idx < 3072; idx += NTHR) { const int seq = idx >> 10, k = idx & 1023; const float c = seq < 2 ? p.cp[seq * DM + k] : p.csm[k]; csL[idx] = silu_f(c); }
    __syncthreads();
    const int quad = tid & 31, ksl = tid >> 5;
    const float* W = p.w_ada + (size_t)i * DM * MODW + (size_t)ksl * 64 * MODW + 128 * cgp + 4 * quad;
    f32x4 a0 = {0, 0, 0, 0}, a1 = {0, 0, 0, 0}, a2 = {0, 0, 0, 0};
#pragma unroll 8
    for (int kk = 0; kk < 64; ++kk) { const f32x4 w = *(const f32x4*)(W + (size_t)kk * MODW); const int k = ksl * 64 + kk;
        a0 += w * csL[k]; a1 += w * csL[1024 + k]; a2 += w * csL[2048 + k]; }
    float* rp = red + (ksl * 32 + quad) * 12;
    *(f32x4*)(rp) = a0; *(f32x4*)(rp + 4) = a1; *(f32x4*)(rp + 8) = a2;
    __syncthreads();
    if (tid < 384) { const int q = tid & 31, e = tid >> 5; float s = 0.f;
        for (int k = 0; k < 16; ++k) s += red[(k * 32 + q) * 12 + e];
        const int seq = e >> 2, col = 128 * cgp + 4 * q + (e & 3);
        float* mod = (float*)(p.ws + WS_MOD);
        mod[((size_t)i * 3 + seq) * MODW + col] = s + p.b_ada[i * MODW + col]; }
    __syncthreads();
}

__device__ void wf_task(int wv, const Params& p, int task, float* ldsf) {
    const int tid = otid(wv), g = task >> 4, n0 = (task & 15) * 64;
    float* tile = ldsf; float* ct = ldsf + 128 * 64;
    for (int idx = tid; idx < 128 * 16; idx += NTHR) { const int cp_ = idx >> 4, n4 = (idx & 15) * 4;
        *(f32x4*)(tile + cp_ * 64 + n4) = *(const f32x4*)(p.c_w_out + (size_t)(g * 128 + cp_) * DM + n0 + n4); }
    if (tid < 128) ct[tid] = cospif(2.0f * tid / 128.0f) * 0.08838834764831845f;
    __syncthreads();
    const int n = tid & 63, wvl = __builtin_amdgcn_readfirstlane(tid >> 6);
    float ac[16], as[16];
#pragma unroll
    for (int c = 0; c < 16; ++c) { ac[c] = 0.f; as[c] = 0.f; }
    for (int cq = 0; cq < 128; ++cq) { const float v = tile[cq * 64 + n];
#pragma unroll
        for (int cc = 0; cc < 16; ++cc) { const int idx = ((wvl * 16 + cc) * cq) & 127; ac[cc] += ct[idx] * v; as[cc] += ct[(idx + 96) & 127] * v; } }
    float* Wf = (float*)(p.ws + WS_WF32);
#pragma unroll
    for (int cc = 0; cc < 16; ++cc) { const int c = wvl * 16 + cc; Wf[(size_t)(g * 128 + c) * DM + n0 + n] = ac[cc]; Wf[(size_t)(1024 + g * 128 + c) * DM + n0 + n] = as[cc]; }
    __syncthreads();
}

__device__ void convert_matrix(int wv, const float* src, int K, int N, int ld, int perm, bf16_t* dst, float* tileL, int rot) {
    const int tid = otid(wv), G = gridDim.x, ntk = K >> 6, ntiles = ntk * (N >> 8);
    for (int t = (blockIdx.x + G - (rot % G)) % G; t < ntiles; t += G) {
        const int k0 = (t % ntk) * 64, n0 = (t / ntk) * 256;
        f32x4 v[8];
#pragma unroll
        for (int ps = 0; ps < 8; ++ps) { const int idx = tid + ps * NTHR, kk = idx >> 6, n4 = (idx & 63) * 4; const int sc = perm ? upcol(n0 + n4) : n0 + n4;
            v[ps] = *(const f32x4*)(src + (size_t)(k0 + kk) * ld + sc); }
#pragma unroll
        for (int ps = 0; ps < 8; ++ps) { const int idx = tid + ps * NTHR, kk = idx >> 6, n4 = (idx & 63) * 4;
            float* tp = tileL + kk * 257 + n4; tp[0] = v[ps][0]; tp[1] = v[ps][1]; tp[2] = v[ps][2]; tp[3] = v[ps][3]; }
        __syncthreads();
        { const int n = tid >> 1, kh = (tid & 1) * 32;
#pragma unroll
            for (int q = 0; q < 4; ++q) { float e[8];
#pragma unroll
                for (int j = 0; j < 8; ++j) e[j] = tileL[(kh + 8 * q + j) * 257 + n];
                u32x4 w; w.x = cvt_pk_bf16(e[0], e[1]); w.y = cvt_pk_bf16(e[2], e[3]); w.z = cvt_pk_bf16(e[4], e[5]); w.w = cvt_pk_bf16(e[6], e[7]);
                *(u32x4*)(dst + (size_t)(n0 + n) * K + k0 + kh + 8 * q) = w; } }
        __syncthreads();
    }
}

__device__ void bias_task(int wv, const float* W, int ld, int perm, const float* sh, float* bias, int nb, int grp, float* red) {
    const int tid = otid(wv), quad = tid & 63, ksl = __builtin_amdgcn_readfirstlane(tid >> 6);
    const int nn = 256 * grp + 4 * quad, sc = perm ? upcol(nn) : nn;
    f32x4 a0 = {0, 0, 0, 0}, a1 = {0, 0, 0, 0}, a2 = {0, 0, 0, 0};
    const float* wp = W + (size_t)ksl * 128 * ld + sc; const float* s0 = sh + ksl * 128;
#pragma unroll 16
    for (int kk = 0; kk < 128; ++kk) { const f32x4 w = *(const f32x4*)(wp + (size_t)kk * ld); a0 += w * s0[kk]; a1 += w * s0[MODW + kk]; a2 += w * s0[2 * MODW + kk]; }
    float* rp = red + (ksl * 64 + quad) * 12;
    *(f32x4*)(rp) = a0; *(f32x4*)(rp + 4) = a1; *(f32x4*)(rp + 8) = a2;
    __syncthreads();
    for (int idx = tid; idx < 768; idx += NTHR) { const int q = idx & 63, e = idx >> 6; float s = 0.f;
        for (int k = 0; k < 8; ++k) s += red[(k * 64 + q) * 12 + e];
        bias[(size_t)(e >> 2) * nb + 256 * grp + 4 * q + (e & 3)] = s; }
    __syncthreads();
}

__device__ __forceinline__ f32x4 mfma16(bf16x8 a, bf16x8 b, f32x4 c) { return __builtin_amdgcn_mfma_f32_16x16x32_bf16(a, b, c, 0, 0, 0); }

__device__ void sg_phase(int wv, const Params& p, int jl, unsigned char* lds) {
    const int tid = otid(wv), lane = tid & 63, w = __builtin_amdgcn_readfirstlane(tid >> 6), lr = lane & 15, lq = lane >> 4;
    bf16_t* uv = (bf16_t*)(p.ws + WS_BIG1);
    const u64* vss = (const u64*)(p.ws + WS_SS) + (size_t)(9 + jl) * MTOK;
    constexpr int PW = 136;
    bf16_t* WsL = (bf16_t*)lds; bf16_t* VTL = WsL + 128 * PW; float* rsL = (float*)(VTL + 128 * PW);
    for (int unit = blockIdx.x; unit < 2048; unit += gridDim.x) {
        const int ch = unit >> 3, g = unit & 7, t0 = ch * 128;
        if (tid < 128) rsL[tid] = 1.0f / sqrtf((float)vss[t0 + tid] * SSKI + EPSN);
        __syncthreads();
        const float* ws = p.a_w_s + ((size_t)jl * 8 + g) * 128 * 128;
#pragma unroll
        for (int ps = 0; ps < 8; ++ps) { const int idx = tid + ps * NTHR, t = idx >> 5, s4 = (idx & 31) * 4;
            const f32x4 wv = *(const f32x4*)(ws + t * 128 + s4); const f32x4 r4 = *(const f32x4*)(rsL + s4); const f32x4 x = wv * r4;
            u32x2 pk; pk.x = cvt_pk_bf16(x[0], x[1]); pk.y = cvt_pk_bf16(x[2], x[3]); *(u32x2*)(WsL + t * PW + s4) = pk; }
#pragma unroll
        for (int ps = 0; ps < 4; ++ps) { const int idx = tid + ps * NTHR, s = idx & 127, d8 = (idx >> 7) * 8;
            const bf16x8 v = *(const bf16x8*)(uv + (size_t)(t0 + s) * 2048 + 1024 + g * 128 + d8);
#pragma unroll
            for (int e = 0; e < 8; ++e) VTL[(d8 + e) * PW + s] = (bf16_t)v[e]; }
        __syncthreads();
        bf16x8 af[4];
#pragma unroll
        for (int kk = 0; kk < 4; ++kk) af[kk] = *(const bf16x8*)(WsL + (16 * w + lr) * PW + 32 * kk + 8 * lq);
        const int tok = t0 + 16 * w + lr; const float bs = p.a_b_s[((size_t)jl * 8 + g) * 128 + 16 * w + lr];
#pragma unroll
        for (int db = 0; db < 8; ++db) { f32x4 acc = {0, 0, 0, 0};
#pragma unroll
            for (int kk = 0; kk < 4; ++kk) { const bf16x8 bf = *(const bf16x8*)(VTL + (16 * db + lr) * PW + 32 * kk + 8 * lq); acc = mfma16(bf, af[kk], acc); }
            const int col = g * 128 + 16 * db + 4 * lq; const f32x4 gv = *(const f32x4*)(p.a_g_v + jl * DM + col);
            bf16_t* up = uv + (size_t)tok * 2048 + col; const u32x2 uu = *(const u32x2*)up;
            const float u0 = __uint_as_float(uu.x << 16), u1 = __uint_as_float(uu.x & 0xffff0000u), u2 = __uint_as_float(uu.y << 16), u3 = __uint_as_float(uu.y & 0xffff0000u);
            const f32x4 sv = acc * gv + bs; u32x2 o; o.x = cvt_pk_bf16(u0 * sv[0], u1 * sv[1]); o.y = cvt_pk_bf16(u2 * sv[2], u3 * sv[3]);
            *(u32x2*)up = o; }
        __syncthreads();
    }
}

__device__ void att_phase(int wv, const Params& p, unsigned char* lds) {
    const int tid = otid(wv), lane = tid & 63, w = __builtin_amdgcn_readfirstlane(tid >> 6), lr = lane & 15, lq = lane >> 4;
    bf16_t* qkv = (bf16_t*)(p.ws + WS_BIG1);
    constexpr int KP = 72, VP = 392;
    bf16_t* KL = (bf16_t*)lds; bf16_t* VTL = KL + 384 * KP;
    for (int unit = blockIdx.x; unit < 1024; unit += gridDim.x) {
        const int B = unit >> 2, kh = unit & 3;
        const int sb = B < 64 ? 0 : (B < 128 ? 64 : 128), se = B < 64 ? 64 : (B < 128 ? 128 : 256);
#pragma unroll
        for (int ps = 0; ps < 6; ++ps) { const int idx = tid + ps * NTHR, s = idx >> 3, c8 = (idx & 7) * 8; const int kb = B - 1 + (s >> 7);
            bf16x8 kv = {0, 0, 0, 0, 0, 0, 0, 0}, vv = {0, 0, 0, 0, 0, 0, 0, 0};
            if (kb >= sb && kb < se) { const bf16_t* rp = qkv + (size_t)(kb * 128 + (s & 127)) * 1536 + 64 * kh + c8; kv = *(const bf16x8*)(rp + 1024); vv = *(const bf16x8*)(rp + 1280); }
            *(bf16x8*)(KL + s * KP + c8) = kv;
#pragma unroll
            for (int e = 0; e < 8; ++e) VTL[(c8 + e) * VP + s] = (bf16_t)vv[e]; }
        __syncthreads();
        const int gq = w >> 1, h = 4 * kh + gq;
        const float slope = exp2f(-0.5f * (float)(h + 1)), sink = p.b_sinks[h];
        for (int rb = 0; rb < 4; ++rb) {
            const int qrow = 64 * (w & 1) + 16 * rb + lr;
            const size_t tokq = (size_t)B * 128 + qrow;
            bf16x8 qf[2];
#pragma unroll
            for (int kk = 0; kk < 2; ++kk) qf[kk] = *(const bf16x8*)(qkv + tokq * 1536 + 64 * h + 32 * kk + 8 * lq);
            f32x4 sc[24];
#pragma unroll
            for (int cb = 0; cb < 24; ++cb) { f32x4 a = {0, 0, 0, 0};
#pragma unroll
                for (int kk = 0; kk < 2; ++kk) { const bf16x8 kf = *(const bf16x8*)(KL + (16 * cb + lr) * KP + 32 * kk + 8 * lq); a = mfma16(kf, qf[kk], a); }
                sc[cb] = a; }
            float mx = sink;
#pragma unroll
            for (int cb = 0; cb < 24; ++cb) { const int kb = B - 1 + (cb >> 3); const bool bval = (kb >= sb && kb < se);
#pragma unroll
                for (int j = 0; j < 4; ++j) { const int krel = 16 * cb + 4 * lq + j - 128;
                    int dist = qrow - krel; dist = dist < 0 ? -dist : dist;
                    const float v = (bval && dist <= 128) ? sc[cb][j] * 0.125f - slope * (float)dist : -1e30f;
                    sc[cb][j] = v; mx = fmaxf(mx, v); } }
            mx = fmaxf(mx, __shfl_xor(mx, 16)); mx = fmaxf(mx, __shfl_xor(mx, 32));
            float sum = 0.f;
#pragma unroll
            for (int cb = 0; cb < 24; ++cb)
#pragma unroll
                for (int j = 0; j < 4; ++j) { const float e = __expf(sc[cb][j] - mx); sc[cb][j] = e; sum += e; }
            sum += __shfl_xor(sum, 16); sum += __shfl_xor(sum, 32);
            sum += __expf(sink - mx);
            const float inv = 1.0f / sum;
            f32x4 oa[4];
#pragma unroll
            for (int db = 0; db < 4; ++db) oa[db] = (f32x4){0, 0, 0, 0};
#pragma unroll
            for (int ks = 0; ks < 12; ++ks) {
                union { bf16x8 v; unsigned u[4]; } pf;
                pf.u[0] = cvt_pk_bf16_asm(sc[2 * ks][0], sc[2 * ks][1]); pf.u[1] = cvt_pk_bf16_asm(sc[2 * ks][2], sc[2 * ks][3]);
                pf.u[2] = cvt_pk_bf16_asm(sc[2 * ks + 1][0], sc[2 * ks + 1][1]); pf.u[3] = cvt_pk_bf16_asm(sc[2 * ks + 1][2], sc[2 * ks + 1][3]);
#pragma unroll
                for (int db = 0; db < 4; ++db) {
                    union { bf16x8 v; u32x2 h2[2]; } vf;
                    const bf16_t* vp = VTL + (16 * db + lr) * VP + 32 * ks + 4 * lq;
                    vf.h2[0] = *(const u32x2*)vp; vf.h2[1] = *(const u32x2*)(vp + 16);
                    oa[db] = mfma16(vf.v, pf.v, oa[db]); } }
#pragma unroll
            for (int db = 0; db < 4; ++db) { const f32x4 o = oa[db] * inv; u32x2 wv; wv.x = cvt_pk_bf16_asm(o[0], o[1]); wv.y = cvt_pk_bf16_asm(o[2], o[3]);
                *(u32x2*)(qkv + tokq * 1536 + 64 * h + 16 * db + 4 * lq) = wv; }
        }
        __syncthreads();
    }
}

template <int N1> __device__ void fft1_units(int wv, const Params& p, unsigned char* lds, int seq_lo, int nseq, int part, int nparts) {
    const int tid = otid(wv), lane = tid & 63, w = __builtin_amdgcn_readfirstlane(tid >> 6), lr = lane & 15, lq = lane >> 4;
    constexpr int PW = N1 + 8, NB = N1 / 16, NK = N1 / 32; constexpr int S = N1 * 128;
    const bf16_t* z = (const bf16_t*)(p.ws + WS_BIG1); bf16_t* A1 = (bf16_t*)(p.ws + WS_BIG2);
    const bf16_t* ctg = (const bf16_t*)(p.ws + WS_TAB + (N1 == 64 ? TAB_CT64 : TAB_CT128)); const bf16_t* stg = (const bf16_t*)(p.ws + WS_TAB + (N1 == 64 ? TAB_ST64 : TAB_ST128));
    bf16_t* CT = (bf16_t*)lds; bf16_t* ST = CT + N1 * PW; bf16_t* XT = ST + N1 * PW;
    for (int idx = tid; idx < N1 * N1 / 8; idx += NTHR) { const int r = idx / (N1 / 8), c8 = (idx % (N1 / 8)) * 8;
        *(bf16x8*)(CT + r * PW + c8) = *(const bf16x8*)(ctg + r * N1 + c8); *(bf16x8*)(ST + r * PW + c8) = *(const bf16x8*)(stg + r * N1 + c8); }
    __syncthreads();
    const int nunits = nseq * 128 * 8;
    for (int unit = part; unit < nunits; unit += nparts) {
        const int sq = unit / 1024, b = (unit >> 3) & 127, cb = unit & 7;
        const int seq = seq_lo + sq; const size_t sbase = (size_t)seq * 8192;
        for (int idx = tid; idx < N1 * 16; idx += NTHR) { const int a = idx % N1, c8 = (idx / N1) * 8;
            const bf16x8 v = *(const bf16x8*)(z + (sbase + 128 * a + b) * DM + cb * 128 + c8);
#pragma unroll
            for (int e = 0; e < 8; ++e) XT[(c8 + e) * PW + a] = (bf16_t)v[e]; }
        __syncthreads();
        bf16x8 xf[NK];
#pragma unroll
        for (int kk = 0; kk < NK; ++kk) xf[kk] = *(const bf16x8*)(XT + (16 * w + lr) * PW + 32 * kk + 8 * lq);
#pragma unroll
        for (int i = 0; i < NB; ++i) { f32x4 ar = {0, 0, 0, 0}, as = {0, 0, 0, 0};
#pragma unroll
            for (int kk = 0; kk < NK; ++kk) { const bf16x8 cf = *(const bf16x8*)(CT + (16 * i + lr) * PW + 32 * kk + 8 * lq), sf = *(const bf16x8*)(ST + (16 * i + lr) * PW + 32 * kk + 8 * lq);
                ar = mfma16(xf[kk], cf, ar); as = mfma16(xf[kk], sf, as); }
            const int ka = 16 * i + lr; float tc, ts; sincospif(2.0f * (float)(b * ka) / (float)S, &ts, &tc);
            const f32x4 re = ar * tc - as * ts, im = -(as * tc) - ar * ts;
            bf16_t* op = A1 + (sbase + (size_t)ka * 128 + b) * 2048 + cb * 128 + 16 * w + 4 * lq;
            u32x2 o; o.x = cvt_pk_bf16(re[0], re[1]); o.y = cvt_pk_bf16(re[2], re[3]); *(u32x2*)op = o;
            o.x = cvt_pk_bf16(im[0], im[1]); o.y = cvt_pk_bf16(im[2], im[3]); *(u32x2*)(op + 1024) = o; }
        __syncthreads();
    }
}
__device__ void fft2_phase(int wv, const Params& p, unsigned char* lds) {
    const int tid = otid(wv), lane = tid & 63, w = __builtin_amdgcn_readfirstlane(tid >> 6), lr = lane & 15, lq = lane >> 4;
    constexpr int PW = 136;
    const bf16_t* A1 = (const bf16_t*)(p.ws + WS_BIG2); bf16_t* Y = (bf16_t*)(p.ws + WS_BIG1);
    const bf16_t* ctg = (const bf16_t*)(p.ws + WS_TAB + TAB_CT128); const bf16_t* stg = (const bf16_t*)(p.ws + WS_TAB + TAB_ST128);
    bf16_t* CT = (bf16_t*)lds; bf16_t* ST = CT + 128 * PW; bf16_t* XR = ST + 128 * PW; bf16_t* XI = XR + 128 * PW;
    for (int idx = tid; idx < 128 * 16; idx += NTHR) { const int r = idx >> 4, c8 = (idx & 15) * 8;
        *(bf16x8*)(CT + r * PW + c8) = *(const bf16x8*)(ctg + r * 128 + c8); *(bf16x8*)(ST + r * PW + c8) = *(const bf16x8*)(stg + r * 128 + c8); }
    __syncthreads();
    for (int unit = blockIdx.x; unit < 2048; unit += gridDim.x) {
        const int gi = unit >> 3, cb = unit & 7;
        const int seq = gi < 64 ? 0 : (gi < 128 ? 1 : 2); const int ka = gi - (seq == 0 ? 0 : (seq == 1 ? 64 : 128)); const int N1 = seq == 2 ? 128 : 64;
        const size_t sbase = (size_t)seq * 8192;
#pragma unroll
        for (int ps = 0; ps < 4; ++ps) { const int idx = tid + ps * NTHR, b = idx & 127, c8 = (idx >> 7) * 8;
            const bf16_t* rp = A1 + ((size_t)gi * 128 + b) * 2048 + cb * 128 + c8; const bf16x8 vr = *(const bf16x8*)rp, vi = *(const bf16x8*)(rp + 1024);
#pragma unroll
            for (int e = 0; e < 8; ++e) { XR[(c8 + e) * PW + b] = (bf16_t)vr[e]; XI[(c8 + e) * PW + b] = (bf16_t)vi[e]; } }
        __syncthreads();
        bf16x8 xr[4], xi[4], nxr[4];
#pragma unroll
        for (int kk = 0; kk < 4; ++kk) { xr[kk] = *(const bf16x8*)(XR + (16 * w + lr) * PW + 32 * kk + 8 * lq); xi[kk] = *(const bf16x8*)(XI + (16 * w + lr) * PW + 32 * kk + 8 * lq);
            union { bf16x8 v; unsigned u[4]; } t; t.v = xr[kk]; t.u[0] ^= 0x80008000u; t.u[1] ^= 0x80008000u; t.u[2] ^= 0x80008000u; t.u[3] ^= 0x80008000u; nxr[kk] = t.v; }
#pragma unroll
        for (int i = 0; i < 8; ++i) { f32x4 re = {0, 0, 0, 0}, im = {0, 0, 0, 0};
#pragma unroll
            for (int kk = 0; kk < 4; ++kk) { const bf16x8 cf = *(const bf16x8*)(CT + (16 * i + lr) * PW + 32 * kk + 8 * lq), sf = *(const bf16x8*)(ST + (16 * i + lr) * PW + 32 * kk + 8 * lq);
                re = mfma16(xr[kk], cf, re); re = mfma16(xi[kk], sf, re); im = mfma16(xi[kk], cf, im); im = mfma16(nxr[kk], sf, im); }
            const int kb = 16 * i + lr;
            bf16_t* op = Y + (sbase + (size_t)N1 * kb + ka) * 2048 + cb * 128 + 16 * w + 4 * lq;
            u32x2 o; o.x = cvt_pk_bf16(re[0], re[1]); o.y = cvt_pk_bf16(re[2], re[3]); *(u32x2*)op = o;
            o.x = cvt_pk_bf16(im[0], im[1]); o.y = cvt_pk_bf16(im[2], im[3]); *(u32x2*)(op + 1024) = o; }
        __syncthreads();
    }
}

__device__ void fix_phase(int wv, const Params& p, int li) {
    const float* edge = (const float*)(p.ws + WS_EDGE); const float* cw = (const float*)(p.ws + WS_CW) + (size_t)li * 4 * NUP; bf16_t* act = (bf16_t*)(p.ws + WS_ACT);
    const int total = 1024 * (FFD / 4);
    const int tid = otid(wv);
    for (int idx = blockIdx.x * NTHR + tid; idx < total; idx += gridDim.x * NTHR) {
        const int e = idx / (FFD / 4), c = (idx % (FFD / 4)) * 4; const int band = e >> 1, hi = e & 1; const int R = band * 64 + (hi ? 63 : 0);
        const int ca = (c >> 7) * 256 + (c & 127), cg_ = ca + 128;
        const bool seqstart = (R == 0 || R == 8192 || R == 16384), seqend = (R == 8191 || R == 16383 || R == 32767);
        const float* ep = edge + (size_t)band * 4 * NUP;
        f32x4 pa, pg, ua, ug, na, ng; const f32x4 zero = {0, 0, 0, 0};
        if (!hi) { pa = seqstart ? zero : *(const f32x4*)(ep - NUP + ca); pg = seqstart ? zero : *(const f32x4*)(ep - NUP + cg_);
            ua = *(const f32x4*)(ep + ca); ug = *(const f32x4*)(ep + cg_); na = *(const f32x4*)(ep + NUP + ca); ng = *(const f32x4*)(ep + NUP + cg_); }
        else { pa = *(const f32x4*)(ep + 2 * NUP + ca); pg = *(const f32x4*)(ep + 2 * NUP + cg_); ua = *(const f32x4*)(ep + 3 * NUP + ca); ug = *(const f32x4*)(ep + 3 * NUP + cg_);
            na = seqend ? zero : *(const f32x4*)(ep + 4 * NUP + ca); ng = seqend ? zero : *(const f32x4*)(ep + 4 * NUP + cg_); }
        const f32x4 a = *(const f32x4*)(cw + ca) * pa + *(const f32x4*)(cw + NUP + ca) * ua + *(const f32x4*)(cw + 2 * NUP + ca) * na + *(const f32x4*)(cw + 3 * NUP + ca);
        const f32x4 g = *(const f32x4*)(cw + cg_) * pg + *(const f32x4*)(cw + NUP + cg_) * ug + *(const f32x4*)(cw + 2 * NUP + cg_) * ng + *(const f32x4*)(cw + 3 * NUP + cg_);
        float o[4];
#pragma unroll
        for (int j = 0; j < 4; ++j) o[j] = a[j] * g[j] / (1.0f + __expf(-g[j]));
        u32x2 wv; wv.x = cvt_pk_bf16(o[0], o[1]); wv.y = cvt_pk_bf16(o[2], o[3]);
        *(u32x2*)(act + (size_t)R * FFD + c) = wv;
    }
}

#define XB_TMO      128
#define XB_XCNT(j)  (256  + 64 * (j))
#define XB_XSUB(j)  (1280 + 64 * (j))
#define XB_XGEN(j)  (2304 + 64 * (j))
#define XB_TOP      3328
#define XB_TOPGEN   3392
#define XCD_BAR_WORDS 3456
#define XB_SPIN_CAP (1u << 18)
__device__ __forceinline__ unsigned xb_ld(unsigned* p)              { return __hip_atomic_load(p, __ATOMIC_RELAXED, __HIP_MEMORY_SCOPE_AGENT); }
__device__ __forceinline__ unsigned xb_add(unsigned* p, unsigned v) { return __hip_atomic_fetch_add(p, v, __ATOMIC_RELAXED, __HIP_MEMORY_SCOPE_AGENT); }
__device__ __forceinline__ unsigned xb_xcc_id() { return (unsigned)__builtin_amdgcn_s_getreg((3 << 11) | 20) & 0xFu; }
#define XB_SPIN(cond, bar) do { unsigned _sp = 0; while (cond) { __builtin_amdgcn_s_sleep(1); \
    if ((++_sp & 255u) == 0u) { if (xb_ld(&(bar)[XB_TMO])) break; if (_sp > XB_SPIN_CAP) { atomicAdd(&(bar)[XB_TMO], 1u); break; } } } } while (0)
struct XcdBarrier { unsigned* bar; unsigned x; volatile LAS unsigned* st; };
__device__ __forceinline__ XcdBarrier xcd_barrier_post(unsigned* bar, volatile LAS unsigned* st) {
    XcdBarrier b; b.bar = bar; b.x = xb_xcc_id(); b.st = st;
    if (threadIdx.x == 0) (void)xb_add(&bar[XB_XCNT(b.x)], 1u);
    return b;
}
__device__ __forceinline__ void xcd_barrier_complete(unsigned* bar, unsigned x, unsigned& nloc, unsigned& nx) {
    const unsigned G = gridDim.x * gridDim.y * gridDim.z;
    unsigned sum, cnt, mine, sp = 0u;
    for (;;) {
        sum = 0u; cnt = 0u; mine = 0u;
#pragma unroll
        for (unsigned j = 0; j < 16; ++j) { const unsigned c = xb_ld(&bar[XB_XCNT(j)]); sum += c; cnt += (c > 0u) ? 1u : 0u; mine = (j == x) ? c : mine; }
        if (sum == G) break;
        __builtin_amdgcn_s_sleep(1);
        if ((++sp & 255u) == 0u) { if (xb_ld(&bar[XB_TMO])) break; if (sp > XB_SPIN_CAP) { atomicAdd(&bar[XB_TMO], 1u); break; } }
    }
    nloc = mine > 0u ? mine : 1u; nx = cnt > 0u ? cnt : 1u;
}
__device__ __forceinline__ void xcd_barrier(const XcdBarrier& b, int wv) {
    asm volatile("s_waitcnt vmcnt(0)" ::: "memory");
    __syncthreads();
    if (otid(wv) == 0) {
        unsigned* bar = b.bar;
        unsigned bx = (unsigned)__builtin_amdgcn_readfirstlane((int)xb_xcc_id()); asm volatile("" : "+s"(bx));
        __builtin_amdgcn_s_waitcnt(0);
        unsigned nloc = b.st[0], nx = b.st[1];
        if (nloc == 0u) { xcd_barrier_complete(bar, bx, nloc, nx); b.st[0] = nloc; b.st[1] = nx; }
        const unsigned old = xb_add(&bar[XB_XSUB(bx)], 1u);
        const unsigned gen = old / nloc;
        if (old + 1u == (gen + 1u) * nloc) {
            __builtin_amdgcn_fence(__ATOMIC_RELEASE, "agent");
            asm volatile("s_waitcnt vmcnt(0)" ::: "memory");
            const unsigned og = xb_add(&bar[XB_TOP], 1u);
            const unsigned tg = og / nx;
            if (og + 1u == (tg + 1u) * nx) xb_add(&bar[XB_TOPGEN], 1u);
            else XB_SPIN(xb_ld(&bar[XB_TOPGEN]) == tg, bar);
            __builtin_amdgcn_fence(__ATOMIC_ACQUIRE, "agent");
            xb_add(&bar[XB_XGEN(bx)], 1u);
            asm volatile("s_waitcnt vmcnt(0)" ::: "memory");
        } else {
            XB_SPIN(xb_ld(&bar[XB_XGEN(bx)]) == gen, bar);
            __builtin_amdgcn_fence(__ATOMIC_ACQUIRE, "agent");
            asm volatile("s_waitcnt vmcnt(0)" ::: "memory");
        }
    }
    __syncthreads();
}

__global__ void __launch_bounds__(NTHR, 2) mega(Params p) {
    extern __shared__ __attribute__((aligned(16))) unsigned char lds[];
    cg::grid_group grid = cg::this_grid();
    const int G = gridDim.x, bid = blockIdx.x;
    const int wv = __builtin_amdgcn_readfirstlane(threadIdx.x >> 6);
    volatile LAS unsigned* xst = (volatile LAS unsigned*)((LAS unsigned char*)lds + (LDS_BYTES - 16));
    if (threadIdx.x == 0) { xst[0] = 0u; xst[1] = 0u; }
    __syncthreads();
    const XcdBarrier xbar = xcd_barrier_post((unsigned*)(p.ws + WS_BAR), xst);
    float* ldsf = (float*)lds;
#define WSPTRS \
    size_t wsoff_ = 0; asm volatile("" : "+s"(wsoff_)); unsigned char* ws = p.ws + wsoff_; \
    u64* ssb = (u64*)(ws + WS_SS); float* mod = (float*)(ws + WS_MOD); float* gsT = (float*)(ws + WS_GS); \
    float* biasG1 = (float*)(ws + WS_BG1); float* biasUP = (float*)(ws + WS_BUP); float* cwT = (float*)(ws + WS_CW); \
    bf16_t* xb = (bf16_t*)(ws + WS_XB); bf16_t* big1 = (bf16_t*)(ws + WS_BIG1); \
    bf16_t* wain = (bf16_t*)(ws + WS_WAIN); bf16_t* waout = (bf16_t*)(ws + WS_WAOUT); bf16_t* wqkv = (bf16_t*)(ws + WS_WQKV); bf16_t* wo = (bf16_t*)(ws + WS_WO); \
    bf16_t* wcin = (bf16_t*)(ws + WS_WCIN); bf16_t* wf = (bf16_t*)(ws + WS_WF); bf16_t* wup = (bf16_t*)(ws + WS_WUP); bf16_t* wdn = (bf16_t*)(ws + WS_WDN); \
    (void)ssb; (void)mod; (void)gsT; (void)biasG1; (void)biasUP; (void)cwT; (void)xb; (void)big1; (void)wain; (void)waout; (void)wqkv; (void)wo; (void)wcin; (void)wf; (void)wup; (void)wdn;
    {
    WSPTRS
    const int tid = otid(wv);
    for (int idx = bid * NTHR + tid; idx < 10 * MTOK / 2; idx += G * NTHR) *(u32x4*)(ssb + MTOK + 2 * (size_t)idx) = (u32x4){0u, 0u, 0u, 0u};
    if (bid < 192) mod_task(wv, p, bid, ldsf);
    { bf16_t* tab = (bf16_t*)(ws + WS_TAB);
        for (int idx = bid * NTHR + tid; idx < 4096 + 16384; idx += G * NTHR) {
            if (idx < 4096) { const int ka = idx >> 6, a = idx & 63; const float x = 2.0f * (float)((ka * a) & 63) / 64.0f; tab[TAB_CT64 / 2 + idx] = f2bf(cospif(x) * 0.125f); tab[TAB_ST64 / 2 + idx] = f2bf(sinpif(x) * 0.125f); }
            else { const int i2 = idx - 4096, ka = i2 >> 7, a = i2 & 127; const float x = 2.0f * (float)((ka * a) & 127) / 128.0f; tab[TAB_CT128 / 2 + i2] = f2bf(cospif(x) * 0.08838834764831845f); tab[TAB_ST128 / 2 + i2] = f2bf(sinpif(x) * 0.08838834764831845f); } } }
    if (bid >= G - 128) wf_task(wv, p, bid - (G - 128), ldsf);
    convert_matrix(wv, p.a_w_in, 1024, 2048, 2048, 0, wain, ldsf, 0);
    convert_matrix(wv, p.a_w_in + (size_t)1024 * 2048, 1024, 2048, 2048, 0, wain + (size_t)2048 * 1024, ldsf, 128);
    convert_matrix(wv, p.a_w_out, 1024, 1024, 1024, 0, waout, ldsf, 0);
    convert_matrix(wv, p.a_w_out + (size_t)1024 * 1024, 1024, 1024, 1024, 0, waout + (size_t)1024 * 1024, ldsf, 64);
    convert_matrix(wv, p.b_w_qkv, 1024, 1536, 1536, 0, wqkv, ldsf, 128);
    convert_matrix(wv, p.b_w_o, 1024, 1024, 1024, 0, wo, ldsf, 224);
    convert_matrix(wv, p.c_w_in, 1024, 1024, 1024, 0, wcin, ldsf, 32);
    convert_matrix(wv, p.f_w_up, 1024, NUP, NUP, 1, wup, ldsf, 96);
    convert_matrix(wv, p.f_w_down, FFD, 1024, 1024, 0, wdn, ldsf, 192);
    grid.sync();

    }
    {
    WSPTRS
    const int tid = otid(wv);
    if (bid < 26 + 88) {
        const float* W; int ld, perm = 0, nb, grp; const float* sh; float* bo;
        if (bid < 8) { W = p.a_w_in; ld = 2048; sh = mod; bo = biasG1; nb = 2048; grp = bid; }
        else if (bid < 14) { W = p.b_w_qkv; ld = 1536; sh = mod + 3 * MODW; bo = biasG1 + 3 * 2048; nb = 1536; grp = bid - 8; }
        else if (bid < 18) { W = p.c_w_in; ld = 1024; sh = mod + 6 * MODW; bo = biasG1 + 6 * 2048; nb = 1024; grp = bid - 14; }
        else if (bid < 26) { W = p.a_w_in + (size_t)1024 * 2048; ld = 2048; sh = mod + 9 * MODW; bo = biasG1 + 9 * 2048; nb = 2048; grp = bid - 18; }
        else { const int li = (bid - 26) / 22; W = p.f_w_up + (size_t)li * 1024 * NUP; ld = NUP; perm = 1; sh = mod + (size_t)li * 3 * MODW + 3 * DM; bo = biasUP + (size_t)li * 3 * NUP; nb = NUP; grp = (bid - 26) % 22; }
        bias_task(wv, W, ld, perm, sh, bo, nb, grp, ldsf);
    }
    for (int idx = bid * NTHR + tid; idx < 9 * 3 * DM; idx += G * NTHR) { const int ni = idx / (3 * DM), seq = (idx / DM) % 3, c = idx % DM;
        float v; if (ni == 8) v = p.g_final[c]; else { const int i = ni >> 1, t = ni & 1; v = p.norm_g[(i * 2 + t) * DM + c] * (1.0f + mod[((size_t)i * 3 + seq) * MODW + (t ? 4 : 1) * DM + c]); }
        gsT[idx] = v; }
    for (int idx = bid * NTHR + tid; idx < 4 * 4 * NUP; idx += G * NTHR) { const int i = idx / (4 * NUP), q = (idx / NUP) & 3, n = idx % NUP; const int oc = upcol(n);
        cwT[idx] = q < 3 ? p.f_w_conv[((size_t)i * 3 + q) * NUP + oc] : p.f_b_conv[(size_t)i * NUP + oc]; }
    convert_matrix(wv, (const float*)(ws + WS_WF32), 2048, 1024, 1024, 0, wf, ldsf, 48);
    { const int wid = tid >> 6, lane = tid & 63;
        for (int r = bid * 8 + wid; r < MTOK; r += G * 8) { const int seq = seq_of_row(r);
            const float* xr = r < 16384 ? p.xp + (size_t)r * DM : p.xs + (size_t)(r - 16384) * DM; float s = 0.f; f32x4 v[4];
#pragma unroll
            for (int jj = 0; jj < 4; ++jj) { v[jj] = *(const f32x4*)(xr + jj * 256 + 4 * lane); s += (v[jj][0] * v[jj][0] + v[jj][1] * v[jj][1]) + (v[jj][2] * v[jj][2] + v[jj][3] * v[jj][3]); }
#pragma unroll
            for (int o = 32; o >= 1; o >>= 1) s += __shfl_xor(s, o);
            if (lane == 0) ssb[r] = (u64)(s * SSK);
#pragma unroll
            for (int jj = 0; jj < 4; ++jj) { const int c = jj * 256 + 4 * lane; u32x2 wv; float h[4];
#pragma unroll
                for (int j = 0; j < 4; ++j) h[j] = v[jj][j] * (p.norm_g[c + j] * (1.0f + mod[(size_t)seq * MODW + DM + c + j]));
                wv.x = cvt_pk_bf16(h[0], h[1]); wv.y = cvt_pk_bf16(h[2], h[3]); *(u32x2*)(xb + (size_t)r * DM + c) = wv; } } }
    xcd_barrier(xbar, wv);
    }

    LAS unsigned char* ldsl = (LAS unsigned char*)lds;
    for (int i = 0; i < 4; ++i) {
        WSPTRS
        const int kind = i % 3, jl = i / 3;
        {   pg8::StaticOrder S; const u64* ssin = ssb + (size_t)(2 * i) * MTOK;
            if (kind == 0) { pg8::Gemm g{xb, wain + (size_t)jl * 2048 * 1024, MTOK, 2048, 1024, 1024}; S.init(MTOK, 2048, G, bid);
                pg8::EpiAct<1> E{big1, 2048, biasG1 + (size_t)i * 3 * 2048, 2048, ssin, ssb + (size_t)(9 + jl) * MTOK, 1024};
#ifndef NO_G1A
                pg8::gemm_phase<pg8::EpiAct<1>>(wv, ldsl, g, S, E);
#endif
 }
            else { const int N = kind == 1 ? 1536 : 1024; pg8::Gemm g{xb, kind == 1 ? wqkv : wcin, MTOK, N, 1024, 1024}; S.init(MTOK, N, G, bid);
                pg8::EpiAct<0> E{big1, N, biasG1 + (size_t)i * 3 * 2048, N, ssin, nullptr, 0};
#ifndef NO_G1B
                pg8::gemm_phase<pg8::EpiAct<0>>(wv, ldsl, g, S, E);
#endif
 }
        }
        xcd_barrier(xbar, wv);
        if (i < 3) {
            convert_matrix(wv, p.f_w_up + (size_t)(i + 1) * 1024 * NUP, 1024, NUP, NUP, 1, wup + (size_t)((i + 1) & 1) * NUP * 1024, ldsf, 0);
            convert_matrix(wv, p.f_w_down + (size_t)(i + 1) * FFD * 1024, FFD, 1024, 1024, 0, wdn + (size_t)((i + 1) & 1) * 1024 * FFD, ldsf, 96);
        }
#ifndef NO_SG
        if (kind == 0) sg_phase(wv, p, jl, lds);
#endif
#ifndef NO_ATT
        if (kind == 1) att_phase(wv, p, lds);
#endif
#ifndef NO_FFT
        if (kind == 2) {
#ifndef NO_FFT1
            if (bid < G / 2) fft1_units<64>(wv, p, lds, 0, 2, bid, G / 2); else fft1_units<128>(wv, p, lds, 2, 1, bid - G / 2, G - G / 2);
#endif
            xcd_barrier(xbar, wv);
#ifndef NO_FFT2
            fft2_phase(wv, p, lds);
#endif
        }
#endif
        xcd_barrier(xbar, wv);
        for (int half = 0; half < 2; ++half) {
            if (half == 1) {
                {   pg8::Gemm g{xb, wup + (size_t)(i & 1) * NUP * 1024, MTOK, NUP, 1024, 1024}; pg8::StaticOrder S; S.init(MTOK, NUP, G, bid);
                    pg8::EpiUp E{(bf16_t*)(ws + WS_ACT), biasUP + (size_t)i * 3 * NUP, cwT + (size_t)i * 4 * NUP, ssb + (size_t)(2 * i + 1) * MTOK, (float*)(ws + WS_EDGE)};
#ifndef NO_UP
                    pg8::gemm_phase<pg8::EpiUp>(wv, ldsl, g, S, E);
#endif
 }
                xcd_barrier(xbar, wv);
                fix_phase(wv, p, i);
                xcd_barrier(xbar, wv);
            }
            pg8::Gemm g; const float* gate; const float* gsn; bf16_t* xbo = xb; u64* ssn; const float* b0 = nullptr; const float* b1 = nullptr;
            if (half == 0) {
                if (kind == 0) g = pg8::Gemm{big1, waout + (size_t)jl * 1024 * 1024, MTOK, 1024, 1024, 2048};
                else if (kind == 1) g = pg8::Gemm{big1, wo, MTOK, 1024, 1024, 1536};
                else g = pg8::Gemm{big1, wf, MTOK, 1024, 2048, 2048};
                gate = mod + (size_t)i * 3 * MODW + 2 * DM; gsn = gsT + (size_t)(2 * i + 1) * 3 * DM; ssn = ssb + (size_t)(2 * i + 1) * MTOK;
                if (i == 0) { b0 = p.xp; b1 = p.xs; }
            } else {
                g = pg8::Gemm{(const bf16_t*)(ws + WS_ACT), wdn + (size_t)(i & 1) * 1024 * FFD, MTOK, 1024, FFD, FFD};
                gate = mod + (size_t)i * 3 * MODW + 5 * DM; gsn = gsT + (size_t)(2 * i + 2) * 3 * DM; ssn = ssb + (size_t)(2 * i + 2) * MTOK;
                if (i == 3) xbo = nullptr;
            }
            pg8::StaticOrder S; S.init(MTOK, 1024, G, bid);
            pg8::EpiRes E{b0, b1, (bf16_t*)p.out, gate, gsn, xbo, ssn};
#ifndef NO_RES
            pg8::gemm_phase<pg8::EpiRes>(wv, ldsl, g, S, E);
#endif
            xcd_barrier(xbar, wv);
        }
    }
    { const u64* ssF = (const u64*)(p.ws + WS_SS) + (size_t)8 * MTOK; const int tid = otid(wv);
        const bf16_t* xh = (const bf16_t*)p.out; bf16_t* xcp = (bf16_t*)(p.ws + WS_BIG1);
        for (size_t idx = (size_t)bid * NTHR + tid; idx < (size_t)16384 * DM / 8; idx += (size_t)G * NTHR) { const int r = 16384 + (int)(idx >> 7), c = (int)(idx & 127) * 8;
            const u32x4 q = *(const u32x4*)(xh + (size_t)r * DM + c); const u32x4 q2 = *(const u32x4*)(xh + (size_t)(r - 16384) * DM + c);
            *(u32x4*)(xcp + (size_t)(r - 16384) * DM + c) = q2;
            const float rs = 1.0f / sqrtf((float)ssF[r] * SSKI + EPSN); const f32x4 g0 = *(const f32x4*)(p.g_final + c), g1 = *(const f32x4*)(p.g_final + c + 4);
            f32x4 v0 = {__uint_as_float(q.x << 16), __uint_as_float(q.x & 0xffff0000u), __uint_as_float(q.y << 16), __uint_as_float(q.y & 0xffff0000u)};
            f32x4 v1 = {__uint_as_float(q.z << 16), __uint_as_float(q.z & 0xffff0000u), __uint_as_float(q.w << 16), __uint_as_float(q.w & 0xffff0000u)};
            *(f32x4*)(p.out + (size_t)r * DM + c) = v0 * rs * g0; *(f32x4*)(p.out + (size_t)r * DM + c + 4) = v1 * rs * g1; }
        xcd_barrier(xbar, wv);
        for (size_t idx = (size_t)bid * NTHR + tid; idx < (size_t)16384 * DM / 8; idx += (size_t)G * NTHR) { const int r = (int)(idx >> 7), c = (int)(idx & 127) * 8;
            const u32x4 q = *(const u32x4*)(xcp + (size_t)r * DM + c);
            const float rs = 1.0f / sqrtf((float)ssF[r] * SSKI + EPSN); const f32x4 g0 = *(const f32x4*)(p.g_final + c), g1 = *(const f32x4*)(p.g_final + c + 4);
            f32x4 v0 = {__uint_as_float(q.x << 16), __uint_as_float(q.x & 0xffff0000u), __uint_as_float(q.y << 16), __uint_as_float(q.y & 0xffff0000u)};
            f32x4 v1 = {__uint_as_float(q.z << 16), __uint_as_float(q.z & 0xffff0000u), __uint_as_float(q.w << 16), __uint_as_float(q.w & 0xffff0000u)};
            *(f32x4*)(p.out + (size_t)r * DM + c) = v0 * rs * g0; *(f32x4*)(p.out + (size_t)r * DM + c + 4) = v1 * rs * g1; } }
}

extern "C" void kernel_launch(void* const* d_in, const int* in_sizes, int n_in, void* d_out, int out_size, void* d_ws, size_t ws_size, hipStream_t stream) {
    static int grid_blocks = 0;
    if (!grid_blocks) {
        if (ws_size < WS_END) { fprintf(stderr, "kernel_launch: workspace too small: %zu < %zu\n", ws_size, (size_t)WS_END); grid_blocks = -1; return; }
        int dev = 0, cus = 0, per_cu = 0;
        hipGetDevice(&dev);
        hipDeviceGetAttribute(&cus, hipDeviceAttributeMultiprocessorCount, dev);
        hipFuncSetAttribute((const void*)mega, hipFuncAttributeMaxDynamicSharedMemorySize, LDS_BYTES);
        hipOccupancyMaxActiveBlocksPerMultiprocessor(&per_cu, (const void*)mega, NTHR, LDS_BYTES);
        if (per_cu < 1) { fprintf(stderr, "kernel_launch: occupancy query says %d blocks per CU\n", per_cu); per_cu = 1; }
        grid_blocks = cus;
        (void)hipGetLastError();
    }
    if (grid_blocks < 0) return;
    if (hipMemsetAsync((char*)d_ws + WS_BAR, 0, BAR_BYTES, stream) != hipSuccess) { fprintf(stderr, "kernel_launch: memset of the barrier words failed\n"); return; }
    Params p{};
    p.xp = (const float*)d_in[0]; p.xs = (const float*)d_in[1]; p.cp = (const float*)d_in[2]; p.csm = (const float*)d_in[3]; p.w_ada = (const float*)d_in[4]; p.b_ada = (const float*)d_in[5];
    p.norm_g = (const float*)d_in[6]; p.a_w_in = (const float*)d_in[7]; p.a_g_v = (const float*)d_in[8]; p.a_w_s = (const float*)d_in[9]; p.a_b_s = (const float*)d_in[10]; p.a_w_out = (const float*)d_in[11];
    p.b_w_qkv = (const float*)d_in[12]; p.b_sinks = (const float*)d_in[13]; p.b_w_o = (const float*)d_in[14]; p.c_w_in = (const float*)d_in[15]; p.c_w_out = (const float*)d_in[16];
    p.f_w_up = (const float*)d_in[17]; p.f_w_conv = (const float*)d_in[18]; p.f_b_conv = (const float*)d_in[19]; p.f_w_down = (const float*)d_in[20]; p.g_final = (const float*)d_in[21];
    p.out = (float*)d_out; p.ws = (unsigned char*)d_ws;
    void* args[] = {&p};
    hipError_t e = hipLaunchCooperativeKernel((const void*)mega, dim3(grid_blocks), dim3(NTHR), args, LDS_BYTES, stream);
    if (e != hipSuccess) fprintf(stderr, "cooperative launch failed: %s (grid %d)\n", hipGetErrorString(e), grid_blocks);
}
```
